# Optimizing an MI355X kernel written in HIP

```python
import math
import jax, jax.numpy as jnp
from jax import lax
import numpy as np

D_MODEL = 2048
BATCH = 16
SEQ = 2048
DEPTH = 2
DEC_BATCH = 16
DEC_SEQ = 64
PAST_LEN = 4096

CHUNK = 64
GDN_HEADS = 16
GDN_DK = 128
GDN_DV = 128
GDN_WIDTH = GDN_HEADS * GDN_DV
CONV_W = 4
CONV_CH = 2 * GDN_HEADS * GDN_DK + GDN_WIDTH
ATT_HEADS = 16
KV_HEADS = 2
HEAD_DIM = 128
ATT_WIDTH = ATT_HEADS * HEAD_DIM
IDX_HEADS = 16
IDX_DIM = 64
TOPK_MAX = 256
Q_BLOCK = 128
REL_BUCKETS = 32
REL_MAX_DIST = 128
EPS = 1e-6

IN_SIZES = (CONV_CH, GDN_WIDTH, GDN_HEADS, GDN_HEADS,
            ATT_WIDTH, KV_HEADS * HEAD_DIM, KV_HEADS * HEAD_DIM, ATT_WIDTH,
            IDX_HEADS * IDX_DIM, IDX_DIM, IDX_HEADS,
            D_MODEL, D_MODEL)
IN_DIM = sum(IN_SIZES)

kernel_name = 'hybrid_gdn_dsa_stream_step'


def rmsnorm(x, w):
    xf = x.astype(jnp.float32)
    y = xf * lax.rsqrt(jnp.mean(xf * xf, axis=-1, keepdims=True) + EPS)
    return (y * w.astype(jnp.float32)).astype(x.dtype)


def l2norm(x):
    return x * lax.rsqrt(jnp.sum(x * x, axis=-1, keepdims=True) + EPS)


def causal_conv(x, prev, w):
    xp = jnp.concatenate([prev.astype(x.dtype), x], axis=1)
    T = x.shape[1]
    y = xp[:, 0:T] * w[0]
    for j in range(1, CONV_W):
        y = y + xp[:, j:j + T] * w[j]
    return y, xp[:, -(CONV_W - 1):]


def rel_bucket(rel):
    nb = REL_BUCKETS // 2
    max_exact = nb // 2
    n = jnp.abs(rel)
    nf = jnp.maximum(n, 1).astype(jnp.float32)
    large = max_exact + (jnp.log(nf / max_exact) / math.log(REL_MAX_DIST / max_exact)
                         * (nb - max_exact)).astype(jnp.int32)
    large = jnp.minimum(large, nb - 1)
    return jnp.where(rel > 0, nb, 0) + jnp.where(n < max_exact, n, large)


def gated_delta_rule(q, k, v, g, beta, S0):
    B, T, H, DK = q.shape
    C = min(CHUNK, T)
    N = T // C

    def chunks(a):
        a = a.reshape((B, N, C, H) + a.shape[3:])
        return jnp.moveaxis(a, (1, 3), (0, 2))

    q, k, v, g, beta = chunks(q), chunks(k), chunks(v), chunks(g), chunks(beta)
    gc = jnp.cumsum(g, axis=-1)
    idx = jnp.arange(C)
    tril = idx[:, None] >= idx[None, :]
    strict = idx[:, None] > idx[None, :]
    decay = jnp.exp(jnp.where(tril, gc[..., :, None] - gc[..., None, :], -jnp.inf))
    kb = k * beta[..., None]
    A = jnp.where(strict, jnp.einsum('nbhid,nbhjd->nbhij', kb, k) * decay, 0.0)
    eye = jnp.eye(C, dtype=jnp.float32)
    Tm = lax.linalg.triangular_solve(eye + A, jnp.broadcast_to(eye, A.shape),
                                     left_side=True, lower=True, unit_diagonal=True)
    u = jnp.einsum('nbhij,nbhjd->nbhid', Tm, v * beta[..., None])
    w = jnp.einsum('nbhij,nbhjd->nbhid', Tm, kb * jnp.exp(gc)[..., None])
    qk = jnp.einsum('nbhid,nbhjd->nbhij', q, k) * decay
    q_dec = q * jnp.exp(gc)[..., None]
    k_dec = k * jnp.exp(gc[..., -1:] - gc)[..., None]
    g_last = jnp.exp(gc[..., -1])

    def step(S, xs):
        u_i, w_i, qk_i, qd_i, kd_i, gl_i = xs
        v_new = u_i - jnp.einsum('bhcd,bhde->bhce', w_i, S)
        o_i = jnp.einsum('bhcd,bhde->bhce', qd_i, S) + jnp.einsum('bhij,bhje->bhie', qk_i, v_new)
        S = S * gl_i[..., None, None] + jnp.einsum('bhcd,bhce->bhde', kd_i, v_new)
        return S, o_i

    S, o = lax.scan(step, S0, (u, w, qk, q_dec, k_dec, g_last))
    o = jnp.moveaxis(o, (0, 2), (1, 3)).reshape(B, T, H, -1)
    return o, S


def sparse_attention(q, qi, wi, q_pos, K, V, KI, topk, rel_bias):
    B, Tq = q.shape[:2]
    L = K.shape[1]
    k_pos = jnp.arange(L)
    dots = jnp.einsum('bthd,bsd->bths', qi.astype(jnp.float32), KI.astype(jnp.float32))
    score = jnp.einsum('bth,bths->bts', wi.astype(jnp.float32), jax.nn.relu(dots))
    visible = (k_pos[None, :] // CHUNK) <= (q_pos[:, None] // CHUNK)
    score = jnp.where(visible[None], score, -jnp.inf)
    top_val, top_idx = lax.top_k(score, topk)
    valid = jnp.isfinite(top_val)
    Ks = jax.vmap(lambda kb, ib: kb[ib])(K, top_idx)
    Vs = jax.vmap(lambda vb, ib: vb[ib])(V, top_idx)
    G = ATT_HEADS // KV_HEADS
    qg = q.reshape(B, Tq, KV_HEADS, G, HEAD_DIM)
    logits = jnp.einsum('btngd,btsnd->btngs', qg, Ks).astype(jnp.float32) * (HEAD_DIM ** -0.5)
    rel = top_idx - q_pos[None, :, None]
    bias = rel_bias[rel_bucket(rel)].astype(jnp.float32)
    bias = jnp.moveaxis(bias.reshape(B, Tq, topk, KV_HEADS, G), 2, 4)
    logits = jnp.where(valid[:, :, None, None, :], logits + bias, -jnp.inf)
    p = jax.nn.softmax(logits, axis=-1).astype(V.dtype)
    o = jnp.einsum('btngs,btsnd->btngd', p, Vs)
    return o.reshape(B, Tq, ATT_WIDTH)


def trunk_layer(x, c, conv_prev, S0, past, norm_w, w_ada, b_ada, w_in, w_conv, a_log, dt_bias,
                gdn_norm_w, w_branch_a, w_branch_b, w_out, rel_bias):
    B, T, _ = x.shape
    shift, scale, gate = jnp.split(jax.nn.silu(c) @ w_ada + b_ada, 3, axis=-1)
    h = rmsnorm(x, norm_w) * (1.0 + scale[:, None]) + shift[:, None]
    proj = h @ w_in
    (qkv_a, z_a, b_a, a_a, q_b, k_b, v_b, z_b, q_i, k_i, w_i, gl_a, gl_b) = jnp.split(
        proj, np.cumsum(IN_SIZES)[:-1].tolist(), axis=-1)

    conv_out, conv_new = causal_conv(qkv_a, conv_prev, w_conv)
    conv_out = jax.nn.silu(conv_out).astype(jnp.float32)
    qa, ka, va = jnp.split(conv_out, [GDN_HEADS * GDN_DK, 2 * GDN_HEADS * GDN_DK], axis=-1)
    qa = l2norm(qa.reshape(B, T, GDN_HEADS, GDN_DK)) * (GDN_DK ** -0.5)
    ka = l2norm(ka.reshape(B, T, GDN_HEADS, GDN_DK))
    va = va.reshape(B, T, GDN_HEADS, GDN_DV)
    beta = jax.nn.sigmoid(b_a.astype(jnp.float32))
    g = -jnp.exp(a_log.astype(jnp.float32)) * jax.nn.softplus(a_a.astype(jnp.float32) + dt_bias.astype(jnp.float32))
    o_a, S_new = gated_delta_rule(qa, ka, va, g, beta, S0.astype(jnp.float32))
    o_a = rmsnorm(o_a, gdn_norm_w) * jax.nn.silu(z_a.astype(jnp.float32)).reshape(B, T, GDN_HEADS, GDN_DV)
    y_a = o_a.reshape(B, T, GDN_WIDTH).astype(x.dtype) @ w_branch_a

    q_b = q_b.reshape(B, T, ATT_HEADS, HEAD_DIM)
    k_b = k_b.reshape(B, T, KV_HEADS, HEAD_DIM)
    v_b = v_b.reshape(B, T, KV_HEADS, HEAD_DIM)
    q_i = q_i.reshape(B, T, IDX_HEADS, IDX_DIM)
    w_i = w_i * ((IDX_HEADS ** -0.5) * (IDX_DIM ** -0.5))
    if past is None:
        K, V, KI = k_b, v_b, k_i
        topk = min(TOPK_MAX, K.shape[1] // 4)
        qb = min(Q_BLOCK, T)
        nblk = T // qb

        def blk(a):
            return jnp.moveaxis(a.reshape((B, nblk, qb) + a.shape[2:]), 1, 0)

        pos = jnp.arange(T).reshape(nblk, qb)
        o_b = lax.map(lambda xs: sparse_attention(xs[0], xs[1], xs[2], xs[3], K, V, KI, topk, rel_bias),
                      (blk(q_b), blk(q_i), blk(w_i), pos))
        o_b = jnp.moveaxis(o_b, 0, 1).reshape(B, T, ATT_WIDTH)
    else:
        k_past, v_past, ki_past = past
        P = k_past.shape[1]
        K = jnp.concatenate([k_past.astype(k_b.dtype), k_b], axis=1)
        V = jnp.concatenate([v_past.astype(v_b.dtype), v_b], axis=1)
        KI = jnp.concatenate([ki_past.astype(k_i.dtype), k_i], axis=1)
        topk = min(TOPK_MAX, K.shape[1] // 4)
        o_b = sparse_attention(q_b, q_i, w_i, P + jnp.arange(T), K, V, KI, topk, rel_bias)
    y_b = (o_b * jax.nn.silu(z_b)) @ w_branch_b

    merged = jax.nn.sigmoid(gl_a) * y_a + jax.nn.sigmoid(gl_b) * y_b
    x = x + gate[:, None] * (merged @ w_out)
    return x, (k_b, v_b, k_i, S_new, conv_new)


def setup_inputs(seed: int = 0) -> dict:
    key = jax.random.key(seed)
    ks = jax.random.split(key, 24)
    f32 = jnp.float32

    def nrm(k, shape, s):
        return jax.random.normal(k, shape, f32) * s

    dt = jnp.exp(jax.random.uniform(ks[15], (DEPTH, GDN_HEADS), f32, math.log(1e-3), math.log(1e-1)))
    return {
        'x_prompt': nrm(ks[0], (BATCH, SEQ, D_MODEL), 1.0),
        'x_sample': nrm(ks[1], (DEC_BATCH, DEC_SEQ, D_MODEL), 1.0),
        'c_prompt': nrm(ks[2], (BATCH, D_MODEL), 1.0),
        'c_sample': nrm(ks[3], (DEC_BATCH, D_MODEL), 1.0),
        'cache_k': nrm(ks[4], (DEPTH, DEC_BATCH, PAST_LEN, KV_HEADS, HEAD_DIM), 1.0),
        'cache_v': nrm(ks[5], (DEPTH, DEC_BATCH, PAST_LEN, KV_HEADS, HEAD_DIM), 1.0),
        'cache_idx_k': nrm(ks[6], (DEPTH, DEC_BATCH, PAST_LEN, IDX_DIM), 1.0),
        'state_gdn': nrm(ks[7], (DEPTH, DEC_BATCH, GDN_HEADS, GDN_DK, GDN_DV), 0.1),
        'state_conv': nrm(ks[8], (DEPTH, DEC_BATCH, CONV_W - 1, CONV_CH), 1.0),
        'norm_w': 1.0 + nrm(ks[9], (DEPTH, D_MODEL), 0.02),
        'w_ada': nrm(ks[10], (DEPTH, D_MODEL, 3 * D_MODEL), 0.5 * D_MODEL ** -0.5),
        'b_ada': nrm(ks[11], (DEPTH, 3 * D_MODEL), 0.02),
        'w_in': nrm(ks[12], (DEPTH, D_MODEL, IN_DIM), D_MODEL ** -0.5),
        'w_conv': nrm(ks[13], (DEPTH, CONV_W, CONV_CH), CONV_W ** -0.5),
        'a_log': jnp.log(jax.random.uniform(ks[14], (DEPTH, GDN_HEADS), f32, 1.0, 16.0)),
        'dt_bias': dt + jnp.log(-jnp.expm1(-dt)),
        'gdn_norm_w': 1.0 + nrm(ks[16], (DEPTH, GDN_DV), 0.02),
        'w_branch_a': nrm(ks[17], (DEPTH, GDN_WIDTH, D_MODEL), GDN_WIDTH ** -0.5),
        'w_branch_b': nrm(ks[18], (DEPTH, ATT_WIDTH, D_MODEL), ATT_WIDTH ** -0.5),
        'w_out': nrm(ks[19], (DEPTH, D_MODEL, D_MODEL), D_MODEL ** -0.5),
        'rel_bias': nrm(ks[20], (REL_BUCKETS, ATT_HEADS), 0.5),
        'final_norm_w': 1.0 + nrm(ks[21], (D_MODEL,), 0.02),
    }


def reference(x_prompt, x_sample, c_prompt, c_sample, cache_k, cache_v, cache_idx_k, state_gdn, state_conv,
              norm_w, w_ada, b_ada, w_in, w_conv, a_log, dt_bias, gdn_norm_w, w_branch_a, w_branch_b,
              w_out, rel_bias, final_norm_w):
    xp, xs = x_prompt, x_sample
    new_p, new_s = [], []
    for l in range(DEPTH):
        lw = (norm_w[l], w_ada[l], b_ada[l], w_in[l], w_conv[l], a_log[l], dt_bias[l], gdn_norm_w[l],
              w_branch_a[l], w_branch_b[l], w_out[l], rel_bias)
        Bp = xp.shape[0]
        conv0 = jnp.zeros((Bp, CONV_W - 1, CONV_CH), xp.dtype)
        S0 = jnp.zeros((Bp, GDN_HEADS, GDN_DK, GDN_DV), jnp.float32)
        xp, sp = trunk_layer(xp, c_prompt, conv0, S0, None, *lw)
        xs, ss = trunk_layer(xs, c_sample, state_conv[l], state_gdn[l],
                             (cache_k[l], cache_v[l], cache_idx_k[l]), *lw)
        new_p.append(sp)
        new_s.append(ss)
    y_prompt = rmsnorm(xp, final_norm_w)
    y_sample = rmsnorm(xs, final_norm_w)
    new_k_prompt = jnp.stack([s[0] for s in new_p])
    new_v_prompt = jnp.stack([s[1] for s in new_p])
    new_idx_k_prompt = jnp.stack([s[2] for s in new_p])
    new_gdn_prompt = jnp.stack([s[3] for s in new_p])
    new_conv_prompt = jnp.stack([s[4] for s in new_p])
    new_k_sample = jnp.stack([s[0] for s in new_s])
    new_v_sample = jnp.stack([s[1] for s in new_s])
    new_idx_k_sample = jnp.stack([s[2] for s in new_s])
    new_gdn_sample = jnp.stack([s[3] for s in new_s])
    new_conv_sample = jnp.stack([s[4] for s in new_s])
    return (y_prompt, y_sample, new_k_prompt, new_v_prompt, new_idx_k_prompt, new_gdn_prompt, new_conv_prompt,
            new_k_sample, new_v_sample, new_idx_k_sample, new_gdn_sample, new_conv_sample)
```

```cpp
#include <hip/hip_runtime.h>
#include <cstdio>
#include <cstdint>

#ifndef MK_ONE_LAUNCH
#define MK_ONE_LAUNCH 0
#endif

#define LAS __attribute__((address_space(3)))
typedef _Float16 f16;
typedef _Float16 h8 __attribute__((ext_vector_type(8)));
typedef _Float16 h4 __attribute__((ext_vector_type(4)));
typedef _Float16 h2 __attribute__((ext_vector_type(2)));
typedef float f32x4 __attribute__((ext_vector_type(4)));
typedef float f32x2 __attribute__((ext_vector_type(2)));
typedef unsigned u32x4 __attribute__((ext_vector_type(4)));
typedef unsigned u32x2 __attribute__((ext_vector_type(2)));
#define DI __device__ __forceinline__

constexpr int D = 2048, NTOKP = 32768, NTOKS = 1024, NTOK = NTOKP + NTOKS;
constexpr int IN_DIM = 18032, NP = 18176, PS = 17408;
constexpr int LSMP = 4160, PAST = 4096;
constexpr int NSLAB = 4, NWAVES = 8, NTHR = 512;
constexpr int C_QKV = 0, C_ZA = 6144, C_QB = 8192, C_ZB = 10240, C_QI = 12288, C_GA = 13312, C_GB = 15360;
constexpr float EPS = 1e-6f;
constexpr int NPOS = 16 * 2048 + 16 * LSMP;

constexpr size_t O_YP = 0, O_YS = O_YP + (size_t)NTOKP * D, O_NKP = O_YS + (size_t)NTOKS * D, O_NVP = O_NKP + (size_t)2 * 16 * 2048 * 256,
    O_NIP = O_NVP + (size_t)2 * 16 * 2048 * 256, O_NGP = O_NIP + (size_t)2 * 16 * 2048 * 64, O_NCP = O_NGP + (size_t)2 * 16 * 16 * 16384,
    O_NKS = O_NCP + (size_t)2 * 16 * 3 * 6144, O_NVS = O_NKS + (size_t)2 * 16 * 64 * 256, O_NIS = O_NVS + (size_t)2 * 16 * 64 * 256,
    O_NGS = O_NIS + (size_t)2 * 16 * 64 * 64, O_NCS = O_NGS + (size_t)2 * 16 * 16 * 16384, O_END = O_NCS + (size_t)2 * 16 * 3 * 6144;
static_assert(O_END == 126091264ull, "output size");

constexpr size_t al256(size_t x) { return (x + 255) & ~(size_t)255; }
constexpr size_t WS_CTL = 0, CTL_BYTES = 1u << 20;
constexpr size_t WS_ADA = WS_CTL + CTL_BYTES;
constexpr size_t WS_WIN = al256(WS_ADA + (size_t)2 * 32 * 6144 * 4);
constexpr size_t WS_WA = al256(WS_WIN + (size_t)2 * NP * 2048 * 2);
constexpr size_t WS_WB = al256(WS_WA + (size_t)2 * 2048 * 2048 * 2);
constexpr size_t WS_WO = al256(WS_WB + (size_t)2 * 2048 * 2048 * 2);
constexpr size_t WS_H = al256(WS_WO + (size_t)2 * 2048 * 2048 * 2);
constexpr size_t WS_PROJ = al256(WS_H + (size_t)9216 * 2048 * 2);
constexpr size_t WS_OA = al256(WS_PROJ + (size_t)9216 * PS * 2);
constexpr size_t WS_OB = al256(WS_OA + (size_t)9216 * 2048 * 2);
constexpr size_t WS_KU = al256(WS_OB + (size_t)9216 * 2048 * 2);
constexpr size_t WS_VU = al256(WS_KU + (size_t)NPOS * 256 * 2);
constexpr size_t WS_KIU = al256(WS_VU + (size_t)NPOS * 256 * 2);
constexpr size_t WS_WI = al256(WS_KIU + (size_t)NPOS * 64 * 2);
constexpr size_t WS_BETA = al256(WS_WI + (size_t)NTOK * 16 * 4);
constexpr size_t WS_G = al256(WS_BETA + (size_t)NTOK * 16 * 4);
constexpr size_t WS_END = al256(WS_G + (size_t)NTOK * 16 * 4);

constexpr int LDS_BYTES = 147456, LDS_MISC = 131072;

#define XB_TMO      128
#define XB_XCNT(j)  (256  + 64 * (j))
#define XB_XSUB(j)  (1280 + 64 * (j))
#define XB_XGEN(j)  (2304 + 64 * (j))
#define XB_TOP      3328
#define XB_TOPGEN   3392
#define XCD_BAR_WORDS 3456
#define XB_SPIN_CAP (1u << 18)
__device__ __forceinline__ unsigned xb_ld(unsigned* p)              { return __hip_atomic_load(p, __ATOMIC_RELAXED, __HIP_MEMORY_SCOPE_AGENT); }
__device__ __forceinline__ unsigned xb_add(unsigned* p, unsigned v) { return __hip_atomic_fetch_add(p, v, __ATOMIC_RELAXED, __HIP_MEMORY_SCOPE_AGENT); }
__device__ __forceinline__ unsigned xb_xcc_id() { return (unsigned)__builtin_amdgcn_s_getreg((3 << 11) | 20) & 0xFu; }
#define XB_SPIN(cond, bar) do { unsigned _sp = 0; while (cond) { __builtin_amdgcn_s_sleep(1); \
    if ((++_sp & 255u) == 0u) { if (xb_ld(&(bar)[XB_TMO])) break; if (_sp > XB_SPIN_CAP) { atomicAdd(&(bar)[XB_TMO], 1u); break; } } } } while (0)
struct XcdBarrier { unsigned* bar; unsigned x; volatile LAS unsigned* st; };
__device__ __forceinline__ XcdBarrier xcd_barrier_post(unsigned* bar, volatile LAS unsigned* st) {
    XcdBarrier b; b.bar = bar; b.x = xb_xcc_id(); b.st = st;
    if (threadIdx.x == 0) (void)xb_add(&bar[XB_XCNT(b.x)], 1u);
    return b;
}
__device__ __forceinline__ void xcd_barrier_complete(unsigned* bar, unsigned x, unsigned& nloc, unsigned& nx) {
    const unsigned G = gridDim.x * gridDim.y * gridDim.z;
    unsigned sum, cnt, mine, sp = 0u;
    for (;;) {
        sum = 0u; cnt = 0u; mine = 0u;
#pragma unroll
        for (unsigned j = 0; j < 16; ++j) { const unsigned c = xb_ld(&bar[XB_XCNT(j)]); sum += c; cnt += (c > 0u) ? 1u : 0u; mine = (j == x) ? c : mine; }
        if (sum == G) break;
        __builtin_amdgcn_s_sleep(1);
        if ((++sp & 255u) == 0u) { if (xb_ld(&bar[XB_TMO])) break; if (sp > XB_SPIN_CAP) { atomicAdd(&bar[XB_TMO], 1u); break; } }
    }
    nloc = mine > 0u ? mine : 1u; nx = cnt > 0u ? cnt : 1u;
}
__device__ __noinline__ void xcd_barrier(const XcdBarrier b) {
    asm volatile("s_waitcnt vmcnt(0)" ::: "memory");
    __syncthreads();
    if (threadIdx.x == 0) {
        unsigned* bar = b.bar;
        __builtin_amdgcn_s_waitcnt(0);
        unsigned nloc = b.st[0], nx = b.st[1];
        if (nloc == 0u) { xcd_barrier_complete(bar, b.x, nloc, nx); b.st[0] = nloc; b.st[1] = nx; }
        const unsigned old = xb_add(&bar[XB_XSUB(b.x)], 1u);
        const unsigned gen = old / nloc;
        if (old + 1u == (gen + 1u) * nloc) {
            __builtin_amdgcn_fence(__ATOMIC_RELEASE, "agent");
            asm volatile("s_waitcnt vmcnt(0)" ::: "memory");
            const unsigned og = xb_add(&bar[XB_TOP], 1u);
            const unsigned tg = og / nx;
            if (og + 1u == (tg + 1u) * nx) xb_add(&bar[XB_TOPGEN], 1u);
            else XB_SPIN(xb_ld(&bar[XB_TOPGEN]) == tg, bar);
            __builtin_amdgcn_fence(__ATOMIC_ACQUIRE, "agent");
            xb_add(&bar[XB_XGEN(b.x)], 1u);
            asm volatile("s_waitcnt vmcnt(0)" ::: "memory");
        } else {
            XB_SPIN(xb_ld(&bar[XB_XGEN(b.x)]) == gen, bar);
            __builtin_amdgcn_fence(__ATOMIC_ACQUIRE, "agent");
            asm volatile("s_waitcnt vmcnt(0)" ::: "memory");
        }
    }
    __syncthreads();
}

DI float wave_sum(float v) {
#pragma unroll
    for (int o = 32; o > 0; o >>= 1) v += __shfl_xor(v, o);
    return v;
}
DI float sigmoidf_(float x) { return 1.0f / (1.0f + __expf(-x)); }
DI float siluf_(float x) { return x / (1.0f + __expf(-x)); }
DI unsigned pk_f16(float lo, float hi) { h2 v = {(f16)lo, (f16)hi}; return __builtin_bit_cast(unsigned, v); }
DI void rowinfo(int slab, int rs, int& R, int& sq, int& t) {
    if (rs < 8192) { R = slab * 8192 + rs; sq = R >> 11; t = R & 2047; }
    else { const int q = rs - 8192; R = NTOKP + q; sq = 16 + (q >> 6); t = q & 63; }
}
DI int posbase(int sq) { return sq < 16 ? sq * 2048 : 32768 + (sq - 16) * LSMP; }
__host__ __device__ inline int ts_of(int slab) { return slab == 0 ? 9216 : 8192; }
DI int proj_src_col(int n) {
    if (n < 8192) return n;
    if (n < 10240) return 8224 + (n - 8192);
    if (n < 12288) return 10784 + (n - 10240);
    if (n < 13312) return 12832 + (n - 12288);
    if (n < 15360) return 13936 + (n - 13312);
    if (n < 17408) return 15984 + (n - 15360);
    if (n < 17664) return 10272 + (n - 17408);
    if (n < 17920) return 10528 + (n - 17664);
    const int j = n - 17920;
    if (j < 64) return 13856 + j;
    if (j < 80) return 13920 + (j - 64);
    if (j < 96) return 8192 + (j - 80);
    if (j < 112) return 8208 + (j - 96);
    return -1;
}
DI int rel_bucket(int rel) {
    const int n = rel < 0 ? -rel : rel;
    const int v = n < 8 ? n : (n < 12 ? 8 : n < 16 ? 9 : n < 23 ? 10 : n < 32 ? 11 : n < 46 ? 12 : n < 64 ? 13 : n < 91 ? 14 : 15);
    return (rel > 0 ? 16 : 0) + v;
}

namespace pg8 {
constexpr int BM = 256, BK = 64, HALF = 128, HTB = HALF * BK * 2, STAGE_BYTES = 8 * HTB, NXCD = 8, WGM = 8;
DI int lds_byte(int r, int c) { const int st = (r >> 4) * 2 + (c >> 5), rr = r & 15, cc = c & 31, ob = rr * 64 + cc * 2; return st * 1024 + (ob ^ (((ob >> 9) & 1) << 5)); }
DI void stage_rc(int b, int& R, int& C) { const int st = b / 1024, sb = b % 1024, swz = sb ^ (((sb >> 9) & 1) << 5); R = (st >> 1) * 16 + swz / 64; C = (st & 1) * 32 + (swz % 64) / 2; }
DI int perm32(int rho) { const int n = rho >> 4, i = rho & 15; return 8 * (i >> 2) + 4 * n + (i & 3); }

struct Unit { int pm, pn, which; };
struct Gemm { const f16* A0; const f16* B0; const f16* A1; const f16* B1; int M, N, K; };

struct StaticOrder {
    int nM, nN, nwg, G, c;
    DI void init(int M, int N, int G_, int c_) { nM = M / BM; nN = N / BM; nwg = nM * nN; G = G_; c = c_; }
    DI bool tile(long L, Unit& u) const {
        if (L >= nwg) return false;
        int wgid = (int)L; { const int q = nwg / NXCD, r = nwg % NXCD, xcd = wgid % NXCD, off = wgid / NXCD; wgid = (xcd < r ? xcd * (q + 1) : r * (q + 1) + (xcd - r) * q) + off; }
        const int nig = WGM * nN, gid = wgid / nig, fm = gid * WGM, gsz = (nM - fm) < WGM ? (nM - fm) : WGM;
        u.pm = fm + ((wgid % nig) % gsz); u.pn = (wgid % nig) / gsz; return true;
    }
    DI bool next(int i, Unit& u) const { u.which = 0; return tile((long)i * G + c, u); }
};
struct DualOrder : StaticOrder {
    DI bool next(int i, Unit& u) const { u.which = i & 1; return tile((long)(i >> 1) * G + c, u); }
};

template <class Epi, class Sched, bool ALIGN_EPI = true>
DI void gemm_phase(LAS unsigned char* lds, const Gemm g, const Sched& S, const Epi& E) {
    int tid_ = threadIdx.x; asm volatile("" : "+v"(tid_));
    const int tid = tid_, wid = __builtin_amdgcn_readfirstlane(tid >> 6), lane = tid & 63, wr = wid >> 2, wc = wid & 3, fr = lane & 15, fq = lane >> 4;
    const int K = g.K, nt = K / BK;
    unsigned voffA[2], voffB[2];
#pragma unroll
    for (int i = 0; i < 2; ++i) { int R, C; stage_rc(tid * 16 + i * 8192, R, C); const int Rb = (R & ~31) + perm32(R & 31);
        voffA[i] = (unsigned)(R * K + C) * 2u; voffB[i] = (unsigned)(Rb * K + C) * 2u; }
    const size_t kstep = (size_t)(BK * 2);
    const size_t hstep = (size_t)HALF * K * 2;
    const size_t tstep = 2 * hstep;
    const unsigned ldsw = (unsigned)wid * 1024u;
    const int aoff = lds_byte(wr * 64 + fr, fq * 8), boff = lds_byte(wc * 32 + fr, fq * 8);
#define PG8_SA(b, h) (((b) * 2 + (h)) * HTB)
#define PG8_SB(b, h) ((4 + (b) * 2 + (h)) * HTB)
#define PG8_STAGE(bufoff, gbase, voff) do { _Pragma("unroll") for (int _i = 0; _i < 2; ++_i) \
        __builtin_amdgcn_global_load_lds((const unsigned*)((const char*)(gbase) + (voff)[_i]), (LAS unsigned*)(lds + (bufoff) + ldsw + _i * 8192), 16, 0, 0); } while (0)
#define PG8_LDA(dst, b, h) do { _Pragma("unroll") for (int m = 0; m < 4; ++m) _Pragma("unroll") for (int k = 0; k < 2; ++k) dst[m][k] = *(const LAS h8*)(lds + PG8_SA(b, h) + aoff + m * 2048 + k * 1024); } while (0)
#define PG8_LDB(dst, b, h) do { _Pragma("unroll") for (int n = 0; n < 2; ++n) _Pragma("unroll") for (int k = 0; k < 2; ++k) dst[n][k] = *(const LAS h8*)(lds + PG8_SB(b, h) + boff + n * 2048 + k * 1024); } while (0)
#define PG8_MMA(ai, bj, At, Bt) do { __builtin_amdgcn_s_setprio(1); _Pragma("unroll") for (int m = 0; m < 4; ++m) _Pragma("unroll") for (int n = 0; n < 2; ++n) _Pragma("unroll") for (int k = 0; k < 2; ++k) \
        acc[ai][bj][m][n] = __builtin_amdgcn_mfma_f32_16x16x32_f16(Bt[n][k], At[m][k], acc[ai][bj][m][n], 0, 0, 0); __builtin_amdgcn_s_setprio(0); } while (0)
#define PG8_WAIT_V(n) asm volatile("s_waitcnt vmcnt(" #n ")" ::: "memory")
#define PG8_WAIT_L(n) asm volatile("s_waitcnt lgkmcnt(" #n ")" ::: "memory")
#define PG8_BAR __builtin_amdgcn_s_barrier()
#define PG8_SCHED __builtin_amdgcn_sched_barrier(0)
    Unit cur, nxt; int ui = 0;
    if (!S.next(0, cur)) return;
    f32x4 acc[2][2][4][2];
#pragma unroll
    for (int a = 0; a < 2; ++a)
#pragma unroll
        for (int b = 0; b < 2; ++b)
#pragma unroll
            for (int m = 0; m < 4; ++m)
#pragma unroll
                for (int n = 0; n < 2; ++n) acc[a][b][m][n] = (f32x4){0.f, 0.f, 0.f, 0.f};
    h8 At[4][2], B0[2][2], B1[2][2];
    const char* cA = (const char*)(cur.which ? g.A1 : g.A0) + (size_t)cur.pm * tstep; const char* cB = (const char*)(cur.which ? g.B1 : g.B0) + (size_t)cur.pn * tstep;
    PG8_STAGE(PG8_SB(0, 0), cB, voffB); PG8_STAGE(PG8_SB(0, 1), cB + hstep, voffB); PG8_STAGE(PG8_SA(0, 0), cA, voffA); PG8_STAGE(PG8_SA(0, 1), cA + hstep, voffA);
    if (wr == 1) PG8_BAR;
    PG8_WAIT_V(2); PG8_BAR;
    PG8_STAGE(PG8_SB(1, 0), cB + kstep, voffB); PG8_STAGE(PG8_SA(1, 0), cA + kstep, voffA); PG8_STAGE(PG8_SB(1, 1), cB + hstep + kstep, voffB);
    PG8_WAIT_V(6); PG8_BAR;
    for (;;) {
        const bool has_next = S.next(ui + 1, nxt);
        const char* nA = has_next ? (const char*)(nxt.which ? g.A1 : g.A0) + (size_t)nxt.pm * tstep : cA; const char* nB = has_next ? (const char*)(nxt.which ? g.B1 : g.B0) + (size_t)nxt.pn * tstep : cB;
        for (int t = 0; t < nt; t += 2) {
            const bool last = (t == nt - 2);
            const char* a1 = cA + (size_t)(t + 1) * kstep;
            const char* a2 = last ? nA : cA + (size_t)(t + 2) * kstep; const char* b2 = last ? nB : cB + (size_t)(t + 2) * kstep;
            const char* a3 = a2 + kstep; const char* b3 = b2 + kstep;
            PG8_LDB(B0, 0, 0); PG8_LDB(B1, 0, 1); PG8_SCHED; PG8_LDA(At, 0, 0); PG8_STAGE(PG8_SA(1, 1), a1 + hstep, voffA);
            PG8_WAIT_V(8); PG8_WAIT_L(0); PG8_BAR; PG8_MMA(0, 0, At, B0); PG8_MMA(0, 1, At, B1); PG8_BAR; PG8_SCHED;
            PG8_LDA(At, 0, 1); PG8_STAGE(PG8_SB(0, 0), b2, voffB); PG8_STAGE(PG8_SB(0, 1), b2 + hstep, voffB); PG8_STAGE(PG8_SA(0, 0), a2, voffA);
            PG8_WAIT_V(8); PG8_WAIT_L(0); PG8_BAR; PG8_MMA(1, 0, At, B0); PG8_MMA(1, 1, At, B1); PG8_BAR; PG8_SCHED;
            PG8_LDB(B0, 1, 0); PG8_LDB(B1, 1, 1); PG8_SCHED; PG8_LDA(At, 1, 0); PG8_STAGE(PG8_SA(0, 1), a2 + hstep, voffA);
            PG8_WAIT_V(8); PG8_WAIT_L(0); PG8_BAR; PG8_MMA(0, 0, At, B0); PG8_MMA(0, 1, At, B1); PG8_BAR; PG8_SCHED;
            PG8_LDA(At, 1, 1); PG8_STAGE(PG8_SB(1, 0), b3, voffB); PG8_STAGE(PG8_SB(1, 1), b3 + hstep, voffB); PG8_STAGE(PG8_SA(1, 0), a3, voffA);
            PG8_WAIT_V(8); PG8_WAIT_L(0); PG8_BAR; PG8_MMA(1, 0, At, B0); PG8_MMA(1, 1, At, B1); PG8_BAR; PG8_SCHED;
        }
        if constexpr (ALIGN_EPI) { if (wr == 0) PG8_BAR; }
        E(acc, cur, wr, wc, fr, fq);
        if (!has_next) break;
#pragma unroll
        for (int a = 0; a < 2; ++a)
#pragma unroll
            for (int b = 0; b < 2; ++b)
#pragma unroll
                for (int m = 0; m < 4; ++m)
#pragma unroll
                    for (int n = 0; n < 2; ++n) acc[a][b][m][n] = (f32x4){0.f, 0.f, 0.f, 0.f};
        cur = nxt; cA = nA; cB = nB; ++ui;
        if constexpr (ALIGN_EPI) { if (wr == 1) PG8_BAR; }
    }
    PG8_WAIT_V(0);
    if constexpr (!ALIGN_EPI) { if (wr == 0) PG8_BAR; }
    PG8_BAR;
#undef PG8_SA
#undef PG8_SB
#undef PG8_STAGE
#undef PG8_LDA
#undef PG8_LDB
#undef PG8_MMA
#undef PG8_WAIT_V
#undef PG8_WAIT_L
#undef PG8_BAR
#undef PG8_SCHED
}
}

struct Args { const float* in[22]; float* out; unsigned char* ws; int ph_lo, ph_hi; };
constexpr int LDS_TAB = LDS_MISC + 256;
DI unsigned long long ldtab(LAS unsigned char* lds, int i) {
    const unsigned vx = *(const volatile LAS unsigned*)(lds + LDS_TAB + 8 * i), vy = *(const volatile LAS unsigned*)(lds + LDS_TAB + 8 * i + 4); u32x2 v; v.x = vx; v.y = vy;
    return ((unsigned long long)(unsigned)__builtin_amdgcn_readfirstlane((int)v.y) << 32) | (unsigned)__builtin_amdgcn_readfirstlane((int)v.x);
}
struct Frame {
    LAS unsigned char* lds; int tid, lane, wave, G, bid;
    DI Frame fresh() const { Frame f = *this; int t = threadIdx.x; asm volatile("" : "+v"(t)); f.tid = t; f.lane = t & 63; f.wave = __builtin_amdgcn_readfirstlane(t >> 6); return f; }
    DI const float* in(int i) const { return (const float*)ldtab(lds, i); }
    DI float* out() const { return (float*)ldtab(lds, 22); }
    DI unsigned char* ws() const { return (unsigned char*)ldtab(lds, 23); }
    DI unsigned* ctl() const { return (unsigned*)(ws() + WS_CTL); }
    DI float* ADA() const { return (float*)(ws() + WS_ADA); }
    DI f16* WIN() const { return (f16*)(ws() + WS_WIN); }
    DI f16* WA() const { return (f16*)(ws() + WS_WA); }
    DI f16* WB() const { return (f16*)(ws() + WS_WB); }
    DI f16* WO() const { return (f16*)(ws() + WS_WO); }
    DI f16* H() const { return (f16*)(ws() + WS_H); }
    DI f16* PROJ() const { return (f16*)(ws() + WS_PROJ); }
    DI f16* OA() const { return (f16*)(ws() + WS_OA); }
    DI f16* OB() const { return (f16*)(ws() + WS_OB); }
    DI f16* KU() const { return (f16*)(ws() + WS_KU); }
    DI f16* VU() const { return (f16*)(ws() + WS_VU); }
    DI f16* KIU() const { return (f16*)(ws() + WS_KIU); }
    DI float* WI() const { return (float*)(ws() + WS_WI); }
    DI float* BETA() const { return (float*)(ws() + WS_BETA); }
    DI float* GG() const { return (float*)(ws() + WS_G); }
};
enum { I_XP = 0, I_XS, I_CP, I_CS, I_CK, I_CV, I_CIK, I_SG, I_SC, I_NW, I_WADA, I_BADA, I_WIN, I_WCONV, I_ALOG, I_DTB, I_GNW, I_WBA, I_WBB, I_WOUT, I_RELB, I_FNW };
constexpr int CW_BAR = 0, CW_Q = 4096;

struct EpiProj {
    static constexpr bool PERM = true;
    f16* proj; float* out; f16 *KU, *VU, *KIU; float *WI, *BETA, *GG; const float *a_log, *dt_bias; int layer, slab;
    DI void operator()(const f32x4 (&acc)[2][2][4][2], const pg8::Unit& u, int wr, int wc, int fr_, int fq_) const {
        int fr = fr_, fq = fq_; asm volatile("" : "+v"(fr), "+v"(fq));
        const int pn = u.pn;
        const int rsb = u.pm * 256 + wr * 64 + fr;
        if (pn < 68) {
            const int act = ((pn >= 24 && pn < 32) || (pn >= 40 && pn < 48)) ? 1 : (pn >= 52 ? 2 : 0);
            const int col0 = pn * 256 + wc * 32 + 8 * fq;
#pragma unroll
            for (int ai = 0; ai < 2; ++ai)
#pragma unroll
                for (int m = 0; m < 4; ++m) {
                    f16* rowp = proj + (size_t)(rsb + ai * 128 + m * 16) * PS + col0;
#pragma unroll
                    for (int bj = 0; bj < 2; ++bj) {
                        f32x4 v0 = acc[ai][bj][m][0], v1 = acc[ai][bj][m][1];
                        if (act == 1) {
#pragma unroll
                            for (int j = 0; j < 4; ++j) { v0[j] = siluf_(v0[j]); v1[j] = siluf_(v1[j]); }
                        } else if (act == 2) {
#pragma unroll
                            for (int j = 0; j < 4; ++j) { v0[j] = sigmoidf_(v0[j]); v1[j] = sigmoidf_(v1[j]); }
                        }
                        u32x4 w; w.x = pk_f16(v0[0], v0[1]); w.y = pk_f16(v0[2], v0[3]); w.z = pk_f16(v1[0], v1[1]); w.w = pk_f16(v1[2], v1[3]);
                        *(u32x4*)(rowp + bj * 128) = w;
                    }
                }
            if (pn < 24 && fr >= 13) {
                const bool smp = u.pm >= 32;
                if (smp || (u.pm & 7) == 7) {
#pragma unroll
                    for (int ai = 0; ai < 2; ++ai) {
                        if (!smp && !(ai == 1 && wr == 1)) continue;
                        int R, sq, t; rowinfo(slab, rsb + ai * 128 + 48, R, sq, t);
                        const int T = smp ? 64 : 2048;
                        float* base = out + (smp ? O_NCS : O_NCP) + ((size_t)(layer * 16 + (sq & 15)) * 3 + (t - (T - 3))) * 6144 + col0;
#pragma unroll
                        for (int bj = 0; bj < 2; ++bj) { *(f32x4*)(base + bj * 128) = acc[ai][bj][3][0]; *(f32x4*)(base + bj * 128 + 4) = acc[ai][bj][3][1]; }
                    }
                }
            }
        } else {
#pragma unroll
            for (int ai = 0; ai < 2; ++ai)
#pragma unroll
                for (int m = 0; m < 4; ++m) {
                    int R, sq, t; rowinfo(slab, rsb + ai * 128 + m * 16, R, sq, t);
                    const bool smp = sq >= 16; const int b = sq & 15;
                    const size_t pos = (size_t)posbase(sq) + (smp ? PAST : 0) + t;
#pragma unroll
                    for (int bj = 0; bj < 2; ++bj) {
                        const int c = bj * 128 + wc * 32 + 8 * fq;
                        const f32x4 v0 = acc[ai][bj][m][0], v1 = acc[ai][bj][m][1];
                        if (pn < 70) {
                            float* o = out + (pn == 68 ? (smp ? O_NKS : O_NKP) : (smp ? O_NVS : O_NVP)) + ((size_t)(layer * 16 + b) * (smp ? 64 : 2048) + t) * 256 + c;
                            *(f32x4*)o = v0; *(f32x4*)(o + 4) = v1;
                            u32x4 w; w.x = pk_f16(v0[0], v0[1]); w.y = pk_f16(v0[2], v0[3]); w.z = pk_f16(v1[0], v1[1]); w.w = pk_f16(v1[2], v1[3]);
                            *(u32x4*)((pn == 68 ? KU : VU) + pos * 256 + c) = w;
                        } else if (c < 64) {
                            float* o = out + (smp ? O_NIS : O_NIP) + ((size_t)(layer * 16 + b) * (smp ? 64 : 2048) + t) * 64 + c;
                            *(f32x4*)o = v0; *(f32x4*)(o + 4) = v1;
                            u32x4 w; w.x = pk_f16(v0[0], v0[1]); w.y = pk_f16(v0[2], v0[3]); w.z = pk_f16(v1[0], v1[1]); w.w = pk_f16(v1[2], v1[3]);
                            *(u32x4*)(KIU + pos * 64 + c) = w;
                        } else if (c < 80) {
                            float* o = WI + (size_t)R * 16 + (c - 64);
                            *(f32x4*)o = v0 * 0.03125f; *(f32x4*)(o + 4) = v1 * 0.03125f;
                        } else if (c < 96) {
                            float* o = BETA + (size_t)R * 16 + (c - 80);
                            f32x4 a, bb;
#pragma unroll
                            for (int j = 0; j < 4; ++j) { a[j] = sigmoidf_(v0[j]); bb[j] = sigmoidf_(v1[j]); }
                            *(f32x4*)o = a; *(f32x4*)(o + 4) = bb;
                        } else if (c < 112) {
                            float* o = GG + (size_t)R * 16 + (c - 96);
                            f32x4 a, bb;
#pragma unroll
                            for (int j = 0; j < 4; ++j) {
                                const int h0 = (c - 96) + j, h1 = h0 + 4;
                                const float x0 = v0[j] + dt_bias[h0], x1 = v1[j] + dt_bias[h1];
                                const float s0 = x0 > 20.f ? x0 : log1pf(__expf(x0)), s1 = x1 > 20.f ? x1 : log1pf(__expf(x1));
                                a[j] = -__expf(a_log[h0]) * s0; bb[j] = -__expf(a_log[h1]) * s1;
                            }
                            *(f32x4*)o = a; *(f32x4*)(o + 4) = bb;
                        }
                    }
                }
        }
    }
};
struct EpiAB {
    static constexpr bool PERM = true;
    const f16* proj; f16* mg;
    DI void operator()(const f32x4 (&acc)[2][2][4][2], const pg8::Unit& u, int wr, int wc, int fr_, int fq_) const {
        int fr = fr_, fq = fq_; asm volatile("" : "+v"(fr), "+v"(fq));
        const int rsb = u.pm * 256 + wr * 64 + fr, col0 = u.pn * 256 + wc * 32 + 8 * fq;
        const int gc = (u.which ? C_GB : C_GA) + col0;
#pragma unroll
        for (int ai = 0; ai < 2; ++ai)
#pragma unroll
            for (int m = 0; m < 4; ++m) {
                const size_t rs = (size_t)(rsb + ai * 128 + m * 16);
#pragma unroll
                for (int bj = 0; bj < 2; ++bj) {
                    const h8 gt = *(const h8*)(proj + rs * PS + gc + bj * 128);
                    f16* mp = mg + rs * 2048 + col0 + bj * 128;
                    float r[8];
#pragma unroll
                    for (int j = 0; j < 4; ++j) { r[j] = (float)gt[j] * acc[ai][bj][m][0][j]; r[4 + j] = (float)gt[4 + j] * acc[ai][bj][m][1][j]; }
                    if (u.which) { const h8 pv = *(const h8*)mp;
#pragma unroll
                        for (int j = 0; j < 8; ++j) r[j] += (float)pv[j]; }
                    u32x4 w; w.x = pk_f16(r[0], r[1]); w.y = pk_f16(r[2], r[3]); w.z = pk_f16(r[4], r[5]); w.w = pk_f16(r[6], r[7]);
                    *(u32x4*)mp = w;
                }
            }
    }
};
struct EpiOut {
    static constexpr bool PERM = true;
    const float* xp; const float* xs; float* out; const float* ada; int layer, slab;
    DI void operator()(const f32x4 (&acc)[2][2][4][2], const pg8::Unit& u, int wr, int wc, int fr_, int fq_) const {
        int fr = fr_, fq = fq_; asm volatile("" : "+v"(fr), "+v"(fq));
        const int rsb = u.pm * 256 + wr * 64 + fr, col0 = u.pn * 256 + wc * 32 + 8 * fq;
#pragma unroll
        for (int ai = 0; ai < 2; ++ai)
#pragma unroll
            for (int m = 0; m < 4; ++m) {
                int R, sq, t; rowinfo(slab, rsb + ai * 128 + m * 16, R, sq, t);
                const float* xo = layer == 0 ? (R < NTOKP ? xp + (size_t)R * D : xs + (size_t)(R - NTOKP) * D) : out + (size_t)R * D;
                const float* gp = ada + (size_t)sq * 6144 + 4096;
                float* yo = out + (size_t)R * D;
#pragma unroll
                for (int bj = 0; bj < 2; ++bj) {
                    const int c = col0 + bj * 128;
                    const f32x4 x0 = *(const f32x4*)(xo + c), x1 = *(const f32x4*)(xo + c + 4), g0 = *(const f32x4*)(gp + c), g1 = *(const f32x4*)(gp + c + 4);
                    *(f32x4*)(yo + c) = x0 + g0 * acc[ai][bj][m][0]; *(f32x4*)(yo + c + 4) = x1 + g1 * acc[ai][bj][m][1];
                }
            }
    }
};

DI void p0_prologue(const Frame F0) {
    const Frame F = F0.fresh();
    LAS float* tile = (LAS float*)F.lds;
    const int tid = F.tid;
    for (int u = F.bid; u < 2 * 12160; u += F.G) {
        const int l = u / 12160; int v = u % 12160;
        const float* src; f16* dst; int ldn, nb, kb; bool isin;
        if (v < 9088) { isin = true; nb = v >> 5; kb = v & 31; src = F.in(I_WIN) + (size_t)l * 2048 * IN_DIM; ldn = IN_DIM; dst = F.WIN() + (size_t)l * NP * 2048; }
        else { v -= 9088; const int mat = v >> 10, w = v & 1023; isin = false; nb = w >> 5; kb = w & 31; src = F.in(I_WBA + mat) + (size_t)l * 2048 * 2048; ldn = 2048;
               dst = (mat == 0 ? F.WA() : mat == 1 ? F.WB() : F.WO()) + (size_t)l * 2048 * 2048; }
        {
            const int nn = tid & 63, np = nb * 64 + nn; const int o = isin ? proj_src_col(np) : np;
#pragma unroll
            for (int i = 0; i < 8; ++i) { const int kk = (tid >> 6) + 8 * i; tile[kk * 65 + nn] = o >= 0 ? src[(size_t)(kb * 64 + kk) * ldn + o] : 0.f; }
        }
        __syncthreads();
        {
            const int nn = tid >> 3, kg = tid & 7; h8 hv;
#pragma unroll
            for (int j = 0; j < 8; ++j) hv[j] = (f16)tile[(kg * 8 + j) * 65 + nn];
            *(h8*)(dst + (size_t)(nb * 64 + nn) * 2048 + kb * 64 + kg * 8) = hv;
        }
        __syncthreads();
    }
    for (int u = F.bid; u < 2 * 96; u += F.G) {
        const int l = u / 96, cb = u % 96, kg = tid >> 6, n = tid & 63;
        float acc[32];
#pragma unroll
        for (int s = 0; s < 32; ++s) acc[s] = 0.f;
        const float* W = F.in(I_WADA) + (size_t)l * 2048 * 6144 + cb * 64 + n;
        for (int kc = 0; kc < 4; ++kc) {
            for (int i = tid; i < 32 * 512; i += NTHR) { const int s = i >> 9, k = i & 511; const float c = (s < 16 ? F.in(I_CP) + s * 2048 : F.in(I_CS) + (s - 16) * 2048)[kc * 512 + k]; tile[i] = siluf_(c); }
            __syncthreads();
            for (int kk = 0; kk < 64; ++kk) { const int k = kg * 64 + kk; const float w = W[(size_t)(kc * 512 + k) * 6144];
#pragma unroll
                for (int s = 0; s < 32; ++s) acc[s] += tile[s * 512 + k] * w; }
            __syncthreads();
        }
#pragma unroll
        for (int s = 0; s < 32; ++s) tile[(kg * 32 + s) * 64 + n] = acc[s];
        __syncthreads();
        for (int o = tid; o < 2048; o += NTHR) { const int s = o >> 6, nn = o & 63; float r = F.in(I_BADA)[l * 6144 + cb * 64 + nn];
#pragma unroll
            for (int g = 0; g < 8; ++g) r += tile[(g * 32 + s) * 64 + nn];
            F.ADA()[(size_t)(l * 32 + s) * 6144 + cb * 64 + nn] = r; }
        __syncthreads();
    }
}

DI void phase_norm(const Frame F0, int l, int slab) {
    const Frame F = F0.fresh();
    const int Ts = ts_of(slab);
    const float* nw = F.in(I_NW) + l * 2048;
    for (int rs = F.bid * NWAVES + F.wave; rs < Ts; rs += F.G * NWAVES) {
        int R, sq, t; rowinfo(slab, rs, R, sq, t);
        const float* x = l == 0 ? (R < NTOKP ? F.in(I_XP) + (size_t)R * D : F.in(I_XS) + (size_t)(R - NTOKP) * D) : F.out() + (size_t)R * D;
        const float* ad = F.ADA() + (size_t)(l * 32 + sq) * 6144;
        f32x4 v[8]; float ss = 0.f;
#pragma unroll
        for (int i = 0; i < 8; ++i) { v[i] = *(const f32x4*)(x + (i * 64 + F.lane) * 4); ss += v[i][0] * v[i][0] + v[i][1] * v[i][1] + v[i][2] * v[i][2] + v[i][3] * v[i][3]; }
        ss = wave_sum(ss);
        const float r = rsqrtf(ss * (1.0f / 2048.0f) + EPS);
#pragma unroll
        for (int i = 0; i < 8; ++i) { const int c = (i * 64 + F.lane) * 4;
            const f32x4 w = *(const f32x4*)(nw + c), sh = *(const f32x4*)(ad + c), sc = *(const f32x4*)(ad + 2048 + c);
            const f32x4 hv = v[i] * r * w * (sc + 1.0f) + sh;
            u32x2 p; p.x = pk_f16(hv[0], hv[1]); p.y = pk_f16(hv[2], hv[3]);
            *(u32x2*)(F.H() + (size_t)rs * 2048 + c) = p; }
    }
    if (slab == 0) {
        const size_t gid = (size_t)F.bid * NTHR + F.tid, gsz = (size_t)F.G * NTHR;
        const size_t nk = (size_t)16 * PAST * 32;
        for (size_t g = gid; g < nk; g += gsz) {
            const size_t b = g / (PAST * 32), rem = g % (PAST * 32), p = rem >> 5, c8 = (rem & 31) * 8;
            const size_t so = (size_t)l * 16 * PAST * 256 + g * 8, dof = ((size_t)32768 + b * LSMP + p) * 256 + c8;
            { const f32x4 a = *(const f32x4*)(F.in(I_CK) + so), bb = *(const f32x4*)(F.in(I_CK) + so + 4);
              u32x4 w; w.x = pk_f16(a[0], a[1]); w.y = pk_f16(a[2], a[3]); w.z = pk_f16(bb[0], bb[1]); w.w = pk_f16(bb[2], bb[3]); *(u32x4*)(F.KU() + dof) = w; }
            { const f32x4 a = *(const f32x4*)(F.in(I_CV) + so), bb = *(const f32x4*)(F.in(I_CV) + so + 4);
              u32x4 w; w.x = pk_f16(a[0], a[1]); w.y = pk_f16(a[2], a[3]); w.z = pk_f16(bb[0], bb[1]); w.w = pk_f16(bb[2], bb[3]); *(u32x4*)(F.VU() + dof) = w; }
        }
        const size_t ni = (size_t)16 * PAST * 8;
        for (size_t g = gid; g < ni; g += gsz) {
            const size_t b = g / (PAST * 8), rem = g % (PAST * 8), p = rem >> 3, c8 = (rem & 7) * 8;
            const size_t so = (size_t)l * 16 * PAST * 64 + g * 8, dof = ((size_t)32768 + b * LSMP + p) * 64 + c8;
            const f32x4 a = *(const f32x4*)(F.in(I_CIK) + so), bb = *(const f32x4*)(F.in(I_CIK) + so + 4);
            u32x4 w; w.x = pk_f16(a[0], a[1]); w.y = pk_f16(a[2], a[3]); w.z = pk_f16(bb[0], bb[1]); w.w = pk_f16(bb[2], bb[3]); *(u32x4*)(F.KIU() + dof) = w;
        }
    }
}

DI void gdn_chain_unit(const Frame& F, int l, int slab, int sq, int hd) {
    LAS float* S = (LAS float*)F.lds;
    LAS float* vec = S + 16384;
    LAS float* red = vec + 384;
    LAS float* red2 = red + 512;
    LAS float* scal = red2 + 512;
    const int tid = F.tid, lane = F.lane, wave = F.wave;
    const bool smp = sq >= 16; const int b = sq & 15, T = smp ? 64 : 2048;
    const int rs0 = smp ? 8192 + (sq - 16) * 64 : (sq - slab * 4) * 2048;
    const int R0 = smp ? NTOKP + (sq - 16) * 64 : sq * 2048;
    int ch = 0; float w0 = 0, w1 = 0, w2 = 0, w3 = 0, x3 = 0, x2 = 0, x1 = 0;
    if (tid < 384) {
        ch = tid < 128 ? hd * 128 + tid : (tid < 256 ? 2048 + hd * 128 + (tid - 128) : 4096 + hd * 128 + (tid - 256));
        const float* wc = F.in(I_WCONV) + (size_t)l * 4 * 6144 + ch;
        w0 = wc[0]; w1 = wc[6144]; w2 = wc[2 * 6144]; w3 = wc[3 * 6144];
        if (smp) { const float* sc = F.in(I_SC) + ((size_t)(l * 16 + b) * 3) * 6144 + ch; x3 = sc[0]; x2 = sc[6144]; x1 = sc[2 * 6144]; }
    }
    {
        const float* s0 = F.in(I_SG) + ((size_t)(l * 16 + b) * 16 + hd) * 16384;
        for (int i = tid; i < 16384; i += NTHR) S[i] = smp ? s0[i] : 0.f;
    }
    const int e = tid & 127, part = tid >> 7, d0 = part * 32;
    const float gnw = F.in(I_GNW)[l * 128 + e];
    __syncthreads();
    for (int t = 0; t < T; ++t) {
        const size_t rs = (size_t)(rs0 + t);
        if (tid < 384) {
            const float xr = (float)F.PROJ()[rs * PS + ch];
            const float y = w0 * x3 + w1 * x2 + w2 * x1 + w3 * xr; x3 = x2; x2 = x1; x1 = xr;
            vec[tid] = siluf_(y);
        }
        __syncthreads();
        if (wave < 2) { const float a = vec[wave * 128 + lane], bb = vec[wave * 128 + 64 + lane]; const float s = wave_sum(a * a + bb * bb);
            if (lane == 0) scal[wave] = rsqrtf(s + EPS) * (wave == 0 ? 0.08838834764831845f : 1.0f); }
        __syncthreads();
        const float rq = scal[0], rk = scal[1];
        const float beta = F.BETA()[(size_t)(R0 + t) * 16 + hd], decay = __expf(F.GG()[(size_t)(R0 + t) * 16 + hd]);
        float partial = 0.f;
#pragma unroll 8
        for (int d = d0; d < d0 + 32; ++d) partial += vec[128 + d] * S[d * 128 + e];
        red[part * 128 + e] = partial;
        __syncthreads();
        const float kS = (red[e] + red[128 + e] + red[256 + e] + red[384 + e]) * rk;
        const float coef = beta * (vec[256 + e] - decay * kS);
        float po = 0.f;
#pragma unroll 8
        for (int d = d0; d < d0 + 32; ++d) { const float kh = vec[128 + d] * rk; const float s = decay * S[d * 128 + e] + kh * coef; S[d * 128 + e] = s; po += s * vec[d]; }
        red2[part * 128 + e] = po;
        __syncthreads();
        float o = 0.f;
        if (tid < 128) { o = (red2[e] + red2[128 + e] + red2[256 + e] + red2[384 + e]) * rq; const float s = wave_sum(o * o); if (lane == 0) scal[2 + wave] = s; }
        __syncthreads();
        if (tid < 128) {
            const float ms = (scal[2] + scal[3]) * (1.0f / 128.0f);
            const float ov = o * rsqrtf(ms + EPS) * gnw * (float)F.PROJ()[rs * PS + C_ZA + hd * 128 + e];
            F.OA()[rs * 2048 + hd * 128 + e] = (f16)ov;
        }
    }
    __syncthreads();
    float* so = F.out() + (smp ? O_NGS : O_NGP) + ((size_t)(l * 16 + b) * 16 + hd) * 16384;
    for (int i = tid; i < 16384; i += NTHR) so[i] = S[i];
    __syncthreads();
}

DI unsigned sortable(float f) { const unsigned u = __float_as_uint(f); return (u & 0x80000000u) ? ~u : (u | 0x80000000u); }

DI void bq_unit(const Frame& F, int l, int slab, int rs) {
    LAS float* sc = (LAS float*)F.lds;
    LAS float* qi = sc + 4160;
    LAS float* qv = qi + 1024;
    LAS float* lg = qv + 2048;
    LAS int* idx = (LAS int*)(lg + 4096);
    LAS unsigned* cw = (LAS unsigned*)(idx + 256);
    LAS unsigned* wcnt = cw + 32;
    const int tid = F.tid, lane = F.lane, wave = F.wave;
    int R, sq, t; rowinfo(slab, rs, R, sq, t);
    const bool smp = sq >= 16;
    const int qpos = (smp ? PAST : 0) + t, nvis = 64 * (qpos / 64 + 1), pb = posbase(sq);
    const f16* pr = F.PROJ() + (size_t)rs * PS;
    for (int i = tid; i < 1024; i += NTHR) qi[i] = (float)pr[C_QI + i];
    for (int i = tid; i < 2048; i += NTHR) qv[i] = (float)pr[C_QB + i];
    if (tid < 32) cw[tid] = 0u;
    float wi[16];
#pragma unroll
    for (int h = 0; h < 16; ++h) wi[h] = F.WI()[(size_t)R * 16 + h];
    __syncthreads();
    for (int s = tid; s < nvis; s += NTHR) {
        const f16* kr = F.KIU() + (size_t)(pb + s) * 64;
        float k[64];
#pragma unroll
        for (int i = 0; i < 8; ++i) { const h8 hv = *(const h8*)(kr + i * 8);
#pragma unroll
            for (int j = 0; j < 8; ++j) k[i * 8 + j] = (float)hv[j]; }
        float score = 0.f;
#pragma unroll 1
        for (int h = 0; h < 16; ++h) { float dot = 0.f;
#pragma unroll
            for (int d4 = 0; d4 < 16; ++d4) { const f32x4 q = *(const LAS f32x4*)(qi + h * 64 + d4 * 4); dot += q[0] * k[d4 * 4] + q[1] * k[d4 * 4 + 1] + q[2] * k[d4 * 4 + 2] + q[3] * k[d4 * 4 + 3]; }
            score += wi[h] * fmaxf(dot, 0.f); }
        sc[s] = score;
    }
    __syncthreads();
    unsigned thr = 0u;
    if (nvis > 256) {
        for (int bit = 31; bit >= 0; --bit) {
            const unsigned cand = thr | (1u << bit);
            unsigned c = 0;
            for (int s = tid; s < nvis; s += NTHR) c += sortable(sc[s]) >= cand ? 1u : 0u;
#pragma unroll
            for (int o = 32; o > 0; o >>= 1) c += __shfl_xor(c, o);
            if (lane == 0 && c) atomicAdd((unsigned*)(cw + bit), c);
            __syncthreads();
            if (cw[bit] >= 256u) thr = cand;
        }
    }
    int running = 0;
    for (int i0 = 0; i0 < nvis; i0 += NTHR) {
        const int s = i0 + tid;
        const bool flag = s < nvis && sortable(sc[s]) >= thr;
        const unsigned long long bal = __ballot(flag);
        if (lane == 0) wcnt[wave] = (unsigned)__popcll(bal);
        __syncthreads();
        int base = running, tot = 0;
#pragma unroll
        for (int w = 0; w < 8; ++w) { const int c = (int)wcnt[w]; if (w < wave) base += c; tot += c; }
        const int pos = base + (int)__popcll(bal & ((1ull << lane) - 1ull));
        if (flag && pos < 256) idx[pos] = s;
        running += tot;
        __syncthreads();
    }
    const int cnt = running < 256 ? running : 256;
    {
        const int j = tid & 255, hh = tid >> 8; const bool valid = j < cnt; const int key = valid ? idx[j] : 0;
        const f16* kr = F.KU() + (size_t)(pb + key) * 256 + hh * 128;
        h8 kk[16];
#pragma unroll
        for (int i = 0; i < 16; ++i) kk[i] = *(const h8*)(kr + i * 8);
        const int rb = rel_bucket(key - qpos);
#pragma unroll 1
        for (int g = 0; g < 8; ++g) { const int hq = hh * 8 + g; float dot = 0.f;
#pragma unroll
            for (int i = 0; i < 16; ++i) { const f32x4 q0 = *(const LAS f32x4*)(qv + hq * 128 + i * 8), q1 = *(const LAS f32x4*)(qv + hq * 128 + i * 8 + 4);
                dot += q0[0] * (float)kk[i][0] + q0[1] * (float)kk[i][1] + q0[2] * (float)kk[i][2] + q0[3] * (float)kk[i][3] + q1[0] * (float)kk[i][4] + q1[1] * (float)kk[i][5] + q1[2] * (float)kk[i][6] + q1[3] * (float)kk[i][7]; }
            lg[hq * 256 + j] = valid ? dot * 0.08838834764831845f + F.in(I_RELB)[rb * 16 + hq] : -INFINITY; }
    }
    __syncthreads();
    {
        const int hq = tid >> 5, l32 = tid & 31;
        float m = -INFINITY, pv[8];
#pragma unroll
        for (int i = 0; i < 8; ++i) { pv[i] = lg[hq * 256 + l32 + 32 * i]; m = fmaxf(m, pv[i]); }
#pragma unroll
        for (int o = 16; o > 0; o >>= 1) m = fmaxf(m, __shfl_xor(m, o));
        float sum = 0.f;
#pragma unroll
        for (int i = 0; i < 8; ++i) { pv[i] = __expf(pv[i] - m); sum += pv[i]; }
#pragma unroll
        for (int o = 16; o > 0; o >>= 1) sum += __shfl_xor(sum, o);
#pragma unroll
        for (int i = 0; i < 8; ++i) lg[hq * 256 + l32 + 32 * i] = pv[i];
        const float inv = 1.0f / sum;
        __syncthreads();
        const int kvh = hq >> 3, d4 = l32 * 4;
        f32x4 acc = {0.f, 0.f, 0.f, 0.f};
        for (int j = 0; j < cnt; ++j) {
            const float p = lg[hq * 256 + j]; const int key = idx[j];
            const h4 vv = *(const h4*)(F.VU() + (size_t)(pb + key) * 256 + kvh * 128 + d4);
            acc[0] += p * (float)vv[0]; acc[1] += p * (float)vv[1]; acc[2] += p * (float)vv[2]; acc[3] += p * (float)vv[3];
        }
        const h4 zb = *(const h4*)(pr + C_ZB + hq * 128 + d4);
        h4 ov; ov[0] = (f16)(acc[0] * inv * (float)zb[0]); ov[1] = (f16)(acc[1] * inv * (float)zb[1]); ov[2] = (f16)(acc[2] * inv * (float)zb[2]); ov[3] = (f16)(acc[3] * inv * (float)zb[3]);
        *(h4*)(F.OB() + (size_t)rs * 2048 + hq * 128 + d4) = ov;
    }
    __syncthreads();
}

DI void phase_mix(const Frame F0, int l, int slab) {
    const Frame F = F0.fresh();
    LAS int* ubox = (LAS int*)(F.lds + LDS_MISC + 64);
    unsigned* ctr = F.ctl() + CW_Q + (l * NSLAB + slab) * 64;
    const int Ts = ts_of(slab);
    const int nchp = 64, nchs = slab == 0 ? 256 : 0, nch = nchp + nchs;
    for (;;) {
        if (F.tid == 0) ubox[0] = (int)__hip_atomic_fetch_add(ctr, 1u, __ATOMIC_RELAXED, __HIP_MEMORY_SCOPE_AGENT);
        __syncthreads();
        const int u = ubox[0];
        __syncthreads();
        if (u >= nch + Ts) break;
        if (u < nchp) gdn_chain_unit(F, l, slab, slab * 4 + (u >> 4), u & 15);
        else if (u < nch) { const int v = u - nchp; gdn_chain_unit(F, l, slab, 16 + (v >> 4), v & 15); }
        else {
            int q = u - nch, rs;
            if (slab == 0 && q < 1024) rs = 8192 + q;
            else { if (slab == 0) q -= 1024; rs = (q & 3) * 2048 + (2047 - (q >> 2)); }
            bq_unit(F, l, slab, rs);
        }
    }
}

DI void phase_final(const Frame F0) {
    const Frame F = F0.fresh();
    const float* nw = F.in(I_FNW);
    for (int R = F.bid * NWAVES + F.wave; R < NTOK; R += F.G * NWAVES) {
        float* x = F.out() + (size_t)R * D;
        f32x4 v[8]; float ss = 0.f;
#pragma unroll
        for (int i = 0; i < 8; ++i) { v[i] = *(const f32x4*)(x + (i * 64 + F.lane) * 4); ss += v[i][0] * v[i][0] + v[i][1] * v[i][1] + v[i][2] * v[i][2] + v[i][3] * v[i][3]; }
        ss = wave_sum(ss);
        const float r = rsqrtf(ss * (1.0f / 2048.0f) + EPS);
#pragma unroll
        for (int i = 0; i < 8; ++i) { const int c = (i * 64 + F.lane) * 4; *(f32x4*)(x + c) = v[i] * r * *(const f32x4*)(nw + c); }
    }
}

DI void phase_inproj(const Frame F, int l, int s) {
    const int Ts = ts_of(s);
    pg8::Gemm g{F.H(), F.WIN() + (size_t)l * NP * 2048, F.H(), F.WIN() + (size_t)l * NP * 2048, Ts, NP, 2048};
    pg8::StaticOrder S; S.init(Ts, NP, F.G, F.bid);
    EpiProj E{F.PROJ(), F.out(), F.KU(), F.VU(), F.KIU(), F.WI(), F.BETA(), F.GG(), F.in(I_ALOG) + l * 16, F.in(I_DTB) + l * 16, l, s};
    pg8::gemm_phase<EpiProj, pg8::StaticOrder>(F.lds, g, S, E);
}
DI void phase_ab(const Frame F, int l, int s) {
    const int Ts = ts_of(s);
    pg8::Gemm g{F.OA(), F.WA() + (size_t)l * 2048 * 2048, F.OB(), F.WB() + (size_t)l * 2048 * 2048, Ts, 2048, 2048};
    pg8::DualOrder S; S.init(Ts, 2048, F.G, F.bid);
    EpiAB E{F.PROJ(), F.H()};
    pg8::gemm_phase<EpiAB, pg8::DualOrder>(F.lds, g, S, E);
}
DI void phase_outp(const Frame F, int l, int s) {
    const int Ts = ts_of(s);
    pg8::Gemm g{F.H(), F.WO() + (size_t)l * 2048 * 2048, F.H(), F.WO() + (size_t)l * 2048 * 2048, Ts, 2048, 2048};
    pg8::StaticOrder S; S.init(Ts, 2048, F.G, F.bid);
    EpiOut E{F.in(I_XP), F.in(I_XS), F.out(), F.ADA() + (size_t)l * 32 * 6144, l, s};
    pg8::gemm_phase<EpiOut, pg8::StaticOrder>(F.lds, g, S, E);
}
constexpr int N_PHASES = 1 + 2 * NSLAB * 5 + 1;
__global__ void __launch_bounds__(NTHR, 2) fwd_kernel(Args args) {
    extern __shared__ __attribute__((aligned(16))) unsigned char lds[];
    Frame F;
    F.lds = (LAS unsigned char*)lds;
    F.tid = threadIdx.x; F.lane = F.tid & 63; F.wave = __builtin_amdgcn_readfirstlane(F.tid >> 6); F.G = gridDim.x; F.bid = blockIdx.x;
    if (F.tid < 22) *(LAS unsigned long long*)(F.lds + LDS_TAB + 8 * F.tid) = (unsigned long long)args.in[F.tid];
    if (F.tid == 22) *(LAS unsigned long long*)(F.lds + LDS_TAB + 8 * 22) = (unsigned long long)args.out;
    if (F.tid == 23) *(LAS unsigned long long*)(F.lds + LDS_TAB + 8 * 23) = (unsigned long long)args.ws;
    volatile LAS unsigned* MISC = (volatile LAS unsigned*)(F.lds + LDS_MISC);
    if (F.tid < 64) MISC[F.tid] = 0u;
    __syncthreads();
    const int lo = args.ph_lo, hi = args.ph_hi;
    const bool multi = (hi - lo) > 1;
    if (multi) (void)xcd_barrier_post(F.ctl() + CW_BAR, MISC);
#define IN(k) (lo <= (k) && (k) < hi)
#define SEAM(k) do { if (IN(k) && IN((k) + 1)) { XcdBarrier bar_; bar_.bar = F.ctl() + CW_BAR; bar_.x = xb_xcc_id(); bar_.st = MISC; xcd_barrier(bar_); } } while (0)
    if (IN(0)) { p0_prologue(F); }
    SEAM(0);
    for (int l = 0; l < 2; ++l)
        for (int s = 0; s < NSLAB; ++s) {
            const int pb = 1 + (l * NSLAB + s) * 5;
            if (IN(pb)) phase_norm(F, l, s);
            SEAM(pb);
            if (IN(pb + 1)) phase_inproj(F, l, s);
            SEAM(pb + 1);
            if (IN(pb + 2)) phase_mix(F, l, s);
            SEAM(pb + 2);
            if (IN(pb + 3)) phase_ab(F, l, s);
            SEAM(pb + 3);
            if (IN(pb + 4)) phase_outp(F, l, s);
            SEAM(pb + 4);
        }
    if (IN(N_PHASES - 1)) phase_final(F);
#undef IN
#undef SEAM
}

extern "C" void kernel_launch(void* const* d_in, const int* in_sizes, int n_in, void* d_out, int out_size, void* d_ws, size_t ws_size, hipStream_t stream) {
    static int grid = 0;
    if (grid == 0) {
        if (n_in != 22 || (size_t)out_size != O_END || ws_size < WS_END) { fprintf(stderr, "kernel_launch: unexpected shapes (n_in %d out %d ws %zu, need %zu)\n", n_in, out_size, ws_size, (size_t)WS_END); grid = -1; return; }
        int dev = 0, cus = 0, per_cu = 0;
        if (hipGetDevice(&dev) != hipSuccess || hipDeviceGetAttribute(&cus, hipDeviceAttributeMultiprocessorCount, dev) != hipSuccess) { grid = -1; return; }
        if (hipFuncSetAttribute((const void*)fwd_kernel, hipFuncAttributeMaxDynamicSharedMemorySize, LDS_BYTES) != hipSuccess) { fprintf(stderr, "kernel_launch: hipFuncSetAttribute failed\n"); grid = -1; return; }
        if (hipOccupancyMaxActiveBlocksPerMultiprocessor(&per_cu, (const void*)fwd_kernel, NTHR, LDS_BYTES) != hipSuccess || per_cu < 1) { fprintf(stderr, "kernel_launch: occupancy query says %d\n", per_cu); }
        (void)hipGetLastError();
        grid = cus;
    }
    if (grid < 0) return;
    (void)hipMemsetAsync((char*)d_ws + WS_CTL, 0, CTL_BYTES, stream);
    Args a{};
    for (int i = 0; i < 22; ++i) a.in[i] = (const float*)d_in[i];
    a.out = (float*)d_out; a.ws = (unsigned char*)d_ws;
#if MK_ONE_LAUNCH
    a.ph_lo = 0; a.ph_hi = N_PHASES;
    hipLaunchKernelGGL(fwd_kernel, dim3(grid), dim3(NTHR), LDS_BYTES, stream, a);
#else
    for (int p = 0; p < N_PHASES; ++p) { a.ph_lo = p; a.ph_hi = p + 1; hipLaunchKernelGGL(fwd_kernel, dim3(grid), dim3(NTHR), LDS_BYTES, stream, a); }
#endif
}
```

```cpp
#include <hip/hip_runtime.h>
#include <cstdio>
#include <cstdint>

#ifndef MK_ONE_LAUNCH
#define MK_ONE_LAUNCH 1
#endif

#define LAS __attribute__((address_space(3)))
typedef _Float16 f16;
typedef _Float16 h8 __attribute__((ext_vector_type(8)));
typedef _Float16 h4 __attribute__((ext_vector_type(4)));
typedef _Float16 h2 __attribute__((ext_vector_type(2)));
typedef float f32x4 __attribute__((ext_vector_type(4)));
typedef float f32x2 __attribute__((ext_vector_type(2)));
typedef unsigned u32x4 __attribute__((ext_vector_type(4)));
typedef unsigned u32x2 __attribute__((ext_vector_type(2)));
#define DI __device__ __forceinline__

constexpr int D = 2048, NTOKP = 32768, NTOKS = 1024, NTOK = NTOKP + NTOKS;
constexpr int IN_DIM = 18032, NP = 18176, PS = 17408;
constexpr int LSMP = 4160, PAST = 4096;
constexpr int NSLAB = 4, NWAVES = 8, NTHR = 512;
constexpr int C_QKV = 0, C_ZA = 6144, C_QB = 8192, C_ZB = 10240, C_QI = 12288, C_GA = 13312, C_GB = 15360;
constexpr float EPS = 1e-6f;
constexpr int NPOS = 16 * 2048 + 16 * LSMP;

constexpr size_t O_YP = 0, O_YS = O_YP + (size_t)NTOKP * D, O_NKP = O_YS + (size_t)NTOKS * D, O_NVP = O_NKP + (size_t)2 * 16 * 2048 * 256,
    O_NIP = O_NVP + (size_t)2 * 16 * 2048 * 256, O_NGP = O_NIP + (size_t)2 * 16 * 2048 * 64, O_NCP = O_NGP + (size_t)2 * 16 * 16 * 16384,
    O_NKS = O_NCP + (size_t)2 * 16 * 3 * 6144, O_NVS = O_NKS + (size_t)2 * 16 * 64 * 256, O_NIS = O_NVS + (size_t)2 * 16 * 64 * 256,
    O_NGS = O_NIS + (size_t)2 * 16 * 64 * 64, O_NCS = O_NGS + (size_t)2 * 16 * 16 * 16384, O_END = O_NCS + (size_t)2 * 16 * 3 * 6144;
static_assert(O_END == 126091264ull, "output size");

constexpr size_t al256(size_t x) { return (x + 255) & ~(size_t)255; }
constexpr size_t WS_CTL = 0, CTL_BYTES = 1u << 20;
constexpr size_t WS_ADA = WS_CTL + CTL_BYTES;
constexpr size_t WS_WIN = al256(WS_ADA + (size_t)2 * 32 * 6144 * 4);
constexpr size_t WS_WA = al256(WS_WIN + (size_t)2 * NP * 2048 * 2);
constexpr size_t WS_WB = al256(WS_WA + (size_t)2 * 2048 * 2048 * 2);
constexpr size_t WS_WO = al256(WS_WB + (size_t)2 * 2048 * 2048 * 2);
constexpr size_t WS_H = al256(WS_WO + (size_t)2 * 2048 * 2048 * 2);
constexpr size_t WS_PROJ = al256(WS_H + (size_t)9216 * 2048 * 2);
constexpr size_t WS_OA = al256(WS_PROJ + (size_t)9216 * PS * 2);
constexpr size_t WS_OB = al256(WS_OA + (size_t)9216 * 2048 * 2);
constexpr size_t WS_KU = al256(WS_OB + (size_t)9216 * 2048 * 2);
constexpr size_t WS_VU = al256(WS_KU + (size_t)NPOS * 256 * 2);
constexpr size_t WS_KIU = al256(WS_VU + (size_t)NPOS * 256 * 2);
constexpr size_t WS_WI = al256(WS_KIU + (size_t)NPOS * 64 * 2);
constexpr size_t WS_BETA = al256(WS_WI + (size_t)NTOK * 16 * 4);
constexpr size_t WS_G = al256(WS_BETA + (size_t)NTOK * 16 * 4);
constexpr int LDR = 4160;
constexpr size_t WS_SCR = al256(WS_G + (size_t)NTOK * 16 * 4);
constexpr int GP_W = 0, GP_QD = 16384, GP_KD = 32768, GP_U = 49152, GP_QK = 65536, GP_STRIDE = 73728;
constexpr size_t WS_GP = al256(WS_SCR + (size_t)256 * 32 * LDR * 4);
constexpr size_t WS_GL = al256(WS_GP + (size_t)144 * 16 * GP_STRIDE);
constexpr size_t WS_END = al256(WS_GL + (size_t)144 * 16 * 4);

constexpr int LDS_BYTES = 147456, LDS_MISC = 131072;

#define XB_TMO      128
#define XB_XCNT(j)  (256  + 64 * (j))
#define XB_XSUB(j)  (1280 + 64 * (j))
#define XB_XGEN(j)  (2304 + 64 * (j))
#define XB_TOP      3328
#define XB_TOPGEN   3392
#define XCD_BAR_WORDS 3456
#define XB_SPIN_CAP (1u << 18)
__device__ __forceinline__ unsigned xb_ld(unsigned* p)              { return __hip_atomic_load(p, __ATOMIC_RELAXED, __HIP_MEMORY_SCOPE_AGENT); }
__device__ __forceinline__ unsigned xb_add(unsigned* p, unsigned v) { return __hip_atomic_fetch_add(p, v, __ATOMIC_RELAXED, __HIP_MEMORY_SCOPE_AGENT); }
__device__ __forceinline__ unsigned xb_xcc_id() { return (unsigned)__builtin_amdgcn_s_getreg((3 << 11) | 20) & 0xFu; }
#define XB_SPIN(cond, bar) do { unsigned _sp = 0; while (cond) { __builtin_amdgcn_s_sleep(1); \
    if ((++_sp & 255u) == 0u) { if (xb_ld(&(bar)[XB_TMO])) break; if (_sp > XB_SPIN_CAP) { atomicAdd(&(bar)[XB_TMO], 1u); break; } } } } while (0)
struct XcdBarrier { unsigned* bar; unsigned x; volatile LAS unsigned* st; };
__device__ __forceinline__ XcdBarrier xcd_barrier_post(unsigned* bar, volatile LAS unsigned* st) {
    XcdBarrier b; b.bar = bar; b.x = xb_xcc_id(); b.st = st;
    if (threadIdx.x == 0) (void)xb_add(&bar[XB_XCNT(b.x)], 1u);
    return b;
}
__device__ __forceinline__ void xcd_barrier_complete(unsigned* bar, unsigned x, unsigned& nloc, unsigned& nx) {
    const unsigned G = gridDim.x * gridDim.y * gridDim.z;
    unsigned sum, cnt, mine, sp = 0u;
    for (;;) {
        sum = 0u; cnt = 0u; mine = 0u;
#pragma unroll
        for (unsigned j = 0; j < 16; ++j) { const unsigned c = xb_ld(&bar[XB_XCNT(j)]); sum += c; cnt += (c > 0u) ? 1u : 0u; mine = (j == x) ? c : mine; }
        if (sum == G) break;
        __builtin_amdgcn_s_sleep(1);
        if ((++sp & 255u) == 0u) { if (xb_ld(&bar[XB_TMO])) break; if (sp > XB_SPIN_CAP) { atomicAdd(&bar[XB_TMO], 1u); break; } }
    }
    nloc = mine > 0u ? mine : 1u; nx = cnt > 0u ? cnt : 1u;
}
__device__ __noinline__ void xcd_barrier(const XcdBarrier b) {
    asm volatile("s_waitcnt vmcnt(0)" ::: "memory");
    __syncthreads();
    if (threadIdx.x == 0) {
        unsigned* bar = b.bar;
        __builtin_amdgcn_s_waitcnt(0);
        unsigned nloc = b.st[0], nx = b.st[1];
        if (nloc == 0u) { xcd_barrier_complete(bar, b.x, nloc, nx); b.st[0] = nloc; b.st[1] = nx; }
        const unsigned old = xb_add(&bar[XB_XSUB(b.x)], 1u);
        const unsigned gen = old / nloc;
        if (old + 1u == (gen + 1u) * nloc) {
            __builtin_amdgcn_fence(__ATOMIC_RELEASE, "agent");
            asm volatile("s_waitcnt vmcnt(0)" ::: "memory");
            const unsigned og = xb_add(&bar[XB_TOP], 1u);
            const unsigned tg = og / nx;
            if (og + 1u == (tg + 1u) * nx) xb_add(&bar[XB_TOPGEN], 1u);
            else XB_SPIN(xb_ld(&bar[XB_TOPGEN]) == tg, bar);
            __builtin_amdgcn_fence(__ATOMIC_ACQUIRE, "agent");
            xb_add(&bar[XB_XGEN(b.x)], 1u);
            asm volatile("s_waitcnt vmcnt(0)" ::: "memory");
        } else {
            XB_SPIN(xb_ld(&bar[XB_XGEN(b.x)]) == gen, bar);
            __builtin_amdgcn_fence(__ATOMIC_ACQUIRE, "agent");
            asm volatile("s_waitcnt vmcnt(0)" ::: "memory");
        }
    }
    __syncthreads();
}

DI float wave_sum(float v) {
#pragma unroll
    for (int o = 32; o > 0; o >>= 1) v += __shfl_xor(v, o);
    return v;
}
DI float sigmoidf_(float x) { return 1.0f / (1.0f + __expf(-x)); }
DI float siluf_(float x) { return x / (1.0f + __expf(-x)); }
DI unsigned pk_f16(float lo, float hi) { h2 v = {(f16)lo, (f16)hi}; return __builtin_bit_cast(unsigned, v); }
DI void rowinfo(int slab, int rs, int& R, int& sq, int& t) {
    if (rs < 8192) { R = slab * 8192 + rs; sq = R >> 11; t = R & 2047; }
    else { const int q = rs - 8192; R = NTOKP + q; sq = 16 + (q >> 6); t = q & 63; }
}
DI int posbase(int sq) { return sq < 16 ? sq * 2048 : 32768 + (sq - 16) * LSMP; }
__host__ __device__ inline int ts_of(int slab) { return slab == 0 ? 9216 : 8192; }
DI int proj_src_col(int n) {
    if (n < 8192) return n;
    if (n < 10240) return 8224 + (n - 8192);
    if (n < 12288) return 10784 + (n - 10240);
    if (n < 13312) return 12832 + (n - 12288);
    if (n < 15360) return 13936 + (n - 13312);
    if (n < 17408) return 15984 + (n - 15360);
    if (n < 17664) return 10272 + (n - 17408);
    if (n < 17920) return 10528 + (n - 17664);
    const int j = n - 17920;
    if (j < 64) return 13856 + j;
    if (j < 80) return 13920 + (j - 64);
    if (j < 96) return 8192 + (j - 80);
    if (j < 112) return 8208 + (j - 96);
    return -1;
}
DI int rel_bucket(int rel) {
    const int n = rel < 0 ? -rel : rel;
    const int v = n < 8 ? n : (n < 12 ? 8 : n < 16 ? 9 : n < 23 ? 10 : n < 32 ? 11 : n < 46 ? 12 : n < 64 ? 13 : n < 91 ? 14 : 15);
    return (rel > 0 ? 16 : 0) + v;
}

namespace pg8 {
constexpr int BM = 256, BK = 64, HALF = 128, HTB = HALF * BK * 2, STAGE_BYTES = 8 * HTB, NXCD = 8, WGM = 8;
DI int lds_byte(int r, int c) { const int st = (r >> 4) * 2 + (c >> 5), rr = r & 15, cc = c & 31, ob = rr * 64 + cc * 2; return st * 1024 + (ob ^ (((ob >> 9) & 1) << 5)); }
DI void stage_rc(int b, int& R, int& C) { const int st = b / 1024, sb = b % 1024, swz = sb ^ (((sb >> 9) & 1) << 5); R = (st >> 1) * 16 + swz / 64; C = (st & 1) * 32 + (swz % 64) / 2; }
DI int perm32(int rho) { const int n = rho >> 4, i = rho & 15; return 8 * (i >> 2) + 4 * n + (i & 3); }

struct Unit { int pm, pn, which; };
struct Gemm { const f16* A0; const f16* B0; const f16* A1; const f16* B1; int M, N, K; };

struct StaticOrder {
    int nM, nN, nwg, G, c;
    DI void init(int M, int N, int G_, int c_) { nM = M / BM; nN = N / BM; nwg = nM * nN; G = G_; c = c_; }
    DI bool tile(long L, Unit& u) const {
        if (L >= nwg) return false;
        int wgid = (int)L; { const int q = nwg / NXCD, r = nwg % NXCD, xcd = wgid % NXCD, off = wgid / NXCD; wgid = (xcd < r ? xcd * (q + 1) : r * (q + 1) + (xcd - r) * q) + off; }
        const int nig = WGM * nN, gid = wgid / nig, fm = gid * WGM, gsz = (nM - fm) < WGM ? (nM - fm) : WGM;
        u.pm = fm + ((wgid % nig) % gsz); u.pn = (wgid % nig) / gsz; return true;
    }
    DI bool next(int i, Unit& u) const { u.which = 0; return tile((long)i * G + c, u); }
};
struct DualOrder : StaticOrder {
    DI bool next(int i, Unit& u) const { u.which = i & 1; return tile((long)(i >> 1) * G + c, u); }
};

template <class Epi, class Sched, bool ALIGN_EPI = true>
DI void gemm_phase(LAS unsigned char* lds, const Gemm g, const Sched& S, const Epi& E) {
    int tid_ = threadIdx.x; asm volatile("" : "+v"(tid_));
    const int tid = tid_, wid = __builtin_amdgcn_readfirstlane(tid >> 6), lane = tid & 63, wr = wid >> 2, wc = wid & 3, fr = lane & 15, fq = lane >> 4;
    const int K = g.K, nt = K / BK;
    unsigned voffA[2], voffB[2];
#pragma unroll
    for (int i = 0; i < 2; ++i) { int R, C; stage_rc(tid * 16 + i * 8192, R, C); const int Rb = (R & ~31) + perm32(R & 31);
        voffA[i] = (unsigned)(R * K + C) * 2u; voffB[i] = (unsigned)(Rb * K + C) * 2u; }
    const size_t kstep = (size_t)(BK * 2);
    const size_t hstep = (size_t)HALF * K * 2;
    const size_t tstep = 2 * hstep;
    const unsigned ldsw = (unsigned)wid * 1024u;
    const int aoff = lds_byte(wr * 64 + fr, fq * 8), boff = lds_byte(wc * 32 + fr, fq * 8);
#define PG8_SA(b, h) (((b) * 2 + (h)) * HTB)
#define PG8_SB(b, h) ((4 + (b) * 2 + (h)) * HTB)
#define PG8_STAGE(bufoff, gbase, voff) do { _Pragma("unroll") for (int _i = 0; _i < 2; ++_i) \
        __builtin_amdgcn_global_load_lds((const unsigned*)((const char*)(gbase) + (voff)[_i]), (LAS unsigned*)(lds + (bufoff) + ldsw + _i * 8192), 16, 0, 0); } while (0)
#define PG8_LDA(dst, b, h) do { _Pragma("unroll") for (int m = 0; m < 4; ++m) _Pragma("unroll") for (int k = 0; k < 2; ++k) dst[m][k] = *(const LAS h8*)(lds + PG8_SA(b, h) + aoff + m * 2048 + k * 1024); } while (0)
#define PG8_LDB(dst, b, h) do { _Pragma("unroll") for (int n = 0; n < 2; ++n) _Pragma("unroll") for (int k = 0; k < 2; ++k) dst[n][k] = *(const LAS h8*)(lds + PG8_SB(b, h) + boff + n * 2048 + k * 1024); } while (0)
#define PG8_MMA(ai, bj, At, Bt) do { __builtin_amdgcn_s_setprio(1); _Pragma("unroll") for (int m = 0; m < 4; ++m) _Pragma("unroll") for (int n = 0; n < 2; ++n) _Pragma("unroll") for (int k = 0; k < 2; ++k) \
        acc[ai][bj][m][n] = __builtin_amdgcn_mfma_f32_16x16x32_f16(Bt[n][k], At[m][k], acc[ai][bj][m][n], 0, 0, 0); __builtin_amdgcn_s_setprio(0); } while (0)
#define PG8_WAIT_V(n) asm volatile("s_waitcnt vmcnt(" #n ")" ::: "memory")
#define PG8_WAIT_L(n) asm volatile("s_waitcnt lgkmcnt(" #n ")" ::: "memory")
#define PG8_BAR __builtin_amdgcn_s_barrier()
#define PG8_SCHED __builtin_amdgcn_sched_barrier(0)
    Unit cur, nxt; int ui = 0;
    if (!S.next(0, cur)) return;
    f32x4 acc[2][2][4][2];
#pragma unroll
    for (int a = 0; a < 2; ++a)
#pragma unroll
        for (int b = 0; b < 2; ++b)
#pragma unroll
            for (int m = 0; m < 4; ++m)
#pragma unroll
                for (int n = 0; n < 2; ++n) acc[a][b][m][n] = (f32x4){0.f, 0.f, 0.f, 0.f};
    h8 At[4][2], B0[2][2], B1[2][2];
    const char* cA = (const char*)(cur.which ? g.A1 : g.A0) + (size_t)cur.pm * tstep; const char* cB = (const char*)(cur.which ? g.B1 : g.B0) + (size_t)cur.pn * tstep;
    PG8_STAGE(PG8_SB(0, 0), cB, voffB); PG8_STAGE(PG8_SB(0, 1), cB + hstep, voffB); PG8_STAGE(PG8_SA(0, 0), cA, voffA); PG8_STAGE(PG8_SA(0, 1), cA + hstep, voffA);
    if (wr == 1) PG8_BAR;
    PG8_WAIT_V(2); PG8_BAR;
    PG8_STAGE(PG8_SB(1, 0), cB + kstep, voffB); PG8_STAGE(PG8_SA(1, 0), cA + kstep, voffA); PG8_STAGE(PG8_SB(1, 1), cB + hstep + kstep, voffB);
    PG8_WAIT_V(6); PG8_BAR;
    for (;;) {
        const bool has_next = S.next(ui + 1, nxt);
        const char* nA = has_next ? (const char*)(nxt.which ? g.A1 : g.A0) + (size_t)nxt.pm * tstep : cA; const char* nB = has_next ? (const char*)(nxt.which ? g.B1 : g.B0) + (size_t)nxt.pn * tstep : cB;
        for (int t = 0; t < nt; t += 2) {
            const bool last = (t == nt - 2);
            const char* a1 = cA + (size_t)(t + 1) * kstep;
            const char* a2 = last ? nA : cA + (size_t)(t + 2) * kstep; const char* b2 = last ? nB : cB + (size_t)(t + 2) * kstep;
            const char* a3 = a2 + kstep; const char* b3 = b2 + kstep;
            PG8_LDB(B0, 0, 0); PG8_LDB(B1, 0, 1); PG8_SCHED; PG8_LDA(At, 0, 0); PG8_STAGE(PG8_SA(1, 1), a1 + hstep, voffA);
            PG8_WAIT_V(8); PG8_WAIT_L(0); PG8_BAR; PG8_MMA(0, 0, At, B0); PG8_MMA(0, 1, At, B1); PG8_BAR; PG8_SCHED;
            PG8_LDA(At, 0, 1); PG8_STAGE(PG8_SB(0, 0), b2, voffB); PG8_STAGE(PG8_SB(0, 1), b2 + hstep, voffB); PG8_STAGE(PG8_SA(0, 0), a2, voffA);
            PG8_WAIT_V(8); PG8_WAIT_L(0); PG8_BAR; PG8_MMA(1, 0, At, B0); PG8_MMA(1, 1, At, B1); PG8_BAR; PG8_SCHED;
            PG8_LDB(B0, 1, 0); PG8_LDB(B1, 1, 1); PG8_SCHED; PG8_LDA(At, 1, 0); PG8_STAGE(PG8_SA(0, 1), a2 + hstep, voffA);
            PG8_WAIT_V(8); PG8_WAIT_L(0); PG8_BAR; PG8_MMA(0, 0, At, B0); PG8_MMA(0, 1, At, B1); PG8_BAR; PG8_SCHED;
            PG8_LDA(At, 1, 1); PG8_STAGE(PG8_SB(1, 0), b3, voffB); PG8_STAGE(PG8_SB(1, 1), b3 + hstep, voffB); PG8_STAGE(PG8_SA(1, 0), a3, voffA);
            PG8_WAIT_V(8); PG8_WAIT_L(0); PG8_BAR; PG8_MMA(1, 0, At, B0); PG8_MMA(1, 1, At, B1); PG8_BAR; PG8_SCHED;
        }
        if constexpr (ALIGN_EPI) { if (wr == 0) PG8_BAR; }
        E(acc, cur, wr, wc, fr, fq);
        if (!has_next) break;
#pragma unroll
        for (int a = 0; a < 2; ++a)
#pragma unroll
            for (int b = 0; b < 2; ++b)
#pragma unroll
                for (int m = 0; m < 4; ++m)
#pragma unroll
                    for (int n = 0; n < 2; ++n) acc[a][b][m][n] = (f32x4){0.f, 0.f, 0.f, 0.f};
        cur = nxt; cA = nA; cB = nB; ++ui;
        if constexpr (ALIGN_EPI) { if (wr == 1) PG8_BAR; }
    }
    PG8_WAIT_V(0);
    if constexpr (!ALIGN_EPI) { if (wr == 0) PG8_BAR; }
    PG8_BAR;
#undef PG8_SA
#undef PG8_SB
#undef PG8_STAGE
#undef PG8_LDA
#undef PG8_LDB
#undef PG8_MMA
#undef PG8_WAIT_V
#undef PG8_WAIT_L
#undef PG8_BAR
#undef PG8_SCHED
}
}

struct Args { const float* in[22]; float* out; unsigned char* ws; int ph_lo, ph_hi; };
constexpr int LDS_TAB = LDS_MISC + 256;
DI unsigned long long ldtab(LAS unsigned char* lds, int i) {
    const unsigned vx = *(const volatile LAS unsigned*)(lds + LDS_TAB + 8 * i), vy = *(const volatile LAS unsigned*)(lds + LDS_TAB + 8 * i + 4); u32x2 v; v.x = vx; v.y = vy;
    return ((unsigned long long)(unsigned)__builtin_amdgcn_readfirstlane((int)v.y) << 32) | (unsigned)__builtin_amdgcn_readfirstlane((int)v.x);
}
struct Frame {
    LAS unsigned char* lds; int tid, lane, wave, G, bid;
    DI Frame fresh() const { Frame f = *this; int t = threadIdx.x; asm volatile("" : "+v"(t)); f.tid = t; f.lane = t & 63; f.wave = __builtin_amdgcn_readfirstlane(t >> 6); return f; }
    DI const float* in(int i) const { return (const float*)ldtab(lds, i); }
    DI float* out() const { return (float*)ldtab(lds, 22); }
    DI unsigned char* ws() const { return (unsigned char*)ldtab(lds, 23); }
    DI unsigned* ctl() const { return (unsigned*)(ws() + WS_CTL); }
    DI float* ADA() const { return (float*)(ws() + WS_ADA); }
    DI f16* WIN() const { return (f16*)(ws() + WS_WIN); }
    DI f16* WA() const { return (f16*)(ws() + WS_WA); }
    DI f16* WB() const { return (f16*)(ws() + WS_WB); }
    DI f16* WO() const { return (f16*)(ws() + WS_WO); }
    DI f16* H() const { return (f16*)(ws() + WS_H); }
    DI f16* PROJ() const { return (f16*)(ws() + WS_PROJ); }
    DI f16* OA() const { return (f16*)(ws() + WS_OA); }
    DI f16* OB() const { return (f16*)(ws() + WS_OB); }
    DI f16* KU() const { return (f16*)(ws() + WS_KU); }
    DI f16* VU() const { return (f16*)(ws() + WS_VU); }
    DI f16* KIU() const { return (f16*)(ws() + WS_KIU); }
    DI float* WI() const { return (float*)(ws() + WS_WI); }
    DI float* BETA() const { return (float*)(ws() + WS_BETA); }
    DI float* GG() const { return (float*)(ws() + WS_G); }
};
enum { I_XP = 0, I_XS, I_CP, I_CS, I_CK, I_CV, I_CIK, I_SG, I_SC, I_NW, I_WADA, I_BADA, I_WIN, I_WCONV, I_ALOG, I_DTB, I_GNW, I_WBA, I_WBB, I_WOUT, I_RELB, I_FNW };
constexpr int CW_BAR = 0, CW_Q = 4096;

struct EpiProj {
    static constexpr bool PERM = true;
    f16* proj; float* out; f16 *KU, *VU, *KIU; float *WI, *BETA, *GG; const float *a_log, *dt_bias; int layer, slab;
    DI void operator()(const f32x4 (&acc)[2][2][4][2], const pg8::Unit& u, int wr, int wc, int fr_, int fq_) const {
        int fr = fr_, fq = fq_; asm volatile("" : "+v"(fr), "+v"(fq));
        const int pn = u.pn;
        const int rsb = u.pm * 256 + wr * 64 + fr;
        if (pn < 68) {
            const int act = ((pn >= 24 && pn < 32) || (pn >= 40 && pn < 48)) ? 1 : (pn >= 52 ? 2 : 0);
            const int col0 = pn * 256 + wc * 32 + 8 * fq;
#pragma unroll
            for (int ai = 0; ai < 2; ++ai)
#pragma unroll
                for (int m = 0; m < 4; ++m) {
                    f16* rowp = proj + (size_t)(rsb + ai * 128 + m * 16) * PS + col0;
#pragma unroll
                    for (int bj = 0; bj < 2; ++bj) {
                        f32x4 v0 = acc[ai][bj][m][0], v1 = acc[ai][bj][m][1];
                        if (act == 1) {
#pragma unroll
                            for (int j = 0; j < 4; ++j) { v0[j] = siluf_(v0[j]); v1[j] = siluf_(v1[j]); }
                        } else if (act == 2) {
#pragma unroll
                            for (int j = 0; j < 4; ++j) { v0[j] = sigmoidf_(v0[j]); v1[j] = sigmoidf_(v1[j]); }
                        }
                        u32x4 w; w.x = pk_f16(v0[0], v0[1]); w.y = pk_f16(v0[2], v0[3]); w.z = pk_f16(v1[0], v1[1]); w.w = pk_f16(v1[2], v1[3]);
                        *(u32x4*)(rowp + bj * 128) = w;
                    }
                }
            if (pn < 24 && fr >= 13) {
                const bool smp = u.pm >= 32;
                if (smp || (u.pm & 7) == 7) {
#pragma unroll
                    for (int ai = 0; ai < 2; ++ai) {
                        if (!smp && !(ai == 1 && wr == 1)) continue;
                        int R, sq, t; rowinfo(slab, rsb + ai * 128 + 48, R, sq, t);
                        const int T = smp ? 64 : 2048;
                        float* base = out + (smp ? O_NCS : O_NCP) + ((size_t)(layer * 16 + (sq & 15)) * 3 + (t - (T - 3))) * 6144 + col0;
#pragma unroll
                        for (int bj = 0; bj < 2; ++bj) { *(f32x4*)(base + bj * 128) = acc[ai][bj][3][0]; *(f32x4*)(base + bj * 128 + 4) = acc[ai][bj][3][1]; }
                    }
                }
            }
        } else {
#pragma unroll
            for (int ai = 0; ai < 2; ++ai)
#pragma unroll
                for (int m = 0; m < 4; ++m) {
                    int R, sq, t; rowinfo(slab, rsb + ai * 128 + m * 16, R, sq, t);
                    const bool smp = sq >= 16; const int b = sq & 15;
                    const size_t pos = (size_t)posbase(sq) + (smp ? PAST : 0) + t;
#pragma unroll
                    for (int bj = 0; bj < 2; ++bj) {
                        const int c = bj * 128 + wc * 32 + 8 * fq;
                        const f32x4 v0 = acc[ai][bj][m][0], v1 = acc[ai][bj][m][1];
                        if (pn < 70) {
                            float* o = out + (pn == 68 ? (smp ? O_NKS : O_NKP) : (smp ? O_NVS : O_NVP)) + ((size_t)(layer * 16 + b) * (smp ? 64 : 2048) + t) * 256 + c;
                            *(f32x4*)o = v0; *(f32x4*)(o + 4) = v1;
                            u32x4 w; w.x = pk_f16(v0[0], v0[1]); w.y = pk_f16(v0[2], v0[3]); w.z = pk_f16(v1[0], v1[1]); w.w = pk_f16(v1[2], v1[3]);
                            *(u32x4*)((pn == 68 ? KU : VU) + pos * 256 + c) = w;
                        } else if (c < 64) {
                            float* o = out + (smp ? O_NIS : O_NIP) + ((size_t)(layer * 16 + b) * (smp ? 64 : 2048) + t) * 64 + c;
                            *(f32x4*)o = v0; *(f32x4*)(o + 4) = v1;
                            u32x4 w; w.x = pk_f16(v0[0], v0[1]); w.y = pk_f16(v0[2], v0[3]); w.z = pk_f16(v1[0], v1[1]); w.w = pk_f16(v1[2], v1[3]);
                            *(u32x4*)(KIU + pos * 64 + c) = w;
                        } else if (c < 80) {
                            float* o = WI + (size_t)R * 16 + (c - 64);
                            *(f32x4*)o = v0 * 0.03125f; *(f32x4*)(o + 4) = v1 * 0.03125f;
                        } else if (c < 96) {
                            float* o = BETA + (size_t)R * 16 + (c - 80);
                            f32x4 a, bb;
#pragma unroll
                            for (int j = 0; j < 4; ++j) { a[j] = sigmoidf_(v0[j]); bb[j] = sigmoidf_(v1[j]); }
                            *(f32x4*)o = a; *(f32x4*)(o + 4) = bb;
                        } else if (c < 112) {
                            float* o = GG + (size_t)R * 16 + (c - 96);
                            f32x4 a, bb;
#pragma unroll
                            for (int j = 0; j < 4; ++j) {
                                const int h0 = (c - 96) + j, h1 = h0 + 4;
                                const float x0 = v0[j] + dt_bias[h0], x1 = v1[j] + dt_bias[h1];
                                const float s0 = x0 > 20.f ? x0 : log1pf(__expf(x0)), s1 = x1 > 20.f ? x1 : log1pf(__expf(x1));
                                a[j] = -__expf(a_log[h0]) * s0; bb[j] = -__expf(a_log[h1]) * s1;
                            }
                            *(f32x4*)o = a; *(f32x4*)(o + 4) = bb;
                        }
                    }
                }
        }
    }
};
struct EpiAB {
    static constexpr bool PERM = true;
    const f16* proj; f16* mg;
    DI void operator()(const f32x4 (&acc)[2][2][4][2], const pg8::Unit& u, int wr, int wc, int fr_, int fq_) const {
        int fr = fr_, fq = fq_; asm volatile("" : "+v"(fr), "+v"(fq));
        const int rsb = u.pm * 256 + wr * 64 + fr, col0 = u.pn * 256 + wc * 32 + 8 * fq;
        const int gc = (u.which ? C_GB : C_GA) + col0;
#pragma unroll
        for (int ai = 0; ai < 2; ++ai)
#pragma unroll
            for (int m = 0; m < 4; ++m) {
                const size_t rs = (size_t)(rsb + ai * 128 + m * 16);
#pragma unroll
                for (int bj = 0; bj < 2; ++bj) {
                    const h8 gt = *(const h8*)(proj + rs * PS + gc + bj * 128);
                    f16* mp = mg + rs * 2048 + col0 + bj * 128;
                    float r[8];
#pragma unroll
                    for (int j = 0; j < 4; ++j) { r[j] = (float)gt[j] * acc[ai][bj][m][0][j]; r[4 + j] = (float)gt[4 + j] * acc[ai][bj][m][1][j]; }
                    if (u.which) { const h8 pv = *(const h8*)mp;
#pragma unroll
                        for (int j = 0; j < 8; ++j) r[j] += (float)pv[j]; }
                    u32x4 w; w.x = pk_f16(r[0], r[1]); w.y = pk_f16(r[2], r[3]); w.z = pk_f16(r[4], r[5]); w.w = pk_f16(r[6], r[7]);
                    *(u32x4*)mp = w;
                }
            }
    }
};
struct EpiOut {
    static constexpr bool PERM = true;
    const float* xp; const float* xs; float* out; const float* ada; int layer, slab;
    DI void operator()(const f32x4 (&acc)[2][2][4][2], const pg8::Unit& u, int wr, int wc, int fr_, int fq_) const {
        int fr = fr_, fq = fq_; asm volatile("" : "+v"(fr), "+v"(fq));
        const int rsb = u.pm * 256 + wr * 64 + fr, col0 = u.pn * 256 + wc * 32 + 8 * fq;
#pragma unroll
        for (int ai = 0; ai < 2; ++ai)
#pragma unroll
            for (int m = 0; m < 4; ++m) {
                int R, sq, t; rowinfo(slab, rsb + ai * 128 + m * 16, R, sq, t);
                const float* xo = layer == 0 ? (R < NTOKP ? xp + (size_t)R * D : xs + (size_t)(R - NTOKP) * D) : out + (size_t)R * D;
                const float* gp = ada + (size_t)sq * 6144 + 4096;
                float* yo = out + (size_t)R * D;
#pragma unroll
                for (int bj = 0; bj < 2; ++bj) {
                    const int c = col0 + bj * 128;
                    const f32x4 x0 = *(const f32x4*)(xo + c), x1 = *(const f32x4*)(xo + c + 4), g0 = *(const f32x4*)(gp + c), g1 = *(const f32x4*)(gp + c + 4);
                    *(f32x4*)(yo + c) = x0 + g0 * acc[ai][bj][m][0]; *(f32x4*)(yo + c + 4) = x1 + g1 * acc[ai][bj][m][1];
                }
            }
    }
};

DI void p0_prologue(const Frame F0) {
    const Frame F = F0.fresh();
    LAS float* tile = (LAS float*)F.lds;
    const int tid = F.tid;
    for (int u = F.bid; u < 2 * 12160; u += F.G) {
        const int l = u / 12160; int v = u % 12160;
        const float* src; f16* dst; int ldn, nb, kb; bool isin;
        if (v < 9088) { isin = true; nb = v >> 5; kb = v & 31; src = F.in(I_WIN) + (size_t)l * 2048 * IN_DIM; ldn = IN_DIM; dst = F.WIN() + (size_t)l * NP * 2048; }
        else { v -= 9088; const int mat = v >> 10, w = v & 1023; isin = false; nb = w >> 5; kb = w & 31; src = F.in(I_WBA + mat) + (size_t)l * 2048 * 2048; ldn = 2048;
               dst = (mat == 0 ? F.WA() : mat == 1 ? F.WB() : F.WO()) + (size_t)l * 2048 * 2048; }
        {
            const int nn = tid & 63, np = nb * 64 + nn; const int o = isin ? proj_src_col(np) : np;
#pragma unroll
            for (int i = 0; i < 8; ++i) { const int kk = (tid >> 6) + 8 * i; tile[kk * 65 + nn] = o >= 0 ? src[(size_t)(kb * 64 + kk) * ldn + o] : 0.f; }
        }
        __syncthreads();
        {
            const int nn = tid >> 3, kg = tid & 7; h8 hv;
#pragma unroll
            for (int j = 0; j < 8; ++j) hv[j] = (f16)tile[(kg * 8 + j) * 65 + nn];
            *(h8*)(dst + (size_t)(nb * 64 + nn) * 2048 + kb * 64 + kg * 8) = hv;
        }
        __syncthreads();
    }
    for (int u = F.bid; u < 2 * 96; u += F.G) {
        const int l = u / 96, cb = u % 96, kg = tid >> 6, n = tid & 63;
        float acc[32];
#pragma unroll
        for (int s = 0; s < 32; ++s) acc[s] = 0.f;
        const float* W = F.in(I_WADA) + (size_t)l * 2048 * 6144 + cb * 64 + n;
        for (int kc = 0; kc < 4; ++kc) {
            for (int i = tid; i < 32 * 512; i += NTHR) { const int s = i >> 9, k = i & 511; const float c = (s < 16 ? F.in(I_CP) + s * 2048 : F.in(I_CS) + (s - 16) * 2048)[kc * 512 + k]; tile[i] = siluf_(c); }
            __syncthreads();
            for (int kk = 0; kk < 64; ++kk) { const int k = kg * 64 + kk; const float w = W[(size_t)(kc * 512 + k) * 6144];
#pragma unroll
                for (int s = 0; s < 32; ++s) acc[s] += tile[s * 512 + k] * w; }
            __syncthreads();
        }
#pragma unroll
        for (int s = 0; s < 32; ++s) tile[(kg * 32 + s) * 64 + n] = acc[s];
        __syncthreads();
        for (int o = tid; o < 2048; o += NTHR) { const int s = o >> 6, nn = o & 63; float r = F.in(I_BADA)[l * 6144 + cb * 64 + nn];
#pragma unroll
            for (int g = 0; g < 8; ++g) r += tile[(g * 32 + s) * 64 + nn];
            F.ADA()[(size_t)(l * 32 + s) * 6144 + cb * 64 + nn] = r; }
        __syncthreads();
    }
}

DI void phase_norm(const Frame F0, int l, int slab) {
    const Frame F = F0.fresh();
    const int Ts = ts_of(slab);
    const float* nw = F.in(I_NW) + l * 2048;
    for (int rs = F.bid * NWAVES + F.wave; rs < Ts; rs += F.G * NWAVES) {
        int R, sq, t; rowinfo(slab, rs, R, sq, t);
        const float* x = l == 0 ? (R < NTOKP ? F.in(I_XP) + (size_t)R * D : F.in(I_XS) + (size_t)(R - NTOKP) * D) : F.out() + (size_t)R * D;
        const float* ad = F.ADA() + (size_t)(l * 32 + sq) * 6144;
        f32x4 v[8]; float ss = 0.f;
#pragma unroll
        for (int i = 0; i < 8; ++i) { v[i] = *(const f32x4*)(x + (i * 64 + F.lane) * 4); ss += v[i][0] * v[i][0] + v[i][1] * v[i][1] + v[i][2] * v[i][2] + v[i][3] * v[i][3]; }
        ss = wave_sum(ss);
        const float r = rsqrtf(ss * (1.0f / 2048.0f) + EPS);
#pragma unroll
        for (int i = 0; i < 8; ++i) { const int c = (i * 64 + F.lane) * 4;
            const f32x4 w = *(const f32x4*)(nw + c), sh = *(const f32x4*)(ad + c), sc = *(const f32x4*)(ad + 2048 + c);
            const f32x4 hv = v[i] * r * w * (sc + 1.0f) + sh;
            u32x2 p; p.x = pk_f16(hv[0], hv[1]); p.y = pk_f16(hv[2], hv[3]);
            *(u32x2*)(F.H() + (size_t)rs * 2048 + c) = p; }
    }
    if (slab == 0) {
        const size_t gid = (size_t)F.bid * NTHR + F.tid, gsz = (size_t)F.G * NTHR;
        const size_t nk = (size_t)16 * PAST * 32;
        for (size_t g = gid; g < nk; g += gsz) {
            const size_t b = g / (PAST * 32), rem = g % (PAST * 32), p = rem >> 5, c8 = (rem & 31) * 8;
            const size_t so = (size_t)l * 16 * PAST * 256 + g * 8, dof = ((size_t)32768 + b * LSMP + p) * 256 + c8;
            { const f32x4 a = *(const f32x4*)(F.in(I_CK) + so), bb = *(const f32x4*)(F.in(I_CK) + so + 4);
              u32x4 w; w.x = pk_f16(a[0], a[1]); w.y = pk_f16(a[2], a[3]); w.z = pk_f16(bb[0], bb[1]); w.w = pk_f16(bb[2], bb[3]); *(u32x4*)(F.KU() + dof) = w; }
            { const f32x4 a = *(const f32x4*)(F.in(I_CV) + so), bb = *(const f32x4*)(F.in(I_CV) + so + 4);
              u32x4 w; w.x = pk_f16(a[0], a[1]); w.y = pk_f16(a[2], a[3]); w.z = pk_f16(bb[0], bb[1]); w.w = pk_f16(bb[2], bb[3]); *(u32x4*)(F.VU() + dof) = w; }
        }
        const size_t ni = (size_t)16 * PAST * 8;
        for (size_t g = gid; g < ni; g += gsz) {
            const size_t b = g / (PAST * 8), rem = g % (PAST * 8), p = rem >> 3, c8 = (rem & 7) * 8;
            const size_t so = (size_t)l * 16 * PAST * 64 + g * 8, dof = ((size_t)32768 + b * LSMP + p) * 64 + c8;
            const f32x4 a = *(const f32x4*)(F.in(I_CIK) + so), bb = *(const f32x4*)(F.in(I_CIK) + so + 4);
            u32x4 w; w.x = pk_f16(a[0], a[1]); w.y = pk_f16(a[2], a[3]); w.z = pk_f16(bb[0], bb[1]); w.w = pk_f16(bb[2], bb[3]); *(u32x4*)(F.KIU() + dof) = w;
        }
    }
}

DI unsigned sortable(float f) { const unsigned u = __float_as_uint(f); return (u & 0x80000000u) ? ~u : (u | 0x80000000u); }


typedef float f32x16 __attribute__((ext_vector_type(16)));
typedef __fp16 fp16x4_t __attribute__((__vector_size__(4 * sizeof(__fp16))));
#define MFMA32(a, b, c) __builtin_amdgcn_mfma_f32_32x32x16_f16((a), (b), (c), 0, 0, 0)
constexpr int AT_KV = 0, AT_BUF = 34816, AT_V = 17408, AT_ROW = 272;
constexpr int AT_QI = 0, AT_QIS = 1032;
constexpr int AT_MASK = 69632, AT_BT = AT_MASK + 32 * 65 * 8, AT_WI = AT_BT + 16 * 192 * 4, AT_END = AT_WI + 32 * 16 * 4;
static_assert(AT_END <= LDS_MISC && 32 * AT_QIS * 2 <= AT_MASK, "attention LDS map");
constexpr float LOG2E = 1.4426950408889634f, SCL2 = 0.08838834764831845f * LOG2E;


constexpr int GX = 0, GX_S = 392, GTAB = 50176, GAT = GTAB + 1536, GAT_S = 68, GTM = GAT + 17408, GT_S = 72, GKB = GTM + 9216, GVB = GKB + 18432, GPRE_END = GVB + 18432;
static_assert(GPRE_END <= LDS_MISC, "gdn pre LDS map");
DI void gdn_pre_unit(const Frame& F0, int l, int slab, int c, int hd) {
    const Frame F = F0.fresh();
    const int tid = F.tid, lane = F.lane, wave = F.wave, r32 = lane & 31, h2 = lane >> 5;
    LAS unsigned char* lds = F.lds;
    LAS f16* X = (LAS f16*)(lds + GX);
    LAS float* TAB = (LAS float*)(lds + GTAB);
    LAS float* AT = (LAS float*)(lds + GAT);
    LAS f16* TM = (LAS f16*)(lds + GTM);
    LAS f16* KB = (LAS f16*)(lds + GKB);
    LAS f16* VB = (LAS f16*)(lds + GVB);
    const bool smp = c >= 128;
    const int sq = smp ? 16 + (c - 128) : slab * 4 + (c >> 5), n = smp ? 0 : (c & 31), b = sq & 15;
    const int rsb = smp ? 8192 + (sq - 16) * 64 : (sq - slab * 4) * 2048 + n * 64;
    const int Rb = smp ? NTOKP + (sq - 16) * 64 : sq * 2048 + n * 64;
    const f16* PROJ = F.PROJ();
    unsigned char* gp = F.ws() + WS_GP + (size_t)(c * 16 + hd) * GP_STRIDE;
    {
        const float* wcv = F.in(I_WCONV) + (size_t)l * 4 * 6144;
        const float* scv = F.in(I_SC) + (size_t)(l * 16 + b) * 3 * 6144;
#pragma unroll 1
        for (int it = 0; it < 6; ++it) {
            const int item = tid + NTHR * it, tok = item / 48, cg = item % 48, gch = (cg >> 4) * 2048 + hd * 128 + (cg & 15) * 8;
            float acc[8];
#pragma unroll
            for (int j = 0; j < 8; ++j) acc[j] = 0.f;
#pragma unroll
            for (int tap = 0; tap < 4; ++tap) {
                const int tt = tok - 3 + tap;
                float x[8];
                if (tt >= 0 || n > 0) { const h8 hv = *(const h8*)(PROJ + (size_t)(rsb + tt) * PS + gch);
#pragma unroll
                    for (int j = 0; j < 8; ++j) x[j] = (float)hv[j]; }
                else if (smp) { const f32x4 a = *(const f32x4*)(scv + (size_t)(3 + tt) * 6144 + gch), bq = *(const f32x4*)(scv + (size_t)(3 + tt) * 6144 + gch + 4);
                    x[0] = a[0]; x[1] = a[1]; x[2] = a[2]; x[3] = a[3]; x[4] = bq[0]; x[5] = bq[1]; x[6] = bq[2]; x[7] = bq[3]; }
                else {
#pragma unroll
                    for (int j = 0; j < 8; ++j) x[j] = 0.f; }
                const f32x4 w0 = *(const f32x4*)(wcv + tap * 6144 + gch), w1 = *(const f32x4*)(wcv + tap * 6144 + gch + 4);
#pragma unroll
                for (int j = 0; j < 4; ++j) { acc[j] += w0[j] * x[j]; acc[4 + j] += w1[j] * x[4 + j]; }
            }
            h8 y;
#pragma unroll
            for (int j = 0; j < 8; ++j) y[j] = (f16)siluf_(acc[j]);
            *(LAS h8*)(X + tok * GX_S + cg * 8) = y;
        }
        if (tid < 64) {
            const float be = F.BETA()[(size_t)(Rb + tid) * 16 + hd];
            float gcv = F.GG()[(size_t)(Rb + tid) * 16 + hd];
#pragma unroll
            for (int o = 1; o < 64; o <<= 1) { const float tv = __shfl_up(gcv, o); if (lane >= o) gcv += tv; }
            const float gl = __shfl(gcv, 63);
            TAB[128 + tid] = be; TAB[192 + tid] = gcv; TAB[256 + tid] = __expf(gcv); TAB[320 + tid] = __expf(gl - gcv);
            if (tid == 63) ((float*)(F.ws() + WS_GL))[c * 16 + hd] = __expf(gl);
        }
    }
    __syncthreads();
    {
        const int tok = tid >> 3, part = tid & 7;
        float sq_ = 0.f, sk_ = 0.f;
#pragma unroll
        for (int u = 0; u < 2; ++u) { const h8 a = *(const LAS h8*)(X + tok * GX_S + part * 16 + u * 8), k = *(const LAS h8*)(X + tok * GX_S + 128 + part * 16 + u * 8);
#pragma unroll
            for (int j = 0; j < 8; ++j) { sq_ += (float)a[j] * (float)a[j]; sk_ += (float)k[j] * (float)k[j]; } }
#pragma unroll
        for (int o = 4; o > 0; o >>= 1) { sq_ += __shfl_xor(sq_, o); sk_ += __shfl_xor(sk_, o); }
        if (part == 0) { TAB[tok] = rsqrtf(sq_ + EPS) * 0.08838834764831845f; TAB[64 + tok] = rsqrtf(sk_ + EPS); }
    }
    __syncthreads();
#pragma unroll 1
    for (int it = 0; it < 4; ++it) {
        const int item = tid + NTHR * it, img = item >> 10, rem = item & 1023, d = rem & 127, tg = rem >> 7;
        h8 o;
#pragma unroll
        for (int jj = 0; jj < 8; ++jj) { const int tok = 8 * tg + jj; const float x = (float)X[tok * GX_S + (img ? 256 : 128) + d];
            const float sc = img ? TAB[128 + tok] : TAB[64 + tok] * TAB[128 + tok] * TAB[256 + tok]; o[jj] = (f16)(x * sc); }
        *(LAS h8*)((img ? VB : KB) + d * GT_S + 8 * tg) = o;
    }
#pragma unroll 1
    for (int it = 0; it < 4; ++it) {
        const int item = tid + NTHR * it, which = item >> 10, rem = item & 1023, tok = rem >> 4, c8 = (rem & 15) * 8;
        const h8 xv = *(const LAS h8*)(X + tok * GX_S + (which ? 128 : 0) + c8);
        const float sc = which ? TAB[64 + tok] * TAB[320 + tok] : TAB[tok] * TAB[256 + tok];
        h8 o;
#pragma unroll
        for (int j = 0; j < 8; ++j) o[j] = (f16)((float)xv[j] * sc);
        *(h8*)(gp + (which ? GP_KD : GP_QD) + (tok * 128 + c8) * 2) = o;
    }
    if (wave < 6) {
        const bool isqk = wave >= 3; const int ti = isqk ? wave - 3 : wave;
        const int rt = (ti == 2 ? 1 : 0), ct = (ti == 0 ? 0 : 1);
        f32x16 acc;
#pragma unroll
        for (int i = 0; i < 16; ++i) acc[i] = 0.f;
#pragma unroll
        for (int s = 0; s < 8; ++s) { const h8 a = *(const LAS h8*)(X + (32 * rt + r32) * GX_S + 128 + 16 * s + 8 * h2);
            const h8 bq = *(const LAS h8*)(X + (32 * ct + r32) * GX_S + (isqk ? 0 : 128) + 16 * s + 8 * h2); acc = MFMA32(a, bq, acc); }
        const int col = 32 * ct + r32;
        if (!isqk) {
            const float bk = TAB[128 + col] * TAB[64 + col], gck = TAB[192 + col];
#pragma unroll
            for (int g = 0; g < 4; ++g) { const int j0 = 32 * rt + 8 * g + 4 * h2;
                const f32x4 rk = *(const LAS f32x4*)(TAB + 64 + j0), gj = *(const LAS f32x4*)(TAB + 192 + j0);
                f32x4 v;
#pragma unroll
                for (int jj = 0; jj < 4; ++jj) v[jj] = (col > j0 + jj) ? bk * rk[jj] * acc[4 * g + jj] * __expf(fminf(gck - gj[jj], 0.f)) : 0.f;
                *(LAS f32x4*)(AT + col * GAT_S + j0) = v; }
        } else {
            const float rqi = TAB[col], gci = TAB[192 + col];
#pragma unroll
            for (int g = 0; g < 4; ++g) { const int j0 = 32 * rt + 8 * g + 4 * h2;
                const f32x4 rk = *(const LAS f32x4*)(TAB + 64 + j0), gj = *(const LAS f32x4*)(TAB + 192 + j0);
                h4 v;
#pragma unroll
                for (int jj = 0; jj < 4; ++jj) v[jj] = (f16)((col >= j0 + jj) ? rqi * rk[jj] * acc[4 * g + jj] * __expf(fminf(gci - gj[jj], 0.f)) : 0.f);
                *(h4*)(gp + GP_QK + (col * 64 + j0) * 2) = v; }
        }
    } else if (wave == 6) {
#pragma unroll
        for (int u = 0; u < 4; ++u) { const int p = lane + 64 * u, i = p >> 3, j0 = 32 + (p & 7) * 4; *(h4*)(gp + GP_QK + (i * 64 + j0) * 2) = (h4){(f16)0.f, (f16)0.f, (f16)0.f, (f16)0.f}; }
    }
    __syncthreads();
    {
        LAS float* TF = (LAS float*)(lds + GX);
        LAS float* PT = TF + 64 * GAT_S;
        if (wave == 0) {
            const int o = 16 * (lane >> 4), cc = lane & 15;
#pragma unroll 1
            for (int i = 0; i < 16; ++i) {
                float sacc = (i == cc) ? 1.f : 0.f;
#pragma unroll
                for (int j = 0; j < 15; ++j) { if (j < i) sacc -= AT[(o + i) * GAT_S + o + j] * TF[(o + j) * GAT_S + o + cc]; }
                TF[(o + i) * GAT_S + o + cc] = sacc;
            }
        }
        __syncthreads();
        {
            const int bs = 32 * (tid >> 8), i = (tid >> 4) & 15, cc = tid & 15;
            float p = 0.f;
#pragma unroll
            for (int k = 0; k < 16; ++k) p += AT[(bs + 16 + i) * GAT_S + bs + k] * TF[(bs + k) * GAT_S + bs + cc];
            PT[tid] = p;
            TF[(bs + i) * GAT_S + bs + 16 + cc] = 0.f;
            __syncthreads();
            float v = 0.f;
#pragma unroll
            for (int k = 0; k < 16; ++k) v -= TF[(bs + 16 + i) * GAT_S + bs + 16 + k] * PT[(tid & 256) + k * 16 + cc];
            TF[(bs + 16 + i) * GAT_S + bs + cc] = v;
        }
        __syncthreads();
        {
            float p[2];
#pragma unroll
            for (int u = 0; u < 2; ++u) { const int e = tid + NTHR * u, i = e >> 5, cc = e & 31; float a = 0.f;
#pragma unroll 8
                for (int k = 0; k < 32; ++k) a += AT[(32 + i) * GAT_S + k] * TF[k * GAT_S + cc];
                p[u] = a; }
            PT[tid] = p[0]; PT[tid + NTHR] = p[1];
            __syncthreads();
#pragma unroll
            for (int u = 0; u < 2; ++u) { const int e = tid + NTHR * u, i = e >> 5, cc = e & 31; float v = 0.f;
#pragma unroll 8
                for (int k = 0; k < 32; ++k) v -= TF[(32 + i) * GAT_S + 32 + k] * PT[k * 32 + cc];
                TF[(32 + i) * GAT_S + cc] = v; }
        }
        __syncthreads();
        {
            const int i = tid >> 3, jg = tid & 7; h8 o;
#pragma unroll
            for (int jj = 0; jj < 8; ++jj) o[jj] = (i < 32 && jg >= 4) ? (f16)0.f : (f16)TF[i * GAT_S + 8 * jg + jj];
            *(LAS h8*)(TM + i * GT_S + 8 * jg) = o;
        }
    }
    __syncthreads();
    {
        const int mt = wave & 3, nt = wave >> 2;
        f32x16 aw, au;
#pragma unroll
        for (int i = 0; i < 16; ++i) { aw[i] = 0.f; au[i] = 0.f; }
#pragma unroll
        for (int s = 0; s < 4; ++s) {
            const h8 tb = *(const LAS h8*)(TM + (32 * nt + r32) * GT_S + 16 * s + 8 * h2);
            const h8 ka = *(const LAS h8*)(KB + (32 * mt + r32) * GT_S + 16 * s + 8 * h2);
            const h8 vb = *(const LAS h8*)(VB + (32 * mt + r32) * GT_S + 16 * s + 8 * h2);
            aw = MFMA32(ka, tb, aw);
            au = MFMA32(tb, vb, au);
        }
#pragma unroll
        for (int g = 0; g < 4; ++g) {
            h4 w4, u4;
#pragma unroll
            for (int jj = 0; jj < 4; ++jj) { w4[jj] = (f16)aw[4 * g + jj]; u4[jj] = (f16)au[4 * g + jj]; }
            *(h4*)(gp + GP_W + ((32 * nt + r32) * 128 + 32 * mt + 8 * g + 4 * h2) * 2) = w4;
            *(h4*)(gp + GP_U + (((mt * 2 + nt) * 4 + g) * 64 + lane) * 8) = u4;
        }
    }
    __syncthreads();
}

constexpr int SC_W = 0, SC_QD = 17408, SC_KD = 34816, SC_QK = 52224, SC_BUF = 61440, SC_SSQ = 2 * SC_BUF, SC_END = SC_SSQ + 1024;
static_assert(SC_END <= LDS_MISC, "gdn scan LDS map");
DI void gdn_scan_unit(const Frame& F0, int l, int slab, int sq, int hd) {
    const Frame F = F0.fresh();
    const int tid = F.tid, lane = F.lane, wave = F.wave, r32 = lane & 31, h2 = lane >> 5;
    const int i16 = lane & 15, q4 = i16 >> 2, p4 = i16 & 3, blk = (lane >> 4) & 1;
    LAS unsigned char* lds = F.lds;
    LAS float* ssq = (LAS float*)(lds + SC_SSQ);
    const bool smp = sq >= 16; const int b = sq & 15, nch = smp ? 1 : 32;
    const int c0 = smp ? 128 + (sq - 16) : (sq - slab * 4) * 32;
    const int rs0 = smp ? 8192 + (sq - 16) * 64 : (sq - slab * 4) * 2048;
    const unsigned char* gpb = F.ws() + WS_GP + (size_t)hd * GP_STRIDE;
    const float* GLp = (const float*)(F.ws() + WS_GL);
    const int w = wave;
    f32x16 S[4];
    if (wave < 4) {
        const float* s0 = F.in(I_SG) + ((size_t)(l * 16 + b) * 16 + hd) * 16384;
#pragma unroll
        for (int mt = 0; mt < 4; ++mt)
#pragma unroll
            for (int i = 0; i < 16; ++i) S[mt][i] = smp ? s0[(32 * mt + (i & 3) + 8 * (i >> 2) + 4 * h2) * 128 + 32 * w + r32] : 0.f;
    }
    const int lt = tid - 256;
#define SC_STAGE(cc, bufi) do { const unsigned char* src = gpb + (size_t)(cc) * 16 * GP_STRIDE; LAS unsigned char* dst = lds + (bufi) * SC_BUF; \
        u32x4 t0[4], t1[4], t2[4], t3[2]; \
        _Pragma("unroll") for (int it = 0; it < 4; ++it) { const int i = lt + 256 * it, row = i >> 4, c8 = (i & 15) * 8; const int go = (row * 128 + c8) * 2; \
            t0[it] = *(const u32x4*)(src + GP_W + go); t1[it] = *(const u32x4*)(src + GP_QD + go); t2[it] = *(const u32x4*)(src + GP_KD + go); } \
        _Pragma("unroll") for (int it = 0; it < 2; ++it) { const int i = lt + 256 * it, row = i >> 3, c8 = (i & 7) * 8; t3[it] = *(const u32x4*)(src + GP_QK + (row * 64 + c8) * 2); } \
        _Pragma("unroll") for (int it = 0; it < 4; ++it) { const int i = lt + 256 * it, row = i >> 4, c8 = (i & 15) * 8; const int lo = row * 272 + c8 * 2; \
            *(LAS u32x4*)(dst + SC_W + lo) = t0[it]; *(LAS u32x4*)(dst + SC_QD + lo) = t1[it]; *(LAS u32x4*)(dst + SC_KD + lo) = t2[it]; } \
        _Pragma("unroll") for (int it = 0; it < 2; ++it) { const int i = lt + 256 * it, row = i >> 3, c8 = (i & 7) * 8; *(LAS u32x4*)(dst + SC_QK + row * 144 + c8 * 2) = t3[it]; } } while (0)
    if (wave >= 4) SC_STAGE(c0, 0);
    __syncthreads();
    const float gnw0 = 0.f; (void)gnw0;
#pragma unroll 1
    for (int n = 0; n < nch; ++n) {
        const int c = c0 + n;
        LAS unsigned char* bufp = lds + (n & 1) * SC_BUF;
        f32x16 oT[2];
        h8 VNp[2][2];
        if (wave >= 4) { if (n + 1 < nch) SC_STAGE(c + 1, (n + 1) & 1); }
        else {
            const unsigned char* up = gpb + (size_t)c * 16 * GP_STRIDE + GP_U;
            h4 uf[2][4];
#pragma unroll
            for (int tm = 0; tm < 2; ++tm)
#pragma unroll
                for (int g = 0; g < 4; ++g) uf[tm][g] = *(const h4*)(up + (((w * 2 + tm) * 4 + g) * 64 + lane) * 8);
            h8 Sp[4][2];
#pragma unroll
            for (int mt = 0; mt < 4; ++mt)
#pragma unroll
                for (int ks = 0; ks < 2; ++ks) { h8 t;
#pragma unroll
                    for (int jj = 0; jj < 8; ++jj) t[jj] = (f16)S[mt][8 * ks + jj];
                    Sp[mt][ks] = t; }
#pragma unroll
            for (int tm = 0; tm < 2; ++tm) {
                f32x16 ws;
#pragma unroll
                for (int i = 0; i < 16; ++i) ws[i] = 0.f;
#pragma unroll
                for (int mt = 0; mt < 4; ++mt)
#pragma unroll
                    for (int ks = 0; ks < 2; ++ks) {
                        LAS unsigned char* ap = bufp + SC_W + (32 * tm + r32) * 272 + 2 * (32 * mt + 16 * ks + 4 * h2);
                        const h4 lo = *(const LAS h4*)ap, hi = *(const LAS h4*)(ap + 16);
                        ws = MFMA32(__builtin_shufflevector(lo, hi, 0, 1, 2, 3, 4, 5, 6, 7), Sp[mt][ks], ws);
                    }
#pragma unroll
                for (int g = 0; g < 4; ++g)
#pragma unroll
                    for (int jj = 0; jj < 4; ++jj) ws[4 * g + jj] = (float)uf[tm][g][jj] - ws[4 * g + jj];
#pragma unroll
                for (int ks = 0; ks < 2; ++ks) { h8 t;
#pragma unroll
                    for (int jj = 0; jj < 8; ++jj) t[jj] = (f16)ws[8 * ks + jj];
                    VNp[tm][ks] = t; }
            }
#pragma unroll
            for (int tn = 0; tn < 2; ++tn) {
                f32x16 o;
#pragma unroll
                for (int i = 0; i < 16; ++i) o[i] = 0.f;
#pragma unroll
                for (int mt = 0; mt < 4; ++mt)
#pragma unroll
                    for (int ks = 0; ks < 2; ++ks) {
                        LAS unsigned char* bp = bufp + SC_QD + (32 * tn + r32) * 272 + 2 * (32 * mt + 16 * ks + 4 * h2);
                        const h4 lo = *(const LAS h4*)bp, hi = *(const LAS h4*)(bp + 16);
                        o = MFMA32(Sp[mt][ks], __builtin_shufflevector(lo, hi, 0, 1, 2, 3, 4, 5, 6, 7), o);
                    }
#pragma unroll
                for (int tm = 0; tm < 2; ++tm)
#pragma unroll
                    for (int ks = 0; ks < 2; ++ks) {
                        LAS unsigned char* bp = bufp + SC_QK + (32 * tn + r32) * 144 + 2 * (32 * tm + 16 * ks + 4 * h2);
                        const h4 lo = *(const LAS h4*)bp, hi = *(const LAS h4*)(bp + 16);
                        o = MFMA32(VNp[tm][ks], __builtin_shufflevector(lo, hi, 0, 1, 2, 3, 4, 5, 6, 7), o);
                    }
                oT[tn] = o;
                float sacc = 0.f;
#pragma unroll
                for (int i = 0; i < 16; ++i) sacc += o[i] * o[i];
                sacc += __shfl_xor(sacc, 32);
                if (h2 == 0) ssq[w * 64 + 32 * tn + r32] = sacc;
            }
        }
        __syncthreads();
        if (wave < 4) {
            const float* gnw = F.in(I_GNW) + l * 128;
            const f16* PROJ = F.PROJ();
#pragma unroll
            for (int tn = 0; tn < 2; ++tn) {
                const int tok = 32 * tn + r32;
                const float tot = ssq[tok] + ssq[64 + tok] + ssq[128 + tok] + ssq[192 + tok];
                const float rstd = rsqrtf(tot * (1.0f / 128.0f) + EPS);
                const size_t rs = (size_t)(rs0 + 64 * n + tok);
#pragma unroll
                for (int g = 0; g < 4; ++g) {
                    const int dv0 = 32 * w + 8 * g + 4 * h2;
                    const f32x4 gw = *(const f32x4*)(gnw + dv0);
                    const h4 za = *(const h4*)(PROJ + rs * PS + C_ZA + hd * 128 + dv0);
                    h4 ov;
#pragma unroll
                    for (int jj = 0; jj < 4; ++jj) ov[jj] = (f16)(oT[tn][4 * g + jj] * rstd * gw[jj] * (float)za[jj]);
                    *(h4*)(F.OA() + rs * 2048 + hd * 128 + dv0) = ov;
                }
            }
            const float gl = GLp[c * 16 + hd];
#pragma unroll
            for (int mt = 0; mt < 4; ++mt) {
#pragma unroll
                for (int i = 0; i < 16; ++i) S[mt][i] *= gl;
#pragma unroll
                for (int tm = 0; tm < 2; ++tm)
#pragma unroll
                    for (int ks = 0; ks < 2; ++ks) {
                        LAS unsigned char* ap = bufp + SC_KD + (32 * tm + 16 * ks + 4 * h2 + q4) * 272 + 64 * mt + 8 * (4 * blk + p4);
                        const fp16x4_t lo = __builtin_amdgcn_ds_read_tr16_b64_v4f16((LAS fp16x4_t*)ap);
                        const fp16x4_t hi = __builtin_amdgcn_ds_read_tr16_b64_v4f16((LAS fp16x4_t*)(ap + 8 * 272));
                        const h8 a = __builtin_shufflevector(__builtin_bit_cast(h4, lo), __builtin_bit_cast(h4, hi), 0, 1, 2, 3, 4, 5, 6, 7);
                        S[mt] = MFMA32(a, VNp[tm][ks], S[mt]);
                    }
            }
        }
        __syncthreads();
    }
#undef SC_STAGE
    if (wave < 4) {
        float* so = F.out() + (smp ? O_NGS : O_NGP) + ((size_t)(l * 16 + b) * 16 + hd) * 16384;
#pragma unroll
        for (int mt = 0; mt < 4; ++mt)
#pragma unroll
            for (int i = 0; i < 16; ++i) so[(32 * mt + (i & 3) + 8 * (i >> 2) + 4 * h2) * 128 + 32 * w + r32] = S[mt][i];
    }
    __syncthreads();
}

template <int NKMAX>
DI void select_rows(const float* scr, LAS unsigned long long* mask, int wave, int lane, int nk, int nvis) {
#pragma unroll 1
    for (int r = 0; r < 4; ++r) {
        const int q = wave * 4 + r;
        unsigned u[NKMAX];
#pragma unroll
        for (int k = 0; k < NKMAX; ++k) u[k] = (k < nk) ? sortable(scr[(size_t)q * LDR + 64 * k + lane]) : 0u;
        unsigned thr = 0u;
        if (nvis > 256) {
#pragma unroll 1
            for (int bit = 31; bit >= 0; --bit) {
                const unsigned cand = thr | (1u << bit);
                int c = 0;
#pragma unroll
                for (int k = 0; k < NKMAX; ++k) c += (int)__popcll(__ballot(u[k] >= cand));
                if (c >= 256) thr = cand;
            }
        }
#pragma unroll
        for (int k = 0; k < NKMAX; ++k) { const unsigned long long bal = __ballot(u[k] >= thr); if (k < nk && lane == 0) mask[q * 65 + k] = bal; }
    }
}

DI void attn_step3(const Frame& F, LAS unsigned char* lds, LAS unsigned long long* mask, LAS float* bt, const f16* PROJ, int rs0, int qpos0, int nk, int pb);
DI void attn_unit(const Frame& F0, int l, int slab, int rs0) {
    const Frame F = F0.fresh();
    const int tid = F.tid, lane = F.lane, wave = F.wave, r32 = lane & 31, h2 = lane >> 5;
    LAS unsigned char* lds = F.lds;
    LAS unsigned long long* mask = (LAS unsigned long long*)(lds + AT_MASK);
    LAS float* bt = (LAS float*)(lds + AT_BT);
    LAS float* wil = (LAS float*)(lds + AT_WI);
    int R0, sq, t0; rowinfo(slab, rs0, R0, sq, t0);
    const bool smp = sq >= 16;
    const int qpos0 = (smp ? PAST : 0) + t0, nvis = 64 * (qpos0 / 64 + 1), nk = nvis >> 6, pb = posbase(sq);
    float* scr = (float*)(F.ws() + WS_SCR) + (size_t)F.bid * 32 * LDR;
    const f16* PROJ = F.PROJ();
#pragma unroll
    for (int it = 0; it < 8; ++it) { const int i = tid + NTHR * it, row = i >> 7, c8 = (i & 127) * 8;
        *(LAS h8*)(lds + AT_QI + (row * AT_QIS + c8) * 2) = *(const h8*)(PROJ + (size_t)(rs0 + row) * PS + C_QI + c8); }
    { const float* rb = F.in(I_RELB);
      for (int i = tid; i < 16 * 192; i += NTHR) { const int h = i / 192, rel = (i % 192) - 128; bt[i] = rb[rel_bucket(rel) * 16 + h] * LOG2E; } }
    wil[tid] = F.WI()[(size_t)(R0 + (tid >> 4)) * 16 + (tid & 15)];
    __syncthreads();
    {
        const f16* KI = F.KIU();
#pragma unroll 1
        for (int p = wave; p < nk; p += 8) {
            h8 a[2][4];
#pragma unroll
            for (int tl = 0; tl < 2; ++tl)
#pragma unroll
                for (int s = 0; s < 4; ++s) a[tl][s] = *(const h8*)(KI + (size_t)(pb + 64 * p + 32 * tl + r32) * 64 + 16 * s + 8 * h2);
            f32x16 sc0, sc1;
#pragma unroll
            for (int i = 0; i < 16; ++i) { sc0[i] = 0.f; sc1[i] = 0.f; }
#pragma unroll 2
            for (int h = 0; h < 16; ++h) {
                h8 b[4];
#pragma unroll
                for (int s = 0; s < 4; ++s) b[s] = *(const LAS h8*)(lds + AT_QI + (r32 * AT_QIS + h * 64 + 16 * s + 8 * h2) * 2);
                f32x16 c0, c1;
#pragma unroll
                for (int i = 0; i < 16; ++i) { c0[i] = 0.f; c1[i] = 0.f; }
#pragma unroll
                for (int s = 0; s < 4; ++s) { c0 = MFMA32(a[0][s], b[s], c0); c1 = MFMA32(a[1][s], b[s], c1); }
                const float w = wil[r32 * 16 + h];
#pragma unroll
                for (int i = 0; i < 16; ++i) { sc0[i] += w * fmaxf(c0[i], 0.f); sc1[i] += w * fmaxf(c1[i], 0.f); }
            }
            float* o = scr + (size_t)r32 * LDR + 64 * p + 4 * h2;
#pragma unroll
            for (int g = 0; g < 4; ++g) { *(f32x4*)(o + 8 * g) = (f32x4){sc0[4 * g], sc0[4 * g + 1], sc0[4 * g + 2], sc0[4 * g + 3]};
                                          *(f32x4*)(o + 32 + 8 * g) = (f32x4){sc1[4 * g], sc1[4 * g + 1], sc1[4 * g + 2], sc1[4 * g + 3]}; }
        }
    }
    asm volatile("s_waitcnt vmcnt(0)" ::: "memory");
    __syncthreads();
    __builtin_amdgcn_fence(__ATOMIC_ACQUIRE, "agent");
    { int lane2 = lane; asm volatile("" : "+v"(lane2));
      if (smp) select_rows<65>(scr, mask, wave, lane2, nk, nvis); else select_rows<32>(scr, mask, wave, lane2, nk, nvis); }
    __syncthreads();
    attn_step3(F, lds, mask, bt, PROJ, rs0, qpos0, nk, pb);
}
DI void attn_step3(const Frame& F, LAS unsigned char* lds, LAS unsigned long long* mask, LAS float* bt, const f16* PROJ, int rs0, int qpos0, int nk, int pb) {
    int tid = threadIdx.x; asm volatile("" : "+v"(tid));
    const int lane = tid & 63, wave = __builtin_amdgcn_readfirstlane(tid >> 6), r32 = lane & 31, h2 = lane >> 5;
    const f16* KU = F.KU(); const f16* VU = F.VU();
    const int i16 = lane & 15, q4 = i16 >> 2, p4 = i16 & 3, blk = (lane >> 4) & 1;
#pragma unroll 1
    for (int n = 0; n < 2; ++n) {
        const int hq = 8 * n + wave;
        h8 qf[8];
#pragma unroll
        for (int s = 0; s < 8; ++s) qf[s] = *(const h8*)(PROJ + (size_t)(rs0 + r32) * PS + C_QB + hq * 128 + 16 * s + 8 * h2);
        const float b15 = bt[hq * 192];
        f32x16 O[4];
#pragma unroll
        for (int mt = 0; mt < 4; ++mt)
#pragma unroll
            for (int i = 0; i < 16; ++i) O[mt][i] = 0.f;
        float m = -1e30f, lsum = 0.f;
        u32x4 kreg[2], vreg[2];
        const int srow = tid >> 4, sc8 = (tid & 15) * 8;
#define AT_LOAD(j) do { _Pragma("unroll") for (int it = 0; it < 2; ++it) { const size_t go = (size_t)(pb + 64 * (j) + srow + 32 * it) * 256 + n * 128 + sc8; \
            kreg[it] = *(const u32x4*)(KU + go); vreg[it] = *(const u32x4*)(VU + go); } } while (0)
#define AT_STORE(b) do { _Pragma("unroll") for (int it = 0; it < 2; ++it) { const int lo = AT_KV + (b) * AT_BUF + (srow + 32 * it) * AT_ROW + sc8 * 2; \
            *(LAS u32x4*)(lds + lo) = kreg[it]; *(LAS u32x4*)(lds + lo + AT_V) = vreg[it]; } } while (0)
        AT_LOAD(0); AT_STORE(0);
        __syncthreads();
#pragma unroll 1
        for (int j = 0; j < nk; ++j) {
            const bool more = (j + 1) < nk;
            if (more) AT_LOAD(j + 1);
            LAS unsigned char* kb = lds + AT_KV + (j & 1) * AT_BUF;
            LAS unsigned char* vb = kb + AT_V;
            f32x16 st[2];
#pragma unroll
            for (int sub = 0; sub < 2; ++sub) {
#pragma unroll
                for (int i = 0; i < 16; ++i) st[sub][i] = 0.f;
#pragma unroll
                for (int s = 0; s < 8; ++s) { const h8 a = *(const LAS h8*)(kb + (32 * sub + r32) * AT_ROW + 32 * s + 16 * h2); st[sub] = MFMA32(a, qf[s], st[sub]); }
            }
            const bool far = (64 * j + 63 - qpos0) <= -128;
            float mx = -1e30f;
            if (far) {
#pragma unroll
                for (int sub = 0; sub < 2; ++sub)
#pragma unroll
                    for (int i = 0; i < 16; ++i) { st[sub][i] = st[sub][i] * SCL2 + b15; mx = fmaxf(mx, st[sub][i]); }
            } else {
                const int relb = 64 * j + 4 * h2 - (qpos0 + r32) + 128;
#pragma unroll
                for (int sub = 0; sub < 2; ++sub)
#pragma unroll
                    for (int i = 0; i < 16; ++i) { int ri = relb + 32 * sub + (i & 3) + 8 * (i >> 2); ri = ri < 0 ? 0 : ri;
                        st[sub][i] = st[sub][i] * SCL2 + bt[hq * 192 + ri]; mx = fmaxf(mx, st[sub][i]); }
            }
            mx = fmaxf(mx, __shfl_xor(mx, 32));
            const float mnew = fmaxf(m, mx), alpha = __builtin_amdgcn_exp2f(m - mnew);
            m = mnew;
            const unsigned long long mw = mask[r32 * 65 + j];
            float ps = 0.f;
            h8 pf[2][2];
#pragma unroll
            for (int sub = 0; sub < 2; ++sub) {
                const unsigned wsh = ((unsigned)(mw >> (32 * sub))) >> (4 * h2);
#pragma unroll
                for (int i = 0; i < 16; ++i) { const float e = __builtin_amdgcn_exp2f(st[sub][i] - mnew);
                    const float pv = (wsh & (1u << ((i & 3) + 8 * (i >> 2)))) ? e : 0.f; st[sub][i] = pv; ps += pv; }
#pragma unroll
                for (int ks = 0; ks < 2; ++ks) { h8 t;
#pragma unroll
                    for (int jj = 0; jj < 8; ++jj) t[jj] = (f16)st[sub][8 * ks + jj];
                    pf[sub][ks] = t; }
            }
            lsum = lsum * alpha + ps;
            if (__any(alpha != 1.0f)) {
#pragma unroll
                for (int mt = 0; mt < 4; ++mt)
#pragma unroll
                    for (int i = 0; i < 16; ++i) O[mt][i] *= alpha;
            }
#pragma unroll
            for (int mt = 0; mt < 4; ++mt)
#pragma unroll
                for (int sub = 0; sub < 2; ++sub)
#pragma unroll
                    for (int ks = 0; ks < 2; ++ks) {
                        LAS unsigned char* ap = vb + (32 * sub + 16 * ks + 4 * h2 + q4) * AT_ROW + 64 * mt + 8 * (4 * blk + p4);
                        const fp16x4_t lo = __builtin_amdgcn_ds_read_tr16_b64_v4f16((LAS fp16x4_t*)ap);
                        const fp16x4_t hi = __builtin_amdgcn_ds_read_tr16_b64_v4f16((LAS fp16x4_t*)(ap + 8 * AT_ROW));
                        const h4 l4 = __builtin_bit_cast(h4, lo), h4v = __builtin_bit_cast(h4, hi);
                        const h8 a = __builtin_shufflevector(l4, h4v, 0, 1, 2, 3, 4, 5, 6, 7);
                        O[mt] = MFMA32(a, pf[sub][ks], O[mt]);
                    }
            if (more) AT_STORE((j + 1) & 1);
            __syncthreads();
        }
#undef AT_LOAD
#undef AT_STORE
        const float ltot = lsum + __shfl_xor(lsum, 32), inv = 1.0f / ltot;
        const size_t orow = (size_t)(rs0 + r32);
#pragma unroll
        for (int mt = 0; mt < 4; ++mt)
#pragma unroll
            for (int g = 0; g < 4; ++g) {
                const int d = hq * 128 + 32 * mt + 8 * g + 4 * h2;
                const h4 zb = *(const h4*)(PROJ + orow * PS + C_ZB + d);
                h4 ov;
#pragma unroll
                for (int jj = 0; jj < 4; ++jj) ov[jj] = (f16)(O[mt][4 * g + jj] * inv * (float)zb[jj]);
                *(h4*)(F.OB() + orow * 2048 + d) = ov;
            }
    }
    __syncthreads();
}

DI void phase_mix(const Frame F0, int l, int slab) {
    const Frame F = F0.fresh();
    LAS int* ubox = (LAS int*)(F.lds + LDS_MISC + 64);
    unsigned* ctr = F.ctl() + CW_Q + (l * NSLAB + slab) * 64;
    const int Ts = ts_of(slab);
    const int nchp = 64, nchs = slab == 0 ? 256 : 0, nch = nchp + nchs;
    for (;;) {
        if (F.tid == 0) ubox[0] = (int)__hip_atomic_fetch_add(ctr, 1u, __ATOMIC_RELAXED, __HIP_MEMORY_SCOPE_AGENT);
        __syncthreads();
        const int u = ubox[0];
        __syncthreads();
        if (u >= nch + Ts / 32) break;
        if (u < nchp) gdn_scan_unit(F, l, slab, slab * 4 + (u >> 4), u & 15);
        else if (u < nch) { const int v = u - nchp; gdn_scan_unit(F, l, slab, 16 + (v >> 4), v & 15); }
        else {
            int q = u - nch, rs0;
            if (slab == 0 && q < 32) rs0 = 8192 + 32 * q;
            else { if (slab == 0) q -= 32; rs0 = (q & 3) * 2048 + (63 - (q >> 2)) * 32; }
            attn_unit(F, l, slab, rs0);
        }
    }
}

DI void phase_pre(const Frame F0, int l, int slab) {
    const int nc = slab == 0 ? 144 : 128;
    for (int u = F0.bid; u < nc * 16; u += F0.G) gdn_pre_unit(F0, l, slab, u >> 4, u & 15);
}
DI void phase_final(const Frame F0) {
    const Frame F = F0.fresh();
    const float* nw = F.in(I_FNW);
    for (int R = F.bid * NWAVES + F.wave; R < NTOK; R += F.G * NWAVES) {
        float* x = F.out() + (size_t)R * D;
        f32x4 v[8]; float ss = 0.f;
#pragma unroll
        for (int i = 0; i < 8; ++i) { v[i] = *(const f32x4*)(x + (i * 64 + F.lane) * 4); ss += v[i][0] * v[i][0] + v[i][1] * v[i][1] + v[i][2] * v[i][2] + v[i][3] * v[i][3]; }
        ss = wave_sum(ss);
        const float r = rsqrtf(ss * (1.0f / 2048.0f) + EPS);
#pragma unroll
        for (int i = 0; i < 8; ++i) { const int c = (i * 64 + F.lane) * 4; *(f32x4*)(x + c) = v[i] * r * *(const f32x4*)(nw + c); }
    }
}

DI void phase_inproj(const Frame F, int l, int s) {
    const int Ts = ts_of(s);
    pg8::Gemm g{F.H(), F.WIN() + (size_t)l * NP * 2048, F.H(), F.WIN() + (size_t)l * NP * 2048, Ts, NP, 2048};
    pg8::StaticOrder S; S.init(Ts, NP, F.G, F.bid);
    EpiProj E{F.PROJ(), F.out(), F.KU(), F.VU(), F.KIU(), F.WI(), F.BETA(), F.GG(), F.in(I_ALOG) + l * 16, F.in(I_DTB) + l * 16, l, s};
    pg8::gemm_phase<EpiProj, pg8::StaticOrder>(F.lds, g, S, E);
}
DI void phase_ab(const Frame F, int l, int s) {
    const int Ts = ts_of(s);
    pg8::Gemm g{F.OA(), F.WA() + (size_t)l * 2048 * 2048, F.OB(), F.WB() + (size_t)l * 2048 * 2048, Ts, 2048, 2048};
    pg8::DualOrder S; S.init(Ts, 2048, F.G, F.bid);
    EpiAB E{F.PROJ(), F.H()};
    pg8::gemm_phase<EpiAB, pg8::DualOrder>(F.lds, g, S, E);
}
DI void phase_outp(const Frame F, int l, int s) {
    const int Ts = ts_of(s);
    pg8::Gemm g{F.H(), F.WO() + (size_t)l * 2048 * 2048, F.H(), F.WO() + (size_t)l * 2048 * 2048, Ts, 2048, 2048};
    pg8::StaticOrder S; S.init(Ts, 2048, F.G, F.bid);
    EpiOut E{F.in(I_XP), F.in(I_XS), F.out(), F.ADA() + (size_t)l * 32 * 6144, l, s};
    pg8::gemm_phase<EpiOut, pg8::StaticOrder>(F.lds, g, S, E);
}
constexpr int NPH = 6;
constexpr int N_PHASES = 1 + 2 * NSLAB * NPH + 1;
__global__ void __launch_bounds__(NTHR, 2) fwd_kernel(Args args) {
    extern __shared__ __attribute__((aligned(16))) unsigned char lds[];
    Frame F;
    F.lds = (LAS unsigned char*)lds;
    F.tid = threadIdx.x; F.lane = F.tid & 63; F.wave = __builtin_amdgcn_readfirstlane(F.tid >> 6); F.G = gridDim.x; F.bid = blockIdx.x;
    if (F.tid < 22) *(LAS unsigned long long*)(F.lds + LDS_TAB + 8 * F.tid) = (unsigned long long)args.in[F.tid];
    if (F.tid == 22) *(LAS unsigned long long*)(F.lds + LDS_TAB + 8 * 22) = (unsigned long long)args.out;
    if (F.tid == 23) *(LAS unsigned long long*)(F.lds + LDS_TAB + 8 * 23) = (unsigned long long)args.ws;
    volatile LAS unsigned* MISC = (volatile LAS unsigned*)(F.lds + LDS_MISC);
    if (F.tid < 64) MISC[F.tid] = 0u;
    __syncthreads();
    const int lo = args.ph_lo, hi = args.ph_hi;
    const bool multi = (hi - lo) > 1;
    if (multi) (void)xcd_barrier_post(F.ctl() + CW_BAR, MISC);
#define IN(k) (lo <= (k) && (k) < hi)
#define SEAM(k) do { if (IN(k) && IN((k) + 1)) { XcdBarrier bar_; bar_.bar = F.ctl() + CW_BAR; bar_.x = xb_xcc_id(); bar_.st = MISC; xcd_barrier(bar_); } } while (0)
    if (IN(0)) { p0_prologue(F); }
    SEAM(0);
    for (int l = 0; l < 2; ++l)
        for (int s = 0; s < NSLAB; ++s) {
            const int pb = 1 + (l * NSLAB + s) * NPH;
            if (IN(pb)) phase_norm(F, l, s);
            SEAM(pb);
            if (IN(pb + 1)) phase_inproj(F, l, s);
            SEAM(pb + 1);
            if (IN(pb + 2)) phase_pre(F, l, s);
            SEAM(pb + 2);
            if (IN(pb + 3)) phase_mix(F, l, s);
            SEAM(pb + 3);
            if (IN(pb + 4)) phase_ab(F, l, s);
            SEAM(pb + 4);
            if (IN(pb + 5)) phase_outp(F, l, s);
            SEAM(pb + 5);
        }
    if (IN(N_PHASES - 1)) phase_final(F);
#undef IN
#undef SEAM
}

extern "C" void kernel_launch(void* const* d_in, const int* in_sizes, int n_in, void* d_out, int out_size, void* d_ws, size_t ws_size, hipStream_t stream) {
    static int grid = 0;
    if (grid == 0) {
        if (n_in != 22 || (size_t)out_size != O_END || ws_size < WS_END) { fprintf(stderr, "kernel_launch: unexpected shapes (n_in %d out %d ws %zu, need %zu)\n", n_in, out_size, ws_size, (size_t)WS_END); grid = -1; return; }
        int dev = 0, cus = 0, per_cu = 0;
        if (hipGetDevice(&dev) != hipSuccess || hipDeviceGetAttribute(&cus, hipDeviceAttributeMultiprocessorCount, dev) != hipSuccess) { grid = -1; return; }
        if (hipFuncSetAttribute((const void*)fwd_kernel, hipFuncAttributeMaxDynamicSharedMemorySize, LDS_BYTES) != hipSuccess) { fprintf(stderr, "kernel_launch: hipFuncSetAttribute failed\n"); grid = -1; return; }
        if (hipOccupancyMaxActiveBlocksPerMultiprocessor(&per_cu, (const void*)fwd_kernel, NTHR, LDS_BYTES) != hipSuccess || per_cu < 1) { fprintf(stderr, "kernel_launch: occupancy query says %d\n", per_cu); }
        (void)hipGetLastError();
        grid = cus;
    }
    if (grid < 0) return;
    (void)hipMemsetAsync((char*)d_ws + WS_CTL, 0, CTL_BYTES, stream);
    Args a{};
    for (int i = 0; i < 22; ++i) a.in[i] = (const float*)d_in[i];
    a.out = (float*)d_out; a.ws = (unsigned char*)d_ws;
#if MK_ONE_LAUNCH
    a.ph_lo = 0; a.ph_hi = N_PHASES;
    hipLaunchKernelGGL(fwd_kernel, dim3(grid), dim3(NTHR), LDS_BYTES, stream, a);
#else
    for (int p = 0; p < N_PHASES; ++p) { a.ph_lo = p; a.ph_hi = p + 1; hipLaunchKernelGGL(fwd_kernel, dim3(grid), dim3(NTHR), LDS_BYTES, stream, a); }
#endif
}
```

```cpp
#include <hip/hip_runtime.h>
#include <cstdio>
#include <cstdint>

#ifndef PROBE_REP
#define PROBE_REP 0
#endif
#ifndef MK_ONE_LAUNCH
#define MK_ONE_LAUNCH 1
#endif

#define LAS __attribute__((address_space(3)))
typedef _Float16 f16;
typedef _Float16 h8 __attribute__((ext_vector_type(8)));
typedef _Float16 h4 __attribute__((ext_vector_type(4)));
typedef _Float16 h2 __attribute__((ext_vector_type(2)));
typedef float f32x4 __attribute__((ext_vector_type(4)));
typedef float f32x2 __attribute__((ext_vector_type(2)));
typedef unsigned u32x4 __attribute__((ext_vector_type(4)));
typedef unsigned u32x2 __attribute__((ext_vector_type(2)));
#define DI __device__ __forceinline__

constexpr int D = 2048, NTOKP = 32768, NTOKS = 1024, NTOK = NTOKP + NTOKS;
constexpr int IN_DIM = 18032, NP = 18176, PS = 17408;
constexpr int LSMP = 4160, PAST = 4096;
constexpr int NSLAB = 4, NWAVES = 8, NTHR = 512;
constexpr int C_QKV = 0, C_ZA = 6144, C_QB = 8192, C_ZB = 10240, C_QI = 12288, C_GA = 13312, C_GB = 15360;
constexpr float EPS = 1e-6f;
constexpr int NPOS = 16 * 2048 + 16 * LSMP;

constexpr size_t O_YP = 0, O_YS = O_YP + (size_t)NTOKP * D, O_NKP = O_YS + (size_t)NTOKS * D, O_NVP = O_NKP + (size_t)2 * 16 * 2048 * 256,
    O_NIP = O_NVP + (size_t)2 * 16 * 2048 * 256, O_NGP = O_NIP + (size_t)2 * 16 * 2048 * 64, O_NCP = O_NGP + (size_t)2 * 16 * 16 * 16384,
    O_NKS = O_NCP + (size_t)2 * 16 * 3 * 6144, O_NVS = O_NKS + (size_t)2 * 16 * 64 * 256, O_NIS = O_NVS + (size_t)2 * 16 * 64 * 256,
    O_NGS = O_NIS + (size_t)2 * 16 * 64 * 64, O_NCS = O_NGS + (size_t)2 * 16 * 16 * 16384, O_END = O_NCS + (size_t)2 * 16 * 3 * 6144;
static_assert(O_END == 126091264ull, "output size");

constexpr size_t al256(size_t x) { return (x + 255) & ~(size_t)255; }
constexpr size_t WS_CTL = 0, CTL_BYTES = 1u << 20;
constexpr size_t WS_ADA = WS_CTL + CTL_BYTES;
constexpr size_t WS_WIN = al256(WS_ADA + (size_t)2 * 32 * 6144 * 4);
constexpr size_t WS_WA = al256(WS_WIN + (size_t)2 * NP * 2048 * 2);
constexpr size_t WS_WB = al256(WS_WA + (size_t)2 * 2048 * 2048 * 2);
constexpr size_t WS_WO = al256(WS_WB + (size_t)2 * 2048 * 2048 * 2);
constexpr size_t WS_H = al256(WS_WO + (size_t)2 * 2048 * 2048 * 2);
constexpr size_t WS_PROJ = al256(WS_H + (size_t)9216 * 2048 * 2);
constexpr size_t WS_OA = al256(WS_PROJ + (size_t)9216 * PS * 2);
constexpr size_t WS_OB = al256(WS_OA + (size_t)9216 * 2048 * 2);
constexpr size_t WS_KU = al256(WS_OB + (size_t)9216 * 2048 * 2);
constexpr size_t WS_VU = al256(WS_KU + (size_t)NPOS * 256 * 2);
constexpr size_t WS_KIU = al256(WS_VU + (size_t)NPOS * 256 * 2);
constexpr size_t WS_WI = al256(WS_KIU + (size_t)NPOS * 64 * 2);
constexpr size_t WS_BETA = al256(WS_WI + (size_t)NTOK * 16 * 4);
constexpr size_t WS_G = al256(WS_BETA + (size_t)NTOK * 16 * 4);
constexpr int LDR = 4160;
constexpr size_t WS_SCR = al256(WS_G + (size_t)NTOK * 16 * 4);
constexpr int GP_W = 0, GP_QD = 16384, GP_KD = 32768, GP_U = 49152, GP_QK = 65536, GP_STRIDE = 73728;
constexpr size_t WS_GP = al256(WS_SCR + (size_t)256 * 32 * LDR * 4);
constexpr size_t WS_GL = al256(WS_GP + (size_t)144 * 16 * GP_STRIDE);
constexpr size_t WS_END = al256(WS_GL + (size_t)144 * 16 * 4);

constexpr int LDS_BYTES = 147456, LDS_MISC = 131072;

#define XB_TMO      128
#define XB_XCNT(j)  (256  + 64 * (j))
#define XB_XSUB(j)  (1280 + 64 * (j))
#define XB_XGEN(j)  (2304 + 64 * (j))
#define XB_TOP      3328
#define XB_TOPGEN   3392
#define XCD_BAR_WORDS 3456
#define XB_SPIN_CAP (1u << 18)
__device__ __forceinline__ unsigned xb_ld(unsigned* p)              { return __hip_atomic_load(p, __ATOMIC_RELAXED, __HIP_MEMORY_SCOPE_AGENT); }
__device__ __forceinline__ unsigned xb_add(unsigned* p, unsigned v) { return __hip_atomic_fetch_add(p, v, __ATOMIC_RELAXED, __HIP_MEMORY_SCOPE_AGENT); }
__device__ __forceinline__ unsigned xb_xcc_id() { return (unsigned)__builtin_amdgcn_s_getreg((3 << 11) | 20) & 0xFu; }
#define XB_SPIN(cond, bar) do { unsigned _sp = 0; while (cond) { __builtin_amdgcn_s_sleep(1); \
    if ((++_sp & 255u) == 0u) { if (xb_ld(&(bar)[XB_TMO])) break; if (_sp > XB_SPIN_CAP) { atomicAdd(&(bar)[XB_TMO], 1u); break; } } } } while (0)
struct XcdBarrier { unsigned* bar; unsigned x; volatile LAS unsigned* st; };
__device__ __forceinline__ XcdBarrier xcd_barrier_post(unsigned* bar, volatile LAS unsigned* st) {
    XcdBarrier b; b.bar = bar; b.x = xb_xcc_id(); b.st = st;
    if (threadIdx.x == 0) (void)xb_add(&bar[XB_XCNT(b.x)], 1u);
    return b;
}
__device__ __forceinline__ void xcd_barrier_complete(unsigned* bar, unsigned x, unsigned& nloc, unsigned& nx) {
    const unsigned G = gridDim.x * gridDim.y * gridDim.z;
    unsigned sum, cnt, mine, sp = 0u;
    for (;;) {
        sum = 0u; cnt = 0u; mine = 0u;
#pragma unroll
        for (unsigned j = 0; j < 16; ++j) { const unsigned c = xb_ld(&bar[XB_XCNT(j)]); sum += c; cnt += (c > 0u) ? 1u : 0u; mine = (j == x) ? c : mine; }
        if (sum == G) break;
        __builtin_amdgcn_s_sleep(1);
        if ((++sp & 255u) == 0u) { if (xb_ld(&bar[XB_TMO])) break; if (sp > XB_SPIN_CAP) { atomicAdd(&bar[XB_TMO], 1u); break; } }
    }
    nloc = mine > 0u ? mine : 1u; nx = cnt > 0u ? cnt : 1u;
}
__device__ __forceinline__ void xcd_barrier(const XcdBarrier b, const int leader) {
    asm volatile("s_waitcnt vmcnt(0)" ::: "memory");
    __syncthreads();
    if (leader) {
        unsigned* bar = b.bar;
        __builtin_amdgcn_s_waitcnt(0);
        unsigned nloc = b.st[0], nx = b.st[1];
        if (nloc == 0u) { xcd_barrier_complete(bar, b.x, nloc, nx); b.st[0] = nloc; b.st[1] = nx; }
        const unsigned old = xb_add(&bar[XB_XSUB(b.x)], 1u);
        const unsigned gen = old / nloc;
        if (old + 1u == (gen + 1u) * nloc) {
            __builtin_amdgcn_fence(__ATOMIC_RELEASE, "agent");
            asm volatile("s_waitcnt vmcnt(0)" ::: "memory");
            const unsigned og = xb_add(&bar[XB_TOP], 1u);
            const unsigned tg = og / nx;
            if (og + 1u == (tg + 1u) * nx) xb_add(&bar[XB_TOPGEN], 1u);
            else XB_SPIN(xb_ld(&bar[XB_TOPGEN]) == tg, bar);
            __builtin_amdgcn_fence(__ATOMIC_ACQUIRE, "agent");
            xb_add(&bar[XB_XGEN(b.x)], 1u);
            asm volatile("s_waitcnt vmcnt(0)" ::: "memory");
        } else {
            XB_SPIN(xb_ld(&bar[XB_XGEN(b.x)]) == gen, bar);
            __builtin_amdgcn_fence(__ATOMIC_ACQUIRE, "agent");
            asm volatile("s_waitcnt vmcnt(0)" ::: "memory");
        }
    }
    __syncthreads();
}

DI int lane_id_fresh() { unsigned z = 0u; asm volatile("" : "+v"(z)); return (int)__builtin_amdgcn_mbcnt_hi(~0u, __builtin_amdgcn_mbcnt_lo(~0u, z)); }
template <int O> DI float swz_xor(float v) { return __builtin_bit_cast(float, __builtin_amdgcn_ds_swizzle(__builtin_bit_cast(int, v), (O << 10) | 0x1F)); }
DI float shx32(float v, int lane) { return __builtin_bit_cast(float, __builtin_amdgcn_ds_bpermute((lane ^ 32) << 2, __builtin_bit_cast(int, v))); }
DI float wave_sum(float v, int lane) {
    v += swz_xor<1>(v); v += swz_xor<2>(v); v += swz_xor<4>(v); v += swz_xor<8>(v); v += swz_xor<16>(v);
    return v + shx32(v, lane);
}
DI float sigmoidf_(float x) { return 1.0f / (1.0f + __expf(-x)); }
DI float siluf_(float x) { return x / (1.0f + __expf(-x)); }
DI unsigned pk_f16(float lo, float hi) { h2 v = {(f16)lo, (f16)hi}; return __builtin_bit_cast(unsigned, v); }
DI void rowinfo(int slab, int rs, int& R, int& sq, int& t) {
    if (rs < 8192) { R = slab * 8192 + rs; sq = R >> 11; t = R & 2047; }
    else { const int q = rs - 8192; R = NTOKP + q; sq = 16 + (q >> 6); t = q & 63; }
}
DI int posbase(int sq) { return sq < 16 ? sq * 2048 : 32768 + (sq - 16) * LSMP; }
__host__ __device__ inline int ts_of(int slab) { return slab == 0 ? 9216 : 8192; }
DI int proj_src_col(int n) {
    if (n < 8192) return n;
    if (n < 10240) return 8224 + (n - 8192);
    if (n < 12288) return 10784 + (n - 10240);
    if (n < 13312) return 12832 + (n - 12288);
    if (n < 15360) return 13936 + (n - 13312);
    if (n < 17408) return 15984 + (n - 15360);
    if (n < 17664) return 10272 + (n - 17408);
    if (n < 17920) return 10528 + (n - 17664);
    const int j = n - 17920;
    if (j < 64) return 13856 + j;
    if (j < 80) return 13920 + (j - 64);
    if (j < 96) return 8192 + (j - 80);
    if (j < 112) return 8208 + (j - 96);
    return -1;
}
DI int rel_bucket(int rel) {
    const int n = rel < 0 ? -rel : rel;
    const int v = n < 8 ? n : (n < 12 ? 8 : n < 16 ? 9 : n < 23 ? 10 : n < 32 ? 11 : n < 46 ? 12 : n < 64 ? 13 : n < 91 ? 14 : 15);
    return (rel > 0 ? 16 : 0) + v;
}

namespace pg8 {
constexpr int BM = 256, BK = 64, HALF = 128, HTB = HALF * BK * 2, STAGE_BYTES = 8 * HTB, NXCD = 8, WGM = 8;
DI int lds_byte(int r, int c) { const int st = (r >> 4) * 2 + (c >> 5), rr = r & 15, cc = c & 31, ob = rr * 64 + cc * 2; return st * 1024 + (ob ^ (((ob >> 9) & 1) << 5)); }
DI void stage_rc(int b, int& R, int& C) { const int st = b / 1024, sb = b % 1024, swz = sb ^ (((sb >> 9) & 1) << 5); R = (st >> 1) * 16 + swz / 64; C = (st & 1) * 32 + (swz % 64) / 2; }
DI int perm32(int rho) { const int n = rho >> 4, i = rho & 15; return 8 * (i >> 2) + 4 * n + (i & 3); }

struct Unit { int pm, pn, which; };
struct Gemm { const f16* A0; const f16* B0; const f16* A1; const f16* B1; int M, N, K; };

struct StaticOrder {
    int nM, nN, nwg, G, c;
    DI void init(int M, int N, int G_, int c_) { nM = M / BM; nN = N / BM; nwg = nM * nN; G = G_; c = c_; }
    DI bool tile(long L, Unit& u) const {
        if (L >= nwg) return false;
        int wgid = (int)L; { const int q = nwg / NXCD, r = nwg % NXCD, xcd = wgid % NXCD, off = wgid / NXCD; wgid = (xcd < r ? xcd * (q + 1) : r * (q + 1) + (xcd - r) * q) + off; }
        const int nig = WGM * nN, gid = wgid / nig, fm = gid * WGM, gsz = (nM - fm) < WGM ? (nM - fm) : WGM;
        u.pm = fm + ((wgid % nig) % gsz); u.pn = (wgid % nig) / gsz; return true;
    }
    DI bool next(int i, Unit& u) const { u.which = 0; return tile((long)i * G + c, u); }
};
struct DualOrder : StaticOrder {
    DI bool next(int i, Unit& u) const { u.which = i & 1; return tile((long)(i >> 1) * G + c, u); }
};

template <class Epi, class Sched, bool ALIGN_EPI = true>
DI void gemm_phase(LAS unsigned char* lds, const Gemm g, const Sched& S, const Epi& E, int wave_s) {
    int tid_ = lane_id_fresh() + wave_s * 64; asm volatile("" : "+v"(tid_));
    const int tid = tid_, wid = __builtin_amdgcn_readfirstlane(tid >> 6), lane = tid & 63, wr = wid >> 2, wc = wid & 3, fr = lane & 15, fq = lane >> 4;
    const int K = g.K, nt = K / BK;
    unsigned voffA[2], voffB[2];
#pragma unroll
    for (int i = 0; i < 2; ++i) { int R, C; stage_rc(tid * 16 + i * 8192, R, C); const int Rb = (R & ~31) + perm32(R & 31);
        voffA[i] = (unsigned)(R * K + C) * 2u; voffB[i] = (unsigned)(Rb * K + C) * 2u; }
    const size_t kstep = (size_t)(BK * 2);
    const size_t hstep = (size_t)HALF * K * 2;
    const size_t tstep = 2 * hstep;
    const unsigned ldsw = (unsigned)wid * 1024u;
    const int aoff = lds_byte(wr * 64 + fr, fq * 8), boff = lds_byte(wc * 32 + fr, fq * 8);
#define PG8_SA(b, h) (((b) * 2 + (h)) * HTB)
#define PG8_SB(b, h) ((4 + (b) * 2 + (h)) * HTB)
#define PG8_STAGE(bufoff, gbase, voff) do { _Pragma("unroll") for (int _i = 0; _i < 2; ++_i) \
        __builtin_amdgcn_global_load_lds((const unsigned*)((const char*)(gbase) + (voff)[_i]), (LAS unsigned*)(lds + (bufoff) + ldsw + _i * 8192), 16, 0, 0); } while (0)
#define PG8_LDA(dst, b, h) do { _Pragma("unroll") for (int m = 0; m < 4; ++m) _Pragma("unroll") for (int k = 0; k < 2; ++k) dst[m][k] = *(const LAS h8*)(lds + PG8_SA(b, h) + aoff + m * 2048 + k * 1024); } while (0)
#define PG8_LDB(dst, b, h) do { _Pragma("unroll") for (int n = 0; n < 2; ++n) _Pragma("unroll") for (int k = 0; k < 2; ++k) dst[n][k] = *(const LAS h8*)(lds + PG8_SB(b, h) + boff + n * 2048 + k * 1024); } while (0)
#define PG8_MMA(ai, bj, At, Bt) do { __builtin_amdgcn_s_setprio(1); _Pragma("unroll") for (int m = 0; m < 4; ++m) _Pragma("unroll") for (int n = 0; n < 2; ++n) _Pragma("unroll") for (int k = 0; k < 2; ++k) \
        acc[ai][bj][m][n] = __builtin_amdgcn_mfma_f32_16x16x32_f16(Bt[n][k], At[m][k], acc[ai][bj][m][n], 0, 0, 0); __builtin_amdgcn_s_setprio(0); } while (0)
#define PG8_WAIT_V(n) asm volatile("s_waitcnt vmcnt(" #n ")" ::: "memory")
#define PG8_WAIT_L(n) asm volatile("s_waitcnt lgkmcnt(" #n ")" ::: "memory")
#define PG8_BAR __builtin_amdgcn_s_barrier()
#define PG8_SCHED __builtin_amdgcn_sched_barrier(0)
    Unit cur, nxt; int ui = 0;
    if (!S.next(0, cur)) return;
    f32x4 acc[2][2][4][2];
#pragma unroll
    for (int a = 0; a < 2; ++a)
#pragma unroll
        for (int b = 0; b < 2; ++b)
#pragma unroll
            for (int m = 0; m < 4; ++m)
#pragma unroll
                for (int n = 0; n < 2; ++n) acc[a][b][m][n] = (f32x4){0.f, 0.f, 0.f, 0.f};
    h8 At[4][2], B0[2][2], B1[2][2];
    const char* cA = (const char*)(cur.which ? g.A1 : g.A0) + (size_t)cur.pm * tstep; const char* cB = (const char*)(cur.which ? g.B1 : g.B0) + (size_t)cur.pn * tstep;
    PG8_STAGE(PG8_SB(0, 0), cB, voffB); PG8_STAGE(PG8_SB(0, 1), cB + hstep, voffB); PG8_STAGE(PG8_SA(0, 0), cA, voffA); PG8_STAGE(PG8_SA(0, 1), cA + hstep, voffA);
    if (wr == 1) PG8_BAR;
    PG8_WAIT_V(2); PG8_BAR;
    PG8_STAGE(PG8_SB(1, 0), cB + kstep, voffB); PG8_STAGE(PG8_SA(1, 0), cA + kstep, voffA); PG8_STAGE(PG8_SB(1, 1), cB + hstep + kstep, voffB);
    PG8_WAIT_V(6); PG8_BAR;
    for (;;) {
        const bool has_next = S.next(ui + 1, nxt);
        const char* nA = has_next ? (const char*)(nxt.which ? g.A1 : g.A0) + (size_t)nxt.pm * tstep : cA; const char* nB = has_next ? (const char*)(nxt.which ? g.B1 : g.B0) + (size_t)nxt.pn * tstep : cB;
        for (int t = 0; t < nt; t += 2) {
            const bool last = (t == nt - 2);
            const char* a1 = cA + (size_t)(t + 1) * kstep;
            const char* a2 = last ? nA : cA + (size_t)(t + 2) * kstep; const char* b2 = last ? nB : cB + (size_t)(t + 2) * kstep;
            const char* a3 = a2 + kstep; const char* b3 = b2 + kstep;
            PG8_LDB(B0, 0, 0); PG8_LDB(B1, 0, 1); PG8_SCHED; PG8_LDA(At, 0, 0); PG8_STAGE(PG8_SA(1, 1), a1 + hstep, voffA);
            PG8_WAIT_V(8); PG8_WAIT_L(0); PG8_BAR; PG8_MMA(0, 0, At, B0); PG8_MMA(0, 1, At, B1); PG8_BAR; PG8_SCHED;
            PG8_LDA(At, 0, 1); PG8_STAGE(PG8_SB(0, 0), b2, voffB); PG8_STAGE(PG8_SB(0, 1), b2 + hstep, voffB); PG8_STAGE(PG8_SA(0, 0), a2, voffA);
            PG8_WAIT_V(8); PG8_WAIT_L(0); PG8_BAR; PG8_MMA(1, 0, At, B0); PG8_MMA(1, 1, At, B1); PG8_BAR; PG8_SCHED;
            PG8_LDB(B0, 1, 0); PG8_LDB(B1, 1, 1); PG8_SCHED; PG8_LDA(At, 1, 0); PG8_STAGE(PG8_SA(0, 1), a2 + hstep, voffA);
            PG8_WAIT_V(8); PG8_WAIT_L(0); PG8_BAR; PG8_MMA(0, 0, At, B0); PG8_MMA(0, 1, At, B1); PG8_BAR; PG8_SCHED;
            PG8_LDA(At, 1, 1); PG8_STAGE(PG8_SB(1, 0), b3, voffB); PG8_STAGE(PG8_SB(1, 1), b3 + hstep, voffB); PG8_STAGE(PG8_SA(1, 0), a3, voffA);
            PG8_WAIT_V(8); PG8_WAIT_L(0); PG8_BAR; PG8_MMA(1, 0, At, B0); PG8_MMA(1, 1, At, B1); PG8_BAR; PG8_SCHED;
        }
        if constexpr (ALIGN_EPI) { if (wr == 0) PG8_BAR; }
        E(acc, cur, wr, wc, fr, fq);
        if (!has_next) break;
#pragma unroll
        for (int a = 0; a < 2; ++a)
#pragma unroll
            for (int b = 0; b < 2; ++b)
#pragma unroll
                for (int m = 0; m < 4; ++m)
#pragma unroll
                    for (int n = 0; n < 2; ++n) acc[a][b][m][n] = (f32x4){0.f, 0.f, 0.f, 0.f};
        cur = nxt; cA = nA; cB = nB; ++ui;
        if constexpr (ALIGN_EPI) { if (wr == 1) PG8_BAR; }
    }
    PG8_WAIT_V(0);
    if constexpr (!ALIGN_EPI) { if (wr == 0) PG8_BAR; }
    PG8_BAR;
#undef PG8_SA
#undef PG8_SB
#undef PG8_STAGE
#undef PG8_LDA
#undef PG8_LDB
#undef PG8_MMA
#undef PG8_WAIT_V
#undef PG8_WAIT_L
#undef PG8_BAR
#undef PG8_SCHED
}
}

struct Args { const float* in[22]; float* out; unsigned char* ws; int ph_lo, ph_hi; };
constexpr int LDS_TAB = LDS_MISC + 256;
DI unsigned long long ldtab(LAS unsigned char* lds, int i) {
    const unsigned vx = *(const volatile LAS unsigned*)(lds + LDS_TAB + 8 * i), vy = *(const volatile LAS unsigned*)(lds + LDS_TAB + 8 * i + 4); u32x2 v; v.x = vx; v.y = vy;
    return ((unsigned long long)(unsigned)__builtin_amdgcn_readfirstlane((int)v.y) << 32) | (unsigned)__builtin_amdgcn_readfirstlane((int)v.x);
}
struct Frame {
    LAS unsigned char* lds; int tid, lane, wave, G, bid;
    DI Frame fresh() const { Frame f = *this; int t = lane_id_fresh() + wave * 64; asm volatile("" : "+v"(t)); f.tid = t; f.lane = t & 63; f.wave = wave; return f; }
    DI const float* in(int i) const { return (const float*)ldtab(lds, i); }
    DI float* out() const { return (float*)ldtab(lds, 22); }
    DI unsigned char* ws() const { return (unsigned char*)ldtab(lds, 23); }
    DI unsigned* ctl() const { return (unsigned*)(ws() + WS_CTL); }
    DI float* ADA() const { return (float*)(ws() + WS_ADA); }
    DI f16* WIN() const { return (f16*)(ws() + WS_WIN); }
    DI f16* WA() const { return (f16*)(ws() + WS_WA); }
    DI f16* WB() const { return (f16*)(ws() + WS_WB); }
    DI f16* WO() const { return (f16*)(ws() + WS_WO); }
    DI f16* H() const { return (f16*)(ws() + WS_H); }
    DI f16* PROJ() const { return (f16*)(ws() + WS_PROJ); }
    DI f16* OA() const { return (f16*)(ws() + WS_OA); }
    DI f16* OB() const { return (f16*)(ws() + WS_OB); }
    DI f16* KU() const { return (f16*)(ws() + WS_KU); }
    DI f16* VU() const { return (f16*)(ws() + WS_VU); }
    DI f16* KIU() const { return (f16*)(ws() + WS_KIU); }
    DI float* WI() const { return (float*)(ws() + WS_WI); }
    DI float* BETA() const { return (float*)(ws() + WS_BETA); }
    DI float* GG() const { return (float*)(ws() + WS_G); }
};
enum { I_XP = 0, I_XS, I_CP, I_CS, I_CK, I_CV, I_CIK, I_SG, I_SC, I_NW, I_WADA, I_BADA, I_WIN, I_WCONV, I_ALOG, I_DTB, I_GNW, I_WBA, I_WBB, I_WOUT, I_RELB, I_FNW };
constexpr int CW_BAR = 0, CW_Q = 4096;

struct EpiProj {
    static constexpr bool PERM = true;
    f16* proj; float* out; f16 *KU, *VU, *KIU; float *WI, *BETA, *GG; const float *a_log, *dt_bias; int layer, slab;
    DI void operator()(const f32x4 (&acc)[2][2][4][2], const pg8::Unit& u, int wr, int wc, int fr_, int fq_) const {
        int fr = fr_, fq = fq_; asm volatile("" : "+v"(fr), "+v"(fq));
        const int pn = u.pn;
        const int rsb = u.pm * 256 + wr * 64 + fr;
        if (pn < 68) {
            const int act = ((pn >= 24 && pn < 32) || (pn >= 40 && pn < 48)) ? 1 : (pn >= 52 ? 2 : 0);
            const int col0 = pn * 256 + wc * 32 + 8 * fq;
#pragma unroll
            for (int ai = 0; ai < 2; ++ai)
#pragma unroll
                for (int m = 0; m < 4; ++m) {
                    f16* rowp = proj + (size_t)(rsb + ai * 128 + m * 16) * PS + col0;
#pragma unroll
                    for (int bj = 0; bj < 2; ++bj) {
                        f32x4 v0 = acc[ai][bj][m][0], v1 = acc[ai][bj][m][1];
                        if (act == 1) {
#pragma unroll
                            for (int j = 0; j < 4; ++j) { v0[j] = siluf_(v0[j]); v1[j] = siluf_(v1[j]); }
                        } else if (act == 2) {
#pragma unroll
                            for (int j = 0; j < 4; ++j) { v0[j] = sigmoidf_(v0[j]); v1[j] = sigmoidf_(v1[j]); }
                        }
                        u32x4 w; w.x = pk_f16(v0[0], v0[1]); w.y = pk_f16(v0[2], v0[3]); w.z = pk_f16(v1[0], v1[1]); w.w = pk_f16(v1[2], v1[3]);
                        *(u32x4*)(rowp + bj * 128) = w;
                    }
                }
            if (pn < 24 && fr >= 13) {
                const bool smp = u.pm >= 32;
                if (smp || (u.pm & 7) == 7) {
#pragma unroll
                    for (int ai = 0; ai < 2; ++ai) {
                        if (!smp && !(ai == 1 && wr == 1)) continue;
                        int R, sq, t; rowinfo(slab, rsb + ai * 128 + 48, R, sq, t);
                        const int T = smp ? 64 : 2048;
                        float* base = out + (smp ? O_NCS : O_NCP) + ((size_t)(layer * 16 + (sq & 15)) * 3 + (t - (T - 3))) * 6144 + col0;
#pragma unroll
                        for (int bj = 0; bj < 2; ++bj) { *(f32x4*)(base + bj * 128) = acc[ai][bj][3][0]; *(f32x4*)(base + bj * 128 + 4) = acc[ai][bj][3][1]; }
                    }
                }
            }
        } else {
#pragma unroll
            for (int ai = 0; ai < 2; ++ai)
#pragma unroll
                for (int m = 0; m < 4; ++m) {
                    int R, sq, t; rowinfo(slab, rsb + ai * 128 + m * 16, R, sq, t);
                    const bool smp = sq >= 16; const int b = sq & 15;
                    const size_t pos = (size_t)posbase(sq) + (smp ? PAST : 0) + t;
#pragma unroll
                    for (int bj = 0; bj < 2; ++bj) {
                        const int c = bj * 128 + wc * 32 + 8 * fq;
                        const f32x4 v0 = acc[ai][bj][m][0], v1 = acc[ai][bj][m][1];
                        if (pn < 70) {
                            float* o = out + (pn == 68 ? (smp ? O_NKS : O_NKP) : (smp ? O_NVS : O_NVP)) + ((size_t)(layer * 16 + b) * (smp ? 64 : 2048) + t) * 256 + c;
                            *(f32x4*)o = v0; *(f32x4*)(o + 4) = v1;
                            u32x4 w; w.x = pk_f16(v0[0], v0[1]); w.y = pk_f16(v0[2], v0[3]); w.z = pk_f16(v1[0], v1[1]); w.w = pk_f16(v1[2], v1[3]);
                            *(u32x4*)((pn == 68 ? KU : VU) + pos * 256 + c) = w;
                        } else if (c < 64) {
                            float* o = out + (smp ? O_NIS : O_NIP) + ((size_t)(layer * 16 + b) * (smp ? 64 : 2048) + t) * 64 + c;
                            *(f32x4*)o = v0; *(f32x4*)(o + 4) = v1;
                            u32x4 w; w.x = pk_f16(v0[0], v0[1]); w.y = pk_f16(v0[2], v0[3]); w.z = pk_f16(v1[0], v1[1]); w.w = pk_f16(v1[2], v1[3]);
                            *(u32x4*)(KIU + pos * 64 + c) = w;
                        } else if (c < 80) {
                            float* o = WI + (size_t)R * 16 + (c - 64);
                            *(f32x4*)o = v0 * 0.03125f; *(f32x4*)(o + 4) = v1 * 0.03125f;
                        } else if (c < 96) {
                            float* o = BETA + (size_t)R * 16 + (c - 80);
                            f32x4 a, bb;
#pragma unroll
                            for (int j = 0; j < 4; ++j) { a[j] = sigmoidf_(v0[j]); bb[j] = sigmoidf_(v1[j]); }
                            *(f32x4*)o = a; *(f32x4*)(o + 4) = bb;
                        } else if (c < 112) {
                            float* o = GG + (size_t)R * 16 + (c - 96);
                            f32x4 a, bb;
#pragma unroll
                            for (int j = 0; j < 4; ++j) {
                                const int h0 = (c - 96) + j, h1 = h0 + 4;
                                const float x0 = v0[j] + dt_bias[h0], x1 = v1[j] + dt_bias[h1];
                                const float s0 = x0 > 20.f ? x0 : log1pf(__expf(x0)), s1 = x1 > 20.f ? x1 : log1pf(__expf(x1));
                                a[j] = -__expf(a_log[h0]) * s0; bb[j] = -__expf(a_log[h1]) * s1;
                            }
                            *(f32x4*)o = a; *(f32x4*)(o + 4) = bb;
                        }
                    }
                }
        }
    }
};
struct EpiAB {
    static constexpr bool PERM = true;
    const f16* proj; f16* mg;
    DI void operator()(const f32x4 (&acc)[2][2][4][2], const pg8::Unit& u, int wr, int wc, int fr_, int fq_) const {
        int fr = fr_, fq = fq_; asm volatile("" : "+v"(fr), "+v"(fq));
        const int rsb = u.pm * 256 + wr * 64 + fr, col0 = u.pn * 256 + wc * 32 + 8 * fq;
        const int gc = (u.which ? C_GB : C_GA) + col0;
#pragma unroll
        for (int ai = 0; ai < 2; ++ai)
#pragma unroll
            for (int m = 0; m < 4; ++m) {
                const size_t rs = (size_t)(rsb + ai * 128 + m * 16);
#pragma unroll
                for (int bj = 0; bj < 2; ++bj) {
                    const h8 gt = *(const h8*)(proj + rs * PS + gc + bj * 128);
                    f16* mp = mg + rs * 2048 + col0 + bj * 128;
                    float r[8];
#pragma unroll
                    for (int j = 0; j < 4; ++j) { r[j] = (float)gt[j] * acc[ai][bj][m][0][j]; r[4 + j] = (float)gt[4 + j] * acc[ai][bj][m][1][j]; }
                    if (u.which) { const h8 pv = *(const h8*)mp;
#pragma unroll
                        for (int j = 0; j < 8; ++j) r[j] += (float)pv[j]; }
                    u32x4 w; w.x = pk_f16(r[0], r[1]); w.y = pk_f16(r[2], r[3]); w.z = pk_f16(r[4], r[5]); w.w = pk_f16(r[6], r[7]);
                    *(u32x4*)mp = w;
                }
            }
    }
};
struct EpiOut {
    static constexpr bool PERM = true;
    const float* xp; const float* xs; float* out; const float* ada; int layer, slab;
    DI void operator()(const f32x4 (&acc)[2][2][4][2], const pg8::Unit& u, int wr, int wc, int fr_, int fq_) const {
        int fr = fr_, fq = fq_; asm volatile("" : "+v"(fr), "+v"(fq));
        const int rsb = u.pm * 256 + wr * 64 + fr, col0 = u.pn * 256 + wc * 32 + 8 * fq;
#pragma unroll
        for (int ai = 0; ai < 2; ++ai)
#pragma unroll
            for (int m = 0; m < 4; ++m) {
                int R, sq, t; rowinfo(slab, rsb + ai * 128 + m * 16, R, sq, t);
                const float* xo = layer == 0 ? (R < NTOKP ? xp + (size_t)R * D : xs + (size_t)(R - NTOKP) * D) : out + (size_t)R * D;
                const float* gp = ada + (size_t)sq * 6144 + 4096;
                float* yo = out + (size_t)R * D;
#pragma unroll
                for (int bj = 0; bj < 2; ++bj) {
                    const int c = col0 + bj * 128;
                    const f32x4 x0 = *(const f32x4*)(xo + c), x1 = *(const f32x4*)(xo + c + 4), g0 = *(const f32x4*)(gp + c), g1 = *(const f32x4*)(gp + c + 4);
                    *(f32x4*)(yo + c) = x0 + g0 * acc[ai][bj][m][0]; *(f32x4*)(yo + c + 4) = x1 + g1 * acc[ai][bj][m][1];
                }
            }
    }
};

DI void p0_prologue(const Frame F0) {
    const Frame F = F0.fresh();
    LAS float* tile = (LAS float*)F.lds;
    const int tid = F.tid;
    for (int u = F.bid; u < 2 * 12160; u += F.G) {
        const int l = u / 12160; int v = u % 12160;
        const float* src; f16* dst; int ldn, nb, kb; bool isin;
        if (v < 9088) { isin = true; nb = v >> 5; kb = v & 31; src = F.in(I_WIN) + (size_t)l * 2048 * IN_DIM; ldn = IN_DIM; dst = F.WIN() + (size_t)l * NP * 2048; }
        else { v -= 9088; const int mat = v >> 10, w = v & 1023; isin = false; nb = w >> 5; kb = w & 31; src = F.in(I_WBA + mat) + (size_t)l * 2048 * 2048; ldn = 2048;
               dst = (mat == 0 ? F.WA() : mat == 1 ? F.WB() : F.WO()) + (size_t)l * 2048 * 2048; }
        {
            const int nn = tid & 63, np = nb * 64 + nn; const int o = isin ? proj_src_col(np) : np;
#pragma unroll
            for (int i = 0; i < 8; ++i) { const int kk = (tid >> 6) + 8 * i; tile[kk * 65 + nn] = o >= 0 ? src[(size_t)(kb * 64 + kk) * ldn + o] : 0.f; }
        }
        __syncthreads();
        {
            const int nn = tid >> 3, kg = tid & 7; h8 hv;
#pragma unroll
            for (int j = 0; j < 8; ++j) hv[j] = (f16)tile[(kg * 8 + j) * 65 + nn];
            *(h8*)(dst + (size_t)(nb * 64 + nn) * 2048 + kb * 64 + kg * 8) = hv;
        }
        __syncthreads();
    }
    for (int u = F.bid; u < 2 * 96; u += F.G) {
        const int l = u / 96, cb = u % 96, kg = tid >> 6, n = tid & 63;
        float acc[32];
#pragma unroll
        for (int s = 0; s < 32; ++s) acc[s] = 0.f;
        const float* W = F.in(I_WADA) + (size_t)l * 2048 * 6144 + cb * 64 + n;
        for (int kc = 0; kc < 4; ++kc) {
            for (int i = tid; i < 32 * 512; i += NTHR) { const int s = i >> 9, k = i & 511; const float c = (s < 16 ? F.in(I_CP) + s * 2048 : F.in(I_CS) + (s - 16) * 2048)[kc * 512 + k]; tile[i] = siluf_(c); }
            __syncthreads();
            for (int kk = 0; kk < 64; ++kk) { const int k = kg * 64 + kk; const float w = W[(size_t)(kc * 512 + k) * 6144];
#pragma unroll
                for (int s = 0; s < 32; ++s) acc[s] += tile[s * 512 + k] * w; }
            __syncthreads();
        }
#pragma unroll
        for (int s = 0; s < 32; ++s) tile[(kg * 32 + s) * 64 + n] = acc[s];
        __syncthreads();
        for (int o = tid; o < 2048; o += NTHR) { const int s = o >> 6, nn = o & 63; float r = F.in(I_BADA)[l * 6144 + cb * 64 + nn];
#pragma unroll
            for (int g = 0; g < 8; ++g) r += tile[(g * 32 + s) * 64 + nn];
            F.ADA()[(size_t)(l * 32 + s) * 6144 + cb * 64 + nn] = r; }
        __syncthreads();
    }
}

DI void phase_norm(const Frame F0, int l, int slab) {
    const Frame F = F0.fresh();
    const int Ts = ts_of(slab);
    const float* nw = F.in(I_NW) + l * 2048;
    for (int rs = F.bid * NWAVES + F.wave; rs < Ts; rs += F.G * NWAVES) {
        int R, sq, t; rowinfo(slab, rs, R, sq, t);
        const float* x = l == 0 ? (R < NTOKP ? F.in(I_XP) + (size_t)R * D : F.in(I_XS) + (size_t)(R - NTOKP) * D) : F.out() + (size_t)R * D;
        const float* ad = F.ADA() + (size_t)(l * 32 + sq) * 6144;
        f32x4 v[8]; float ss = 0.f;
#pragma unroll
        for (int i = 0; i < 8; ++i) { v[i] = *(const f32x4*)(x + (i * 64 + F.lane) * 4); ss += v[i][0] * v[i][0] + v[i][1] * v[i][1] + v[i][2] * v[i][2] + v[i][3] * v[i][3]; }
        ss = wave_sum(ss, F.lane);
        const float r = rsqrtf(ss * (1.0f / 2048.0f) + EPS);
#pragma unroll
        for (int i = 0; i < 8; ++i) { const int c = (i * 64 + F.lane) * 4;
            const f32x4 w = *(const f32x4*)(nw + c), sh = *(const f32x4*)(ad + c), sc = *(const f32x4*)(ad + 2048 + c);
            const f32x4 hv = v[i] * r * w * (sc + 1.0f) + sh;
            u32x2 p; p.x = pk_f16(hv[0], hv[1]); p.y = pk_f16(hv[2], hv[3]);
            *(u32x2*)(F.H() + (size_t)rs * 2048 + c) = p; }
    }
    if (slab == 0) {
        const size_t gid = (size_t)F.bid * NTHR + F.tid, gsz = (size_t)F.G * NTHR;
        const size_t nk = (size_t)16 * PAST * 32;
        for (size_t g = gid; g < nk; g += gsz) {
            const size_t b = g / (PAST * 32), rem = g % (PAST * 32), p = rem >> 5, c8 = (rem & 31) * 8;
            const size_t so = (size_t)l * 16 * PAST * 256 + g * 8, dof = ((size_t)32768 + b * LSMP + p) * 256 + c8;
            { const f32x4 a = *(const f32x4*)(F.in(I_CK) + so), bb = *(const f32x4*)(F.in(I_CK) + so + 4);
              u32x4 w; w.x = pk_f16(a[0], a[1]); w.y = pk_f16(a[2], a[3]); w.z = pk_f16(bb[0], bb[1]); w.w = pk_f16(bb[2], bb[3]); *(u32x4*)(F.KU() + dof) = w; }
            { const f32x4 a = *(const f32x4*)(F.in(I_CV) + so), bb = *(const f32x4*)(F.in(I_CV) + so + 4);
              u32x4 w; w.x = pk_f16(a[0], a[1]); w.y = pk_f16(a[2], a[3]); w.z = pk_f16(bb[0], bb[1]); w.w = pk_f16(bb[2], bb[3]); *(u32x4*)(F.VU() + dof) = w; }
        }
        const size_t ni = (size_t)16 * PAST * 8;
        for (size_t g = gid; g < ni; g += gsz) {
            const size_t b = g / (PAST * 8), rem = g % (PAST * 8), p = rem >> 3, c8 = (rem & 7) * 8;
            const size_t so = (size_t)l * 16 * PAST * 64 + g * 8, dof = ((size_t)32768 + b * LSMP + p) * 64 + c8;
            const f32x4 a = *(const f32x4*)(F.in(I_CIK) + so), bb = *(const f32x4*)(F.in(I_CIK) + so + 4);
            u32x4 w; w.x = pk_f16(a[0], a[1]); w.y = pk_f16(a[2], a[3]); w.z = pk_f16(bb[0], bb[1]); w.w = pk_f16(bb[2], bb[3]); *(u32x4*)(F.KIU() + dof) = w;
        }
    }
}

DI unsigned sortable(float f) { const unsigned u = __float_as_uint(f); return (u & 0x80000000u) ? ~u : (u | 0x80000000u); }


typedef float f32x16 __attribute__((ext_vector_type(16)));
typedef __fp16 fp16x4_t __attribute__((__vector_size__(4 * sizeof(__fp16))));
#define MFMA32(a, b, c) __builtin_amdgcn_mfma_f32_32x32x16_f16((a), (b), (c), 0, 0, 0)
#define SB() __builtin_amdgcn_sched_barrier(0)
constexpr int AT_KV = 0, AT_BUF = 34816, AT_V = 17408, AT_ROW = 272;
constexpr int AT_QI = 0, AT_QIS = 1032;
constexpr int AT_MASK = 69632, AT_BT = AT_MASK + 32 * 65 * 8, AT_WI = AT_BT + 16 * 192 * 4, AT_END = AT_WI + 32 * 16 * 4;
static_assert(AT_END <= LDS_MISC && 32 * AT_QIS * 2 <= AT_MASK, "attention LDS map");
constexpr float LOG2E = 1.4426950408889634f, SCL2 = 0.08838834764831845f * LOG2E;


constexpr int GX = 0, GX_S = 264, GTF = 33792, GPT = GTF + 17408, GTAB = GPT + 4096, GAT = GTAB + 1536, GAT_S = 68, GTM = GAT + 17408, GT_S = 72, GKB = GTM + 9216, GVB = GKB + 18432, GPRE_END = GVB + 18432;
static_assert(GPRE_END <= LDS_MISC, "gdn pre LDS map");
DI void gdn_pre_unit(const Frame& F0, int l, int slab, int c, int hd) {
    const Frame F = F0.fresh();
    const int tid = F.tid, lane = F.lane, wave = F.wave, r32 = lane & 31, h2 = lane >> 5;
    LAS unsigned char* lds = F.lds;
    LAS f16* X = (LAS f16*)(lds + GX);
    LAS float* TF = (LAS float*)(lds + GTF);
    LAS float* PT = (LAS float*)(lds + GPT);
    LAS float* TAB = (LAS float*)(lds + GTAB);
    LAS float* AT = (LAS float*)(lds + GAT);
    LAS f16* TM = (LAS f16*)(lds + GTM);
    LAS f16* KB = (LAS f16*)(lds + GKB);
    LAS f16* VB = (LAS f16*)(lds + GVB);
    const bool smp = c >= 128;
    const int sq = smp ? 16 + (c - 128) : slab * 4 + (c >> 5), n = smp ? 0 : (c & 31), b = sq & 15;
    const int rsb = smp ? 8192 + (sq - 16) * 64 : (sq - slab * 4) * 2048 + n * 64;
    const int Rb = smp ? NTOKP + (sq - 16) * 64 : sq * 2048 + n * 64;
    const f16* PROJ = F.PROJ();
    unsigned char* gp = F.ws() + WS_GP + (size_t)(c * 16 + hd) * GP_STRIDE;
    {
        const float* wcv = F.in(I_WCONV) + (size_t)l * 4 * 6144;
        const float* scv = F.in(I_SC) + (size_t)(l * 16 + b) * 3 * 6144;
        if (tid < 384) {
            const int run = tid / 48, cg = tid % 48, part = cg >> 4, c8 = (cg & 15) * 8, gch = part * 2048 + hd * 128 + c8, tok0 = run * 8;
            h8 xr[11];
#pragma unroll
            for (int r = 0; r < 11; ++r) {
                const int tt = tok0 - 3 + r;
                if (tt >= 0 || n > 0) xr[r] = *(const h8*)(PROJ + (size_t)(rsb + tt) * PS + gch);
                else if (smp) { const f32x4 a = *(const f32x4*)(scv + (size_t)(3 + tt) * 6144 + gch), bq = *(const f32x4*)(scv + (size_t)(3 + tt) * 6144 + gch + 4);
                    h8 t; t[0] = (f16)a[0]; t[1] = (f16)a[1]; t[2] = (f16)a[2]; t[3] = (f16)a[3]; t[4] = (f16)bq[0]; t[5] = (f16)bq[1]; t[6] = (f16)bq[2]; t[7] = (f16)bq[3]; xr[r] = t; }
                else {
#pragma unroll
                    for (int j = 0; j < 8; ++j) xr[r][j] = (f16)0.f; }
            }
            float w[4][8];
#pragma unroll
            for (int tap = 0; tap < 4; ++tap) { const f32x4 w0 = *(const f32x4*)(wcv + tap * 6144 + gch), w1 = *(const f32x4*)(wcv + tap * 6144 + gch + 4);
#pragma unroll
                for (int j = 0; j < 4; ++j) { w[tap][j] = w0[j]; w[tap][4 + j] = w1[j]; } }
            h8 y[8];
#pragma unroll
            for (int tq = 0; tq < 8; ++tq)
#pragma unroll
                for (int j = 0; j < 8; ++j) {
                    const float acc = w[0][j] * (float)xr[tq][j] + w[1][j] * (float)xr[tq + 1][j] + w[2][j] * (float)xr[tq + 2][j] + w[3][j] * (float)xr[tq + 3][j];
                    y[tq][j] = (f16)siluf_(acc);
                }
            if (part < 2) {
#pragma unroll
                for (int tq = 0; tq < 8; ++tq) *(LAS h8*)(X + (tok0 + tq) * GX_S + cg * 8) = y[tq];
            }
            if (part >= 1) {
                LAS f16* img = part == 1 ? KB : VB;
#pragma unroll
                for (int j = 0; j < 8; ++j) { h8 t;
#pragma unroll
                    for (int tq = 0; tq < 8; ++tq) t[tq] = y[tq][j];
                    *(LAS h8*)(img + (c8 + j) * GT_S + tok0) = t; }
            }
        }
        if (wave == 7) {
            const float be = F.BETA()[(size_t)(Rb + lane) * 16 + hd];
            float gcv = F.GG()[(size_t)(Rb + lane) * 16 + hd];
#pragma unroll
            for (int o = 1; o < 64; o <<= 1) { const float tv = __builtin_bit_cast(float, __builtin_amdgcn_ds_bpermute(((lane - o) & 63) << 2, __builtin_bit_cast(int, gcv))); if (lane >= o) gcv += tv; }
            const float gl = __builtin_bit_cast(float, __builtin_amdgcn_readlane(__builtin_bit_cast(int, gcv), 63));
            TAB[128 + lane] = be; TAB[192 + lane] = gcv; TAB[256 + lane] = __expf(gcv); TAB[320 + lane] = __expf(gl - gcv);
            if (lane == 63) ((float*)(F.ws() + WS_GL))[c * 16 + hd] = __expf(gl);
        }
    }
    __syncthreads();
    {
        const int tok = tid >> 3, part = tid & 7;
        float sq_ = 0.f, sk_ = 0.f;
#pragma unroll
        for (int u = 0; u < 2; ++u) { const h8 a = *(const LAS h8*)(X + tok * GX_S + part * 16 + u * 8), k = *(const LAS h8*)(X + tok * GX_S + 128 + part * 16 + u * 8);
#pragma unroll
            for (int j = 0; j < 8; ++j) { sq_ += (float)a[j] * (float)a[j]; sk_ += (float)k[j] * (float)k[j]; } }
        { sq_ += swz_xor<4>(sq_); sk_ += swz_xor<4>(sk_); sq_ += swz_xor<2>(sq_); sk_ += swz_xor<2>(sk_); sq_ += swz_xor<1>(sq_); sk_ += swz_xor<1>(sk_); }
        if (part == 0) { TAB[tok] = rsqrtf(sq_ + EPS) * 0.08838834764831845f; TAB[64 + tok] = rsqrtf(sk_ + EPS); }
    }
    __syncthreads();
    if (wave < 6) {
        const bool isqk = wave >= 3; const int ti = isqk ? wave - 3 : wave;
        const int rt = isqk ? (ti == 2 ? 1 : 0) : (wave == 2 ? 1 : 0), ct = isqk ? (ti == 0 ? 0 : 1) : (wave == 0 ? 0 : 1);
        f32x16 acc;
#pragma unroll
        for (int i = 0; i < 16; ++i) acc[i] = 0.f;
        {
            h8 fa[8], fb[8];
#pragma unroll
            for (int s = 0; s < 8; ++s) { fa[s] = *(const LAS h8*)(X + (32 * rt + r32) * GX_S + 128 + 16 * s + 8 * h2);
                fb[s] = *(const LAS h8*)(X + (32 * ct + r32) * GX_S + (isqk ? 0 : 128) + 16 * s + 8 * h2); }
            SB();
#pragma unroll
            for (int s = 0; s < 8; ++s) acc = MFMA32(fa[s], fb[s], acc);
            SB();
        }
        const int col = 32 * ct + r32;
        if (!isqk) {
            const float bk = TAB[128 + col] * TAB[64 + col], gck = TAB[192 + col];
#pragma unroll
            for (int g = 0; g < 4; ++g) { const int j0 = 32 * rt + 8 * g + 4 * h2;
                const f32x4 rk = *(const LAS f32x4*)(TAB + 64 + j0), gj = *(const LAS f32x4*)(TAB + 192 + j0);
                f32x4 v;
#pragma unroll
                for (int jj = 0; jj < 4; ++jj) v[jj] = (col > j0 + jj) ? bk * rk[jj] * acc[4 * g + jj] * __expf(fminf(gck - gj[jj], 0.f)) : 0.f;
                *(LAS f32x4*)(AT + col * GAT_S + j0) = v; }
        } else {
            const float rqi = TAB[col], gci = TAB[192 + col];
#pragma unroll
            for (int g = 0; g < 4; ++g) { const int j0 = 32 * rt + 8 * g + 4 * h2;
                const f32x4 rk = *(const LAS f32x4*)(TAB + 64 + j0), gj = *(const LAS f32x4*)(TAB + 192 + j0);
                h4 v;
#pragma unroll
                for (int jj = 0; jj < 4; ++jj) v[jj] = (f16)((col >= j0 + jj) ? rqi * rk[jj] * acc[4 * g + jj] * __expf(fminf(gci - gj[jj], 0.f)) : 0.f);
                *(h4*)(gp + GP_QK + (col * 64 + j0) * 2) = v; }
        }
    } else if (wave == 6) {
#pragma unroll
        for (int u = 0; u < 4; ++u) { const int p = lane + 64 * u, i = p >> 3, j0 = 32 + (p & 7) * 4; *(h4*)(gp + GP_QK + (i * 64 + j0) * 2) = (h4){(f16)0.f, (f16)0.f, (f16)0.f, (f16)0.f}; }
    }
    if (wave == 0 || wave == 2) {
        const int bs = wave == 0 ? 0 : 32;
        asm volatile("s_waitcnt lgkmcnt(0)" ::: "memory");
        {
            const int o = bs + 16 * ((lane >> 4) & 1), cc = lane & 15;
            float T[16];
#pragma unroll
            for (int i = 0; i < 16; ++i) {
                float sacc = (i == cc) ? 1.f : 0.f;
#pragma unroll
                for (int jg = 0; jg < (i + 3) / 4; ++jg) { const f32x4 a4 = *(const LAS f32x4*)(AT + (o + i) * GAT_S + o + 4 * jg);
#pragma unroll
                    for (int jj = 0; jj < 4; ++jj) if (4 * jg + jj < i) sacc -= a4[jj] * T[4 * jg + jj]; }
                T[i] = sacc;
            }
            if (lane < 32) {
#pragma unroll
                for (int i = 0; i < 16; ++i) TF[(o + i) * GAT_S + o + cc] = T[i];
            }
        }
        asm volatile("s_waitcnt lgkmcnt(0)" ::: "memory");
        {
            const int i = lane >> 2, c4 = (lane & 3) * 4;
            f32x4 p = {0.f, 0.f, 0.f, 0.f};
#pragma unroll
            for (int k = 0; k < 16; ++k) { const float a = AT[(bs + 16 + i) * GAT_S + bs + k]; const f32x4 t4 = *(const LAS f32x4*)(TF + (bs + k) * GAT_S + bs + c4); p += a * t4; }
            *(LAS f32x4*)(PT + (bs >> 5) * 256 + i * 16 + c4) = p;
            *(LAS f32x4*)(TF + (bs + i) * GAT_S + bs + 16 + c4) = (f32x4){0.f, 0.f, 0.f, 0.f};
            asm volatile("s_waitcnt lgkmcnt(0)" ::: "memory");
            f32x4 v = {0.f, 0.f, 0.f, 0.f};
#pragma unroll
            for (int k = 0; k < 16; ++k) { const float a = TF[(bs + 16 + i) * GAT_S + bs + 16 + k]; const f32x4 p4 = *(const LAS f32x4*)(PT + (bs >> 5) * 256 + k * 16 + c4); v -= a * p4; }
            *(LAS f32x4*)(TF + (bs + 16 + i) * GAT_S + bs + c4) = v;
        }
    } else {
        const int e = (wave == 1 ? 0 : wave - 2) * 64 + lane;
#pragma unroll 1
        for (int item = e; item < 4096; item += 384) {
            const int kind = item >> 10, rem = item & 1023;
            if (kind < 2) {
                const int d = rem >> 3, tg = rem & 7;
                LAS f16* p = (kind ? VB : KB) + d * GT_S + 8 * tg;
                const h8 xv = *(const LAS h8*)p;
                const f32x4 b0 = *(const LAS f32x4*)(TAB + 128 + 8 * tg), b1 = *(const LAS f32x4*)(TAB + 128 + 8 * tg + 4);
                f32x4 s0 = b0, s1 = b1;
                if (!kind) { s0 = s0 * *(const LAS f32x4*)(TAB + 64 + 8 * tg) * *(const LAS f32x4*)(TAB + 256 + 8 * tg); s1 = s1 * *(const LAS f32x4*)(TAB + 64 + 8 * tg + 4) * *(const LAS f32x4*)(TAB + 256 + 8 * tg + 4); }
                h8 o;
#pragma unroll
                for (int j = 0; j < 4; ++j) { o[j] = (f16)((float)xv[j] * s0[j]); o[4 + j] = (f16)((float)xv[4 + j] * s1[j]); }
                *(LAS h8*)p = o;
            } else {
                const int tok = rem >> 4, c8 = (rem & 15) * 8, which = kind - 2;
                const h8 xv = *(const LAS h8*)(X + tok * GX_S + (which ? 128 : 0) + c8);
                const float sc = which ? TAB[64 + tok] * TAB[320 + tok] : TAB[tok] * TAB[256 + tok];
                h8 o;
#pragma unroll
                for (int j = 0; j < 8; ++j) o[j] = (f16)((float)xv[j] * sc);
                *(h8*)(gp + (which ? GP_KD : GP_QD) + (tok * 128 + c8) * 2) = o;
            }
        }
    }
    __syncthreads();
    {
        float p[2];
#pragma unroll
        for (int u = 0; u < 2; ++u) { const int e = tid + NTHR * u, i = e >> 5, cc = e & 31; float a = 0.f;
#pragma unroll 8
            for (int k = 0; k < 32; ++k) a += AT[(32 + i) * GAT_S + k] * TF[k * GAT_S + cc];
            p[u] = a; }
        PT[tid] = p[0]; PT[tid + NTHR] = p[1];
        __syncthreads();
#pragma unroll
        for (int u = 0; u < 2; ++u) { const int e = tid + NTHR * u, i = e >> 5, cc = e & 31; float v = 0.f;
#pragma unroll 8
            for (int k = 0; k < 32; ++k) v -= TF[(32 + i) * GAT_S + 32 + k] * PT[k * 32 + cc];
            TF[(32 + i) * GAT_S + cc] = v; }
    }
    __syncthreads();
    {
        const int i = tid >> 3, jg = tid & 7; h8 o;
#pragma unroll
        for (int jj = 0; jj < 8; ++jj) o[jj] = (i < 32 && jg >= 4) ? (f16)0.f : (f16)TF[i * GAT_S + 8 * jg + jj];
        *(LAS h8*)(TM + i * GT_S + 8 * jg) = o;
    }
    __syncthreads();
    {
        const int mt = wave & 3, nt = wave >> 2;
        f32x16 aw, au;
#pragma unroll
        for (int i = 0; i < 16; ++i) { aw[i] = 0.f; au[i] = 0.f; }
        {
            h8 tb[4], ka[4], vb[4];
#pragma unroll
            for (int s = 0; s < 4; ++s) {
                tb[s] = *(const LAS h8*)(TM + (32 * nt + r32) * GT_S + 16 * s + 8 * h2);
                ka[s] = *(const LAS h8*)(KB + (32 * mt + r32) * GT_S + 16 * s + 8 * h2);
                vb[s] = *(const LAS h8*)(VB + (32 * mt + r32) * GT_S + 16 * s + 8 * h2);
            }
            SB();
#pragma unroll
            for (int s = 0; s < 4; ++s) { aw = MFMA32(ka[s], tb[s], aw); au = MFMA32(tb[s], vb[s], au); }
            SB();
        }
#pragma unroll
        for (int g = 0; g < 4; ++g) {
            h4 w4, u4;
#pragma unroll
            for (int jj = 0; jj < 4; ++jj) { w4[jj] = (f16)aw[4 * g + jj]; u4[jj] = (f16)au[4 * g + jj]; }
            *(h4*)(gp + GP_W + ((32 * nt + r32) * 128 + 32 * mt + 8 * g + 4 * h2) * 2) = w4;
            *(h4*)(gp + GP_U + (((mt * 2 + nt) * 4 + g) * 64 + lane) * 8) = u4;
        }
    }
    __syncthreads();
}

constexpr int SC_W = 0, SC_QD = 17408, SC_KD = 34816, SC_QK = 52224, SC_BUF = 61440, SC_SSQ = 2 * SC_BUF, SC_END = SC_SSQ + 1024;
static_assert(SC_END <= LDS_MISC, "gdn scan LDS map");
DI void gdn_scan_unit(const Frame& F0, int l, int slab, int sq, int hd) {
    const Frame F = F0.fresh();
    const int tid = F.tid, lane = F.lane, wave = F.wave, r32 = lane & 31, h2 = lane >> 5;
    const int i16 = lane & 15, q4 = i16 >> 2, p4 = i16 & 3, blk = (lane >> 4) & 1;
    LAS unsigned char* lds = F.lds;
    LAS float* ssq = (LAS float*)(lds + SC_SSQ);
    const bool smp = sq >= 16; const int b = sq & 15, nch = smp ? 1 : 32;
    const int c0 = smp ? 128 + (sq - 16) : (sq - slab * 4) * 32;
    const int rs0 = smp ? 8192 + (sq - 16) * 64 : (sq - slab * 4) * 2048;
    const unsigned char* gpb = F.ws() + WS_GP + (size_t)hd * GP_STRIDE;
    const float* GLp = (const float*)(F.ws() + WS_GL);
    const int w = wave;
    f32x16 S[4];
    if (wave < 4) {
        const float* s0 = F.in(I_SG) + ((size_t)(l * 16 + b) * 16 + hd) * 16384;
#pragma unroll
        for (int mt = 0; mt < 4; ++mt)
#pragma unroll
            for (int i = 0; i < 16; ++i) S[mt][i] = smp ? s0[(32 * mt + (i & 3) + 8 * (i >> 2) + 4 * h2) * 128 + 32 * w + r32] : 0.f;
    }
    const int lt = tid - 256;
    h4 uf[2][4];
    if (wave < 4) { const unsigned char* up = gpb + (size_t)c0 * 16 * GP_STRIDE + GP_U;
#pragma unroll
        for (int tm = 0; tm < 2; ++tm)
#pragma unroll
            for (int g = 0; g < 4; ++g) uf[tm][g] = *(const h4*)(up + (((w * 2 + tm) * 4 + g) * 64 + lane) * 8); }
#define SC_LOAD(cc) do { const unsigned char* src = gpb + (size_t)(cc) * 16 * GP_STRIDE; \
        _Pragma("unroll") for (int it = 0; it < 4; ++it) { const int i = lt + 256 * it, row = i >> 4, c8 = (i & 15) * 8; const int go = (row * 128 + c8) * 2; \
            t0[it] = *(const u32x4*)(src + GP_W + go); t1[it] = *(const u32x4*)(src + GP_QD + go); t2[it] = *(const u32x4*)(src + GP_KD + go); } \
        _Pragma("unroll") for (int it = 0; it < 2; ++it) { const int i = lt + 256 * it, row = i >> 3, c8 = (i & 7) * 8; t3[it] = *(const u32x4*)(src + GP_QK + (row * 64 + c8) * 2); } } while (0)
#define SC_STORE(bufi) do { LAS unsigned char* dst = lds + (bufi) * SC_BUF; \
        _Pragma("unroll") for (int it = 0; it < 4; ++it) { const int i = lt + 256 * it, row = i >> 4, c8 = (i & 15) * 8; const int lo = row * 272 + c8 * 2; \
            *(LAS u32x4*)(dst + SC_W + lo) = t0[it]; *(LAS u32x4*)(dst + SC_QD + lo) = t1[it]; *(LAS u32x4*)(dst + SC_KD + lo) = t2[it]; } \
        _Pragma("unroll") for (int it = 0; it < 2; ++it) { const int i = lt + 256 * it, row = i >> 3, c8 = (i & 7) * 8; *(LAS u32x4*)(dst + SC_QK + row * 144 + c8 * 2) = t3[it]; } } while (0)
    u32x4 t0[4], t1[4], t2[4], t3[2];
    if (wave >= 4) { SC_LOAD(c0); SC_STORE(0); }
    __syncthreads();
    const float gnw0 = 0.f; (void)gnw0;
    if (wave >= 4) {
#pragma unroll 1
        for (int n = 0; n < nch; ++n) {
            int tl_ = lane_id_fresh() + wave * 64; asm volatile("" : "+v"(tl_));
            const int lt = tl_ - 256; const bool more = (n + 1) < nch;
            if (more) SC_LOAD(c0 + n + 1);
        asm volatile("s_waitcnt lgkmcnt(0)" ::: "memory"); __builtin_amdgcn_s_barrier(); asm volatile("" ::: "memory");
            if (more) SC_STORE((n + 1) & 1);
        asm volatile("s_waitcnt lgkmcnt(0)" ::: "memory"); __builtin_amdgcn_s_barrier(); asm volatile("" ::: "memory");
        }
    } else {
#pragma unroll 1
    for (int n = 0; n < nch; ++n) {
        const int c = c0 + n;
        int tl_ = lane_id_fresh() + wave * 64; asm volatile("" : "+v"(tl_));
        const int lt = tl_ - 256, lane = tl_ & 63, r32 = lane & 31, h2 = lane >> 5, i16 = lane & 15, q4 = i16 >> 2, p4 = i16 & 3, blk = (lane >> 4) & 1;
        LAS unsigned char* bufp = lds + (n & 1) * SC_BUF;
        f32x16 oT[2];
        h8 VNp[2][2];
        const bool more = (n + 1) < nch;
        float gl = 0.f; h4 zaf[2][4];
            gl = GLp[c * 16 + hd];
            h8 Sp[4][2];
#pragma unroll
            for (int mt = 0; mt < 4; ++mt)
#pragma unroll
                for (int ks = 0; ks < 2; ++ks) { h8 t;
#pragma unroll
                    for (int jj = 0; jj < 8; ++jj) t[jj] = (f16)S[mt][8 * ks + jj];
                    Sp[mt][ks] = t; }
#pragma unroll
            for (int tm = 0; tm < 2; ++tm) {
                h8 wf[8];
#pragma unroll
                for (int kq = 0; kq < 8; ++kq) {
                    LAS unsigned char* ap = bufp + SC_W + (32 * tm + r32) * 272 + 2 * (16 * kq + 4 * h2);
                    const h4 lo = *(const LAS h4*)ap, hi = *(const LAS h4*)(ap + 16);
                    wf[kq] = __builtin_shufflevector(lo, hi, 0, 1, 2, 3, 4, 5, 6, 7);
                }
                f32x16 ws;
#pragma unroll
                for (int i = 0; i < 16; ++i) ws[i] = 0.f;
                SB();
#pragma unroll
                for (int kq = 0; kq < 8; ++kq) ws = MFMA32(wf[kq], Sp[kq >> 1][kq & 1], ws);
                SB();
#pragma unroll
                for (int g = 0; g < 4; ++g)
#pragma unroll
                    for (int jj = 0; jj < 4; ++jj) ws[4 * g + jj] = (float)uf[tm][g][jj] - ws[4 * g + jj];
#pragma unroll
                for (int ks = 0; ks < 2; ++ks) { h8 t;
#pragma unroll
                    for (int jj = 0; jj < 8; ++jj) t[jj] = (f16)ws[8 * ks + jj];
                    VNp[tm][ks] = t; }
            }
#pragma unroll
            for (int tn = 0; tn < 2; ++tn) {
                f32x16 o;
#pragma unroll
                for (int i = 0; i < 16; ++i) o[i] = 0.f;
#pragma unroll
                for (int hb = 0; hb < 2; ++hb) {
                    h8 bf[4];
#pragma unroll
                    for (int kq = 0; kq < 4; ++kq) {
                        LAS unsigned char* bp = bufp + SC_QD + (32 * tn + r32) * 272 + 2 * (16 * (4 * hb + kq) + 4 * h2);
                        const h4 lo = *(const LAS h4*)bp, hi = *(const LAS h4*)(bp + 16);
                        bf[kq] = __builtin_shufflevector(lo, hi, 0, 1, 2, 3, 4, 5, 6, 7);
                    }
                    SB();
#pragma unroll
                    for (int kq = 0; kq < 4; ++kq) o = MFMA32(Sp[(4 * hb + kq) >> 1][kq & 1], bf[kq], o);
                    SB();
                }
                {
                    h8 bf[4];
#pragma unroll
                    for (int kq = 0; kq < 4; ++kq) {
                        LAS unsigned char* bp = bufp + SC_QK + (32 * tn + r32) * 144 + 2 * (16 * kq + 4 * h2);
                        const h4 lo = *(const LAS h4*)bp, hi = *(const LAS h4*)(bp + 16);
                        bf[kq] = __builtin_shufflevector(lo, hi, 0, 1, 2, 3, 4, 5, 6, 7);
                    }
                    SB();
#pragma unroll
                    for (int kq = 0; kq < 4; ++kq) o = MFMA32(VNp[kq >> 1][kq & 1], bf[kq], o);
                    SB();
                }
                oT[tn] = o;
                float sacc = 0.f;
#pragma unroll
                for (int i = 0; i < 16; ++i) sacc += o[i] * o[i];
                sacc += shx32(sacc, lane);
                if (h2 == 0) ssq[w * 64 + 32 * tn + r32] = sacc;
            }
            if (n + 1 < nch) {
                const unsigned char* up = gpb + (size_t)(c + 1) * 16 * GP_STRIDE + GP_U;
#pragma unroll
                for (int tm = 0; tm < 2; ++tm)
#pragma unroll
                    for (int g = 0; g < 4; ++g) uf[tm][g] = *(const h4*)(up + (((w * 2 + tm) * 4 + g) * 64 + lane) * 8);
            }
            {
                const f16* PROJ = F.PROJ();
#pragma unroll
                for (int tn = 0; tn < 2; ++tn)
#pragma unroll
                    for (int g = 0; g < 4; ++g) zaf[tn][g] = *(const h4*)(PROJ + (size_t)(rs0 + 64 * n + 32 * tn + r32) * PS + C_ZA + hd * 128 + 32 * w + 8 * g + 4 * h2);
            }
        asm volatile("s_waitcnt lgkmcnt(0)" ::: "memory"); __builtin_amdgcn_s_barrier(); asm volatile("" ::: "memory");
        {
            const float* gnw = F.in(I_GNW) + l * 128;
#pragma unroll
            for (int tn = 0; tn < 2; ++tn) {
                const int tok = 32 * tn + r32;
                const float tot = ssq[tok] + ssq[64 + tok] + ssq[128 + tok] + ssq[192 + tok];
                const float rstd = rsqrtf(tot * (1.0f / 128.0f) + EPS);
                const size_t rs = (size_t)(rs0 + 64 * n + tok);
#pragma unroll
                for (int g = 0; g < 4; ++g) {
                    const int dv0 = 32 * w + 8 * g + 4 * h2;
                    const f32x4 gw = *(const f32x4*)(gnw + dv0);
                    const h4 za = zaf[tn][g];
                    h4 ov;
#pragma unroll
                    for (int jj = 0; jj < 4; ++jj) ov[jj] = (f16)(oT[tn][4 * g + jj] * rstd * gw[jj] * (float)za[jj]);
                    *(h4*)(F.OA() + rs * 2048 + hd * 128 + dv0) = ov;
                }
            }
#pragma unroll
            for (int mp = 0; mp < 2; ++mp) {
                h8 kf[2][4];
#pragma unroll
                for (int ml = 0; ml < 2; ++ml)
#pragma unroll
                    for (int kq = 0; kq < 4; ++kq) {
                        LAS unsigned char* ap = bufp + SC_KD + (16 * kq + 4 * h2 + q4) * 272 + 64 * (2 * mp + ml) + 8 * (4 * blk + p4);
                        const fp16x4_t lo = __builtin_amdgcn_ds_read_tr16_b64_v4f16((LAS fp16x4_t*)ap);
                        const fp16x4_t hi = __builtin_amdgcn_ds_read_tr16_b64_v4f16((LAS fp16x4_t*)(ap + 8 * 272));
                        kf[ml][kq] = __builtin_shufflevector(__builtin_bit_cast(h4, lo), __builtin_bit_cast(h4, hi), 0, 1, 2, 3, 4, 5, 6, 7);
                    }
#pragma unroll
                for (int i = 0; i < 16; ++i) { S[2 * mp][i] *= gl; S[2 * mp + 1][i] *= gl; }
                SB();
#pragma unroll
                for (int kq = 0; kq < 4; ++kq) { S[2 * mp] = MFMA32(kf[0][kq], VNp[kq >> 1][kq & 1], S[2 * mp]); S[2 * mp + 1] = MFMA32(kf[1][kq], VNp[kq >> 1][kq & 1], S[2 * mp + 1]); }
                SB();
            }
        }
        asm volatile("s_waitcnt lgkmcnt(0)" ::: "memory"); __builtin_amdgcn_s_barrier(); asm volatile("" ::: "memory");
    }
    }
#undef SC_LOAD
#undef SC_STORE
    if (wave < 4) {
        float* so = F.out() + (smp ? O_NGS : O_NGP) + ((size_t)(l * 16 + b) * 16 + hd) * 16384;
#pragma unroll
        for (int mt = 0; mt < 4; ++mt)
#pragma unroll
            for (int i = 0; i < 16; ++i) so[(32 * mt + (i & 3) + 8 * (i >> 2) + 4 * h2) * 128 + 32 * w + r32] = S[mt][i];
    }
    __syncthreads();
}

template <int NKMAX>
DI void select_rows(const float* scr, LAS unsigned long long* mask, int wave, int lane, int nk, int nvis) {
#pragma unroll 1
    for (int r = 0; r < 4; ++r) {
        const int q = wave * 4 + r;
        unsigned u[NKMAX];
#pragma unroll
        for (int k = 0; k < NKMAX; ++k) u[k] = (k < nk) ? sortable(scr[(size_t)q * LDR + 64 * k + lane]) : 0u;
        unsigned thr = 0u;
        if (nvis > 256) {
#pragma unroll 1
            for (int bit = 31; bit >= 0; --bit) {
                const unsigned cand = thr | (1u << bit);
                int c = 0;
#pragma unroll
                for (int k = 0; k < NKMAX; ++k) c += (int)__popcll(__ballot(u[k] >= cand));
                if (c >= 256) thr = cand;
            }
        }
#pragma unroll
        for (int k = 0; k < NKMAX; ++k) { const unsigned long long bal = __ballot(u[k] >= thr); if (k < nk && lane == 0) mask[q * 65 + k] = bal; }
    }
}

DI void attn_step3(const Frame& F, LAS unsigned char* lds, LAS unsigned long long* mask, LAS float* bt, const f16* PROJ, int rs0, int qpos0, int nk, int pb);
DI void attn_unit(const Frame& F0, int l, int slab, int rs0) {
    const Frame F = F0.fresh();
    const int tid = F.tid, lane = F.lane, wave = F.wave, r32 = lane & 31, h2 = lane >> 5;
    LAS unsigned char* lds = F.lds;
    LAS unsigned long long* mask = (LAS unsigned long long*)(lds + AT_MASK);
    LAS float* bt = (LAS float*)(lds + AT_BT);
    LAS float* wil = (LAS float*)(lds + AT_WI);
    int R0, sq, t0; rowinfo(slab, rs0, R0, sq, t0);
    const bool smp = sq >= 16;
    const int qpos0 = (smp ? PAST : 0) + t0, nvis = 64 * (qpos0 / 64 + 1), nk = nvis >> 6, pb = posbase(sq);
    float* scr = (float*)(F.ws() + WS_SCR) + (size_t)F.bid * 32 * LDR;
    const f16* PROJ = F.PROJ();
#pragma unroll
    for (int it = 0; it < 8; ++it) { const int i = tid + NTHR * it, row = i >> 7, c8 = (i & 127) * 8;
        *(LAS h8*)(lds + AT_QI + (row * AT_QIS + c8) * 2) = *(const h8*)(PROJ + (size_t)(rs0 + row) * PS + C_QI + c8); }
    { const float* rb = F.in(I_RELB);
      for (int i = tid; i < 16 * 192; i += NTHR) { const int h = i / 192, rel = (i % 192) - 128; bt[i] = rb[rel_bucket(rel) * 16 + h] * LOG2E; } }
    wil[tid] = F.WI()[(size_t)(R0 + (tid >> 4)) * 16 + (tid & 15)];
    __syncthreads();
    {
        const f16* KI = F.KIU();
#pragma unroll 1
        for (int p = wave; p < nk; p += 8) {
            h8 a[2][4];
#pragma unroll
            for (int tl = 0; tl < 2; ++tl)
#pragma unroll
                for (int s = 0; s < 4; ++s) a[tl][s] = *(const h8*)(KI + (size_t)(pb + 64 * p + 32 * tl + r32) * 64 + 16 * s + 8 * h2);
            f32x16 sc0, sc1;
#pragma unroll
            for (int i = 0; i < 16; ++i) { sc0[i] = 0.f; sc1[i] = 0.f; }
#pragma unroll 2
            for (int h = 0; h < 16; ++h) {
                h8 b[4];
#pragma unroll
                for (int s = 0; s < 4; ++s) b[s] = *(const LAS h8*)(lds + AT_QI + (r32 * AT_QIS + h * 64 + 16 * s + 8 * h2) * 2);
                f32x16 c0, c1;
#pragma unroll
                for (int i = 0; i < 16; ++i) { c0[i] = 0.f; c1[i] = 0.f; }
#pragma unroll
                for (int s = 0; s < 4; ++s) { c0 = MFMA32(a[0][s], b[s], c0); c1 = MFMA32(a[1][s], b[s], c1); }
                const float w = wil[r32 * 16 + h];
#pragma unroll
                for (int i = 0; i < 16; ++i) { sc0[i] += w * fmaxf(c0[i], 0.f); sc1[i] += w * fmaxf(c1[i], 0.f); }
            }
            float* o = scr + (size_t)r32 * LDR + 64 * p + 4 * h2;
#pragma unroll
            for (int g = 0; g < 4; ++g) { *(f32x4*)(o + 8 * g) = (f32x4){sc0[4 * g], sc0[4 * g + 1], sc0[4 * g + 2], sc0[4 * g + 3]};
                                          *(f32x4*)(o + 32 + 8 * g) = (f32x4){sc1[4 * g], sc1[4 * g + 1], sc1[4 * g + 2], sc1[4 * g + 3]}; }
        }
    }
    asm volatile("s_waitcnt vmcnt(0)" ::: "memory");
    __syncthreads();
    __builtin_amdgcn_fence(__ATOMIC_ACQUIRE, "agent");
    { int lane2 = lane; asm volatile("" : "+v"(lane2));
      if (smp) select_rows<65>(scr, mask, wave, lane2, nk, nvis); else select_rows<32>(scr, mask, wave, lane2, nk, nvis); }
    __syncthreads();
    attn_step3(F, lds, mask, bt, PROJ, rs0, qpos0, nk, pb);
    if (PROBE_REP & 128) attn_step3(F, lds, mask, bt, PROJ, rs0, qpos0, nk, pb);
}
DI void attn_step3(const Frame& F, LAS unsigned char* lds, LAS unsigned long long* mask, LAS float* bt, const f16* PROJ, int rs0, int qpos0, int nk, int pb) {
    int tid = lane_id_fresh() + F.wave * 64; asm volatile("" : "+v"(tid));
    const int lane = tid & 63, wave = F.wave, r32 = lane & 31, h2 = lane >> 5;
    const f16* KU = F.KU(); const f16* VU = F.VU();
    const int i16 = lane & 15, q4 = i16 >> 2, p4 = i16 & 3, blk = (lane >> 4) & 1;
#pragma unroll 1
    for (int n = 0; n < 2; ++n) {
        const int hq = 8 * n + wave;
        h8 qf[8];
#pragma unroll
        for (int s = 0; s < 8; ++s) qf[s] = *(const h8*)(PROJ + (size_t)(rs0 + r32) * PS + C_QB + hq * 128 + 16 * s + 8 * h2);
        const float b15 = bt[hq * 192];
        f32x16 O[4];
#pragma unroll
        for (int mt = 0; mt < 4; ++mt)
#pragma unroll
            for (int i = 0; i < 16; ++i) O[mt][i] = 0.f;
        float m = -1e30f, lsum = 0.f;
        u32x4 kreg[2], vreg[2];
        const int srow = tid >> 4, sc8 = (tid & 15) * 8;
#define AT_LOAD(j) do { _Pragma("unroll") for (int it = 0; it < 2; ++it) { const size_t go = (size_t)(pb + 64 * (j) + srow + 32 * it) * 256 + n * 128 + sc8; \
            kreg[it] = *(const u32x4*)(KU + go); vreg[it] = *(const u32x4*)(VU + go); } } while (0)
#define AT_STORE(b) do { _Pragma("unroll") for (int it = 0; it < 2; ++it) { const int lo = AT_KV + (b) * AT_BUF + (srow + 32 * it) * AT_ROW + sc8 * 2; \
            *(LAS u32x4*)(lds + lo) = kreg[it]; *(LAS u32x4*)(lds + lo + AT_V) = vreg[it]; } } while (0)
        AT_LOAD(0); AT_STORE(0);
        __syncthreads();
#pragma unroll 1
        for (int j = 0; j < nk; ++j) {
            const bool more = (j + 1) < nk;
            if (more) AT_LOAD(j + 1);
            LAS unsigned char* kb = lds + AT_KV + (j & 1) * AT_BUF;
            LAS unsigned char* vb = kb + AT_V;
            f32x16 st[2];
#pragma unroll
            for (int sub = 0; sub < 2; ++sub) {
                h8 ka[8];
#pragma unroll
                for (int s = 0; s < 8; ++s) ka[s] = *(const LAS h8*)(kb + (32 * sub + r32) * AT_ROW + 32 * s + 16 * h2);
                f32x16 c0;
#pragma unroll
                for (int i = 0; i < 16; ++i) c0[i] = 0.f;
                SB();
#pragma unroll
                for (int s = 0; s < 8; ++s) c0 = MFMA32(ka[s], qf[s], c0);
                SB();
                st[sub] = c0;
            }
            const bool far = (64 * j + 63 - qpos0) <= -128;
            float mx = -1e30f;
            if (far) {
#pragma unroll
                for (int sub = 0; sub < 2; ++sub)
#pragma unroll
                    for (int i = 0; i < 16; ++i) { st[sub][i] = st[sub][i] * SCL2 + b15; mx = fmaxf(mx, st[sub][i]); }
            } else {
                const int relb = 64 * j + 4 * h2 - (qpos0 + r32) + 128;
#pragma unroll
                for (int sub = 0; sub < 2; ++sub)
#pragma unroll
                    for (int i = 0; i < 16; ++i) { int ri = relb + 32 * sub + (i & 3) + 8 * (i >> 2); ri = ri < 0 ? 0 : ri;
                        st[sub][i] = st[sub][i] * SCL2 + bt[hq * 192 + ri]; mx = fmaxf(mx, st[sub][i]); }
            }
            mx = fmaxf(mx, shx32(mx, lane));
            const float mnew = fmaxf(m, mx), alpha = __builtin_amdgcn_exp2f(m - mnew);
            m = mnew;
            const unsigned long long mw = mask[r32 * 65 + j];
            float ps = 0.f;
            h8 pf[2][2];
#pragma unroll
            for (int sub = 0; sub < 2; ++sub) {
                const unsigned wsh = ((unsigned)(mw >> (32 * sub))) >> (4 * h2);
#pragma unroll
                for (int i = 0; i < 16; ++i) { const float e = __builtin_amdgcn_exp2f(st[sub][i] - mnew);
                    const float pv = (wsh & (1u << ((i & 3) + 8 * (i >> 2)))) ? e : 0.f; st[sub][i] = pv; ps += pv; }
#pragma unroll
                for (int ks = 0; ks < 2; ++ks) { h8 t;
#pragma unroll
                    for (int jj = 0; jj < 8; ++jj) t[jj] = (f16)st[sub][8 * ks + jj];
                    pf[sub][ks] = t; }
            }
            lsum = lsum * alpha + ps;
            if (__any(alpha != 1.0f)) {
#pragma unroll
                for (int mt = 0; mt < 4; ++mt)
#pragma unroll
                    for (int i = 0; i < 16; ++i) O[mt][i] *= alpha;
            }
#pragma unroll
            for (int mp = 0; mp < 2; ++mp) {
                h8 va[2][4];
#pragma unroll
                for (int ml = 0; ml < 2; ++ml)
#pragma unroll
                    for (int sub = 0; sub < 2; ++sub)
#pragma unroll
                        for (int ks = 0; ks < 2; ++ks) {
                            LAS unsigned char* ap = vb + (32 * sub + 16 * ks + 4 * h2 + q4) * AT_ROW + 64 * (2 * mp + ml) + 8 * (4 * blk + p4);
                            const fp16x4_t lo = __builtin_amdgcn_ds_read_tr16_b64_v4f16((LAS fp16x4_t*)ap);
                            const fp16x4_t hi = __builtin_amdgcn_ds_read_tr16_b64_v4f16((LAS fp16x4_t*)(ap + 8 * AT_ROW));
                            va[ml][sub * 2 + ks] = __builtin_shufflevector(__builtin_bit_cast(h4, lo), __builtin_bit_cast(h4, hi), 0, 1, 2, 3, 4, 5, 6, 7);
                        }
                SB();
#pragma unroll
                for (int kk = 0; kk < 4; ++kk) { O[2 * mp] = MFMA32(va[0][kk], pf[kk >> 1][kk & 1], O[2 * mp]); O[2 * mp + 1] = MFMA32(va[1][kk], pf[kk >> 1][kk & 1], O[2 * mp + 1]); }
                SB();
            }
            if (more) AT_STORE((j + 1) & 1);
            __syncthreads();
        }
#undef AT_LOAD
#undef AT_STORE
        const float ltot = lsum + shx32(lsum, lane), inv = 1.0f / ltot;
        const size_t orow = (size_t)(rs0 + r32);
#pragma unroll
        for (int mt = 0; mt < 4; ++mt)
#pragma unroll
            for (int g = 0; g < 4; ++g) {
                const int d = hq * 128 + 32 * mt + 8 * g + 4 * h2;
                const h4 zb = *(const h4*)(PROJ + orow * PS + C_ZB + d);
                h4 ov;
#pragma unroll
                for (int jj = 0; jj < 4; ++jj) ov[jj] = (f16)(O[mt][4 * g + jj] * inv * (float)zb[jj]);
                *(h4*)(F.OB() + orow * 2048 + d) = ov;
            }
    }
    __syncthreads();
}

DI void phase_mix(const Frame F0, int l, int slab, int rep = 0) {
    const Frame F = F0.fresh();
    LAS int* ubox = (LAS int*)(F.lds + LDS_MISC + 64);
    unsigned* ctr = F.ctl() + CW_Q + (rep * 8 + l * NSLAB + slab) * 64;
    const int Ts = ts_of(slab);
    const int nchp = 64, nchs = slab == 0 ? 256 : 0, nch = nchp + nchs;
    for (;;) {
        if (F.tid == 0) ubox[0] = (int)__hip_atomic_fetch_add(ctr, 1u, __ATOMIC_RELAXED, __HIP_MEMORY_SCOPE_AGENT);
        __syncthreads();
        const int u = ubox[0];
        __syncthreads();
        if (u >= nch + Ts / 32) break;
        if (u < nchp) { gdn_scan_unit(F, l, slab, slab * 4 + (u >> 4), u & 15); if (PROBE_REP & 256) gdn_scan_unit(F, l, slab, slab * 4 + (u >> 4), u & 15); }
        else if (u < nch) { const int v = u - nchp; gdn_scan_unit(F, l, slab, 16 + (v >> 4), v & 15); }
        else {
            int q = u - nch, rs0;
            if (slab == 0 && q < 32) rs0 = 8192 + 32 * q;
            else { if (slab == 0) q -= 32; rs0 = (q & 3) * 2048 + (63 - (q >> 2)) * 32; }
            attn_unit(F, l, slab, rs0);
        }
    }
}

DI void phase_pre(const Frame F0, int l, int slab) {
    const int nc = slab == 0 ? 144 : 128;
    for (int u = F0.bid; u < nc * 16; u += F0.G) gdn_pre_unit(F0, l, slab, u >> 4, u & 15);
}
DI void phase_final(const Frame F0) {
    const Frame F = F0.fresh();
    const float* nw = F.in(I_FNW);
    for (int R = F.bid * NWAVES + F.wave; R < NTOK; R += F.G * NWAVES) {
        float* x = F.out() + (size_t)R * D;
        f32x4 v[8]; float ss = 0.f;
#pragma unroll
        for (int i = 0; i < 8; ++i) { v[i] = *(const f32x4*)(x + (i * 64 + F.lane) * 4); ss += v[i][0] * v[i][0] + v[i][1] * v[i][1] + v[i][2] * v[i][2] + v[i][3] * v[i][3]; }
        ss = wave_sum(ss, F.lane);
        const float r = rsqrtf(ss * (1.0f / 2048.0f) + EPS);
#pragma unroll
        for (int i = 0; i < 8; ++i) { const int c = (i * 64 + F.lane) * 4; *(f32x4*)(x + c) = v[i] * r * *(const f32x4*)(nw + c); }
    }
}

DI void phase_inproj(const Frame F, int l, int s) {
    const int Ts = ts_of(s);
    pg8::Gemm g{F.H(), F.WIN() + (size_t)l * NP * 2048, F.H(), F.WIN() + (size_t)l * NP * 2048, Ts, NP, 2048};
    pg8::StaticOrder S; S.init(Ts, NP, F.G, F.bid);
    EpiProj E{F.PROJ(), F.out(), F.KU(), F.VU(), F.KIU(), F.WI(), F.BETA(), F.GG(), F.in(I_ALOG) + l * 16, F.in(I_DTB) + l * 16, l, s};
    pg8::gemm_phase<EpiProj, pg8::StaticOrder>(F.lds, g, S, E, F.wave);
}
DI void phase_ab(const Frame F, int l, int s) {
    const int Ts = ts_of(s);
    pg8::Gemm g{F.OA(), F.WA() + (size_t)l * 2048 * 2048, F.OB(), F.WB() + (size_t)l * 2048 * 2048, Ts, 2048, 2048};
    pg8::DualOrder S; S.init(Ts, 2048, F.G, F.bid);
    EpiAB E{F.PROJ(), F.H()};
    pg8::gemm_phase<EpiAB, pg8::DualOrder>(F.lds, g, S, E, F.wave);
}
DI void phase_outp(const Frame F, int l, int s) {
    const int Ts = ts_of(s);
    pg8::Gemm g{F.H(), F.WO() + (size_t)l * 2048 * 2048, F.H(), F.WO() + (size_t)l * 2048 * 2048, Ts, 2048, 2048};
    pg8::StaticOrder S; S.init(Ts, 2048, F.G, F.bid);
    EpiOut E{F.in(I_XP), F.in(I_XS), F.out(), F.ADA() + (size_t)l * 32 * 6144, l, s};
    pg8::gemm_phase<EpiOut, pg8::StaticOrder>(F.lds, g, S, E, F.wave);
}
constexpr int NPH = 6;
constexpr int N_PHASES = 1 + 2 * NSLAB * NPH + 1;
__global__ void __launch_bounds__(NTHR, 2) fwd_kernel(Args args) {
    extern __shared__ __attribute__((aligned(16))) unsigned char lds[];
    Frame F;
    F.lds = (LAS unsigned char*)lds;
    F.tid = threadIdx.x; F.lane = F.tid & 63; F.wave = __builtin_amdgcn_readfirstlane(F.tid >> 6); F.G = gridDim.x; F.bid = blockIdx.x;
    if (F.tid < 22) *(LAS unsigned long long*)(F.lds + LDS_TAB + 8 * F.tid) = (unsigned long long)args.in[F.tid];
    if (F.tid == 22) *(LAS unsigned long long*)(F.lds + LDS_TAB + 8 * 22) = (unsigned long long)args.out;
    if (F.tid == 23) *(LAS unsigned long long*)(F.lds + LDS_TAB + 8 * 23) = (unsigned long long)args.ws;
    volatile LAS unsigned* MISC = (volatile LAS unsigned*)(F.lds + LDS_MISC);
    if (F.tid < 64) MISC[F.tid] = 0u;
    __syncthreads();
    const int lo = args.ph_lo, hi = args.ph_hi;
    const bool multi = (hi - lo) > 1;
    if (multi) (void)xcd_barrier_post(F.ctl() + CW_BAR, MISC);
#define IN(k) (lo <= (k) && (k) < hi)
#define GBAR() do { XcdBarrier bar_; bar_.bar = F.ctl() + CW_BAR; bar_.x = xb_xcc_id(); bar_.st = MISC; xcd_barrier(bar_, (int)(lane_id_fresh() == 0 && F.wave == 0)); } while (0)
#define SEAM(k) do { if (IN(k) && IN((k) + 1)) { XcdBarrier bar_; bar_.bar = F.ctl() + CW_BAR; bar_.x = xb_xcc_id(); bar_.st = MISC; xcd_barrier(bar_, (int)(lane_id_fresh() == 0 && F.wave == 0)); } } while (0)
    if (IN(0)) { p0_prologue(F); if (PROBE_REP & 64) { GBAR(); p0_prologue(F); } }
    SEAM(0);
    for (int l = 0; l < 2; ++l)
        for (int s = 0; s < NSLAB; ++s) {
            const int pb = 1 + (l * NSLAB + s) * NPH;
            if (IN(pb)) { phase_norm(F, l, s); if (PROBE_REP & 1) { GBAR(); phase_norm(F, l, s); } }
            SEAM(pb);
            if (IN(pb + 1)) { phase_inproj(F, l, s); if (PROBE_REP & 2) { GBAR(); phase_inproj(F, l, s); } }
            SEAM(pb + 1);
            if (IN(pb + 2)) { phase_pre(F, l, s); if (PROBE_REP & 4) { GBAR(); phase_pre(F, l, s); } }
            SEAM(pb + 2);
            if (IN(pb + 3)) { phase_mix(F, l, s); if (PROBE_REP & 8) { GBAR(); phase_mix(F, l, s, 1); } }
            SEAM(pb + 3);
            if (IN(pb + 4)) { phase_ab(F, l, s); if (PROBE_REP & 16) { GBAR(); phase_ab(F, l, s); } }
            SEAM(pb + 4);
            if (IN(pb + 5)) { phase_outp(F, l, s); if (PROBE_REP & 32) { GBAR(); phase_outp(F, l, s); } }
            SEAM(pb + 5);
        }
    if (IN(N_PHASES - 1)) phase_final(F);
#undef IN
#undef SEAM
}

extern "C" void kernel_launch(void* const* d_in, const int* in_sizes, int n_in, void* d_out, int out_size, void* d_ws, size_t ws_size, hipStream_t stream) {
    static int grid = 0;
    if (grid == 0) {
        if (n_in != 22 || (size_t)out_size != O_END || ws_size < WS_END) { fprintf(stderr, "kernel_launch: unexpected shapes (n_in %d out %d ws %zu, need %zu)\n", n_in, out_size, ws_size, (size_t)WS_END); grid = -1; return; }
        int dev = 0, cus = 0, per_cu = 0;
        if (hipGetDevice(&dev) != hipSuccess || hipDeviceGetAttribute(&cus, hipDeviceAttributeMultiprocessorCount, dev) != hipSuccess) { grid = -1; return; }
        if (hipFuncSetAttribute((const void*)fwd_kernel, hipFuncAttributeMaxDynamicSharedMemorySize, LDS_BYTES) != hipSuccess) { fprintf(stderr, "kernel_launch: hipFuncSetAttribute failed\n"); grid = -1; return; }
        if (hipOccupancyMaxActiveBlocksPerMultiprocessor(&per_cu, (const void*)fwd_kernel, NTHR, LDS_BYTES) != hipSuccess || per_cu < 1) { fprintf(stderr, "kernel_launch: occupancy query says %d\n", per_cu); }
        (void)hipGetLastError();
        grid = cus;
    }
    if (grid < 0) return;
    (void)hipMemsetAsync((char*)d_ws + WS_CTL, 0, CTL_BYTES, stream);
    Args a{};
    for (int i = 0; i < 22; ++i) a.in[i] = (const float*)d_in[i];
    a.out = (float*)d_out; a.ws = (unsigned char*)d_ws;
#if MK_ONE_LAUNCH
    a.ph_lo = 0; a.ph_hi = N_PHASES;
    hipLaunchKernelGGL(fwd_kernel, dim3(grid), dim3(NTHR), LDS_BYTES, stream, a);
#else
    for (int p = 0; p < N_PHASES; ++p) { a.ph_lo = p; a.ph_hi = p + 1; hipLaunchKernelGGL(fwd_kernel, dim3(grid), dim3(NTHR), LDS_BYTES, stream, a); }
#endif
}
```

```cpp
#include <hip/hip_runtime.h>
#include <cstdio>
#include <cstdint>

#ifndef PROBE_REP
#define PROBE_REP 0
#endif
#ifndef MK_ONE_LAUNCH
#define MK_ONE_LAUNCH 1
#endif

#define LAS __attribute__((address_space(3)))
#define GLB __attribute__((address_space(1)))
typedef _Float16 f16;
typedef _Float16 h8 __attribute__((ext_vector_type(8)));
typedef _Float16 h4 __attribute__((ext_vector_type(4)));
typedef _Float16 h2 __attribute__((ext_vector_type(2)));
typedef float f32x4 __attribute__((ext_vector_type(4)));
typedef float f32x2 __attribute__((ext_vector_type(2)));
typedef unsigned u32x4 __attribute__((ext_vector_type(4)));
typedef unsigned u32x2 __attribute__((ext_vector_type(2)));
#define DI __device__ __forceinline__

constexpr int D = 2048, NTOKP = 32768, NTOKS = 1024, NTOK = NTOKP + NTOKS;
constexpr int IN_DIM = 18032, NP = 18176, PS = 17408;
constexpr int LSMP = 4160, PAST = 4096;
constexpr int NSLAB = 4, NWAVES = 8, NTHR = 512;
constexpr int C_QKV = 0, C_ZA = 6144, C_QB = 8192, C_ZB = 10240, C_QI = 12288, C_GA = 13312, C_GB = 15360;
constexpr float EPS = 1e-6f;
constexpr int NPOS = 16 * 2048 + 16 * LSMP;

constexpr size_t O_YP = 0, O_YS = O_YP + (size_t)NTOKP * D, O_NKP = O_YS + (size_t)NTOKS * D, O_NVP = O_NKP + (size_t)2 * 16 * 2048 * 256,
    O_NIP = O_NVP + (size_t)2 * 16 * 2048 * 256, O_NGP = O_NIP + (size_t)2 * 16 * 2048 * 64, O_NCP = O_NGP + (size_t)2 * 16 * 16 * 16384,
    O_NKS = O_NCP + (size_t)2 * 16 * 3 * 6144, O_NVS = O_NKS + (size_t)2 * 16 * 64 * 256, O_NIS = O_NVS + (size_t)2 * 16 * 64 * 256,
    O_NGS = O_NIS + (size_t)2 * 16 * 64 * 64, O_NCS = O_NGS + (size_t)2 * 16 * 16 * 16384, O_END = O_NCS + (size_t)2 * 16 * 3 * 6144;
static_assert(O_END == 126091264ull, "output size");

constexpr size_t al256(size_t x) { return (x + 255) & ~(size_t)255; }
constexpr size_t WS_CTL = 0, CTL_BYTES = 1u << 20;
constexpr size_t WS_ADA = WS_CTL + CTL_BYTES;
constexpr size_t WS_WIN = al256(WS_ADA + (size_t)2 * 32 * 6144 * 4);
constexpr size_t WS_WA = al256(WS_WIN + (size_t)2 * NP * 2048 * 2);
constexpr size_t WS_WB = al256(WS_WA + (size_t)2 * 2048 * 2048 * 2);
constexpr size_t WS_WO = al256(WS_WB + (size_t)2 * 2048 * 2048 * 2);
constexpr size_t WS_H = al256(WS_WO + (size_t)2 * 2048 * 2048 * 2);
constexpr size_t WS_PROJ = al256(WS_H + (size_t)9216 * 2048 * 2);
constexpr size_t WS_OA = al256(WS_PROJ + (size_t)9216 * PS * 2);
constexpr size_t WS_OB = al256(WS_OA + (size_t)9216 * 2048 * 2);
constexpr size_t WS_KU = al256(WS_OB + (size_t)9216 * 2048 * 2);
constexpr size_t WS_VU = al256(WS_KU + (size_t)NPOS * 256 * 2);
constexpr size_t WS_KIU = al256(WS_VU + (size_t)NPOS * 256 * 2);
constexpr size_t WS_WI = al256(WS_KIU + (size_t)NPOS * 64 * 2);
constexpr size_t WS_BETA = al256(WS_WI + (size_t)NTOK * 16 * 4);
constexpr size_t WS_G = al256(WS_BETA + (size_t)NTOK * 16 * 4);
constexpr int LDR = 4160;
constexpr size_t WS_SCR = al256(WS_G + (size_t)NTOK * 16 * 4);
constexpr int GP_W = 0, GP_QD = 16384, GP_KD = 32768, GP_U = 49152, GP_QK = 65536, GP_STRIDE = 73728;
constexpr size_t WS_GP = al256(WS_SCR + (size_t)256 * 32 * LDR * 4);
constexpr size_t WS_GL = al256(WS_GP + (size_t)144 * 16 * GP_STRIDE);
constexpr size_t WS_END = al256(WS_GL + (size_t)144 * 16 * 4);

constexpr int LDS_BYTES = 147456, LDS_MISC = 131072;

#define XB_TMO      128
#define XB_XCNT(j)  (256  + 64 * (j))
#define XB_XSUB(j)  (1280 + 64 * (j))
#define XB_XGEN(j)  (2304 + 64 * (j))
#define XB_TOP      3328
#define XB_TOPGEN   3392
#define XCD_BAR_WORDS 3456
#define XB_SPIN_CAP (1u << 18)
__device__ __forceinline__ unsigned xb_ld(unsigned* p)              { return __hip_atomic_load(p, __ATOMIC_RELAXED, __HIP_MEMORY_SCOPE_AGENT); }
__device__ __forceinline__ unsigned xb_add(unsigned* p, unsigned v) { return __hip_atomic_fetch_add(p, v, __ATOMIC_RELAXED, __HIP_MEMORY_SCOPE_AGENT); }
__device__ __forceinline__ unsigned xb_xcc_id() { return (unsigned)__builtin_amdgcn_s_getreg((3 << 11) | 20) & 0xFu; }
#define XB_SPIN(cond, bar) do { unsigned _sp = 0; while (cond) { __builtin_amdgcn_s_sleep(1); \
    if ((++_sp & 255u) == 0u) { if (xb_ld(&(bar)[XB_TMO])) break; if (_sp > XB_SPIN_CAP) { atomicAdd(&(bar)[XB_TMO], 1u); break; } } } } while (0)
struct XcdBarrier { unsigned* bar; unsigned x; volatile LAS unsigned* st; };
__device__ __forceinline__ XcdBarrier xcd_barrier_post(unsigned* bar, volatile LAS unsigned* st) {
    XcdBarrier b; b.bar = bar; b.x = xb_xcc_id(); b.st = st;
    if (threadIdx.x == 0) (void)xb_add(&bar[XB_XCNT(b.x)], 1u);
    return b;
}
__device__ __forceinline__ void xcd_barrier_complete(unsigned* bar, unsigned x, unsigned& nloc, unsigned& nx) {
    const unsigned G = gridDim.x * gridDim.y * gridDim.z;
    unsigned sum, cnt, mine, sp = 0u;
    for (;;) {
        sum = 0u; cnt = 0u; mine = 0u;
#pragma unroll
        for (unsigned j = 0; j < 16; ++j) { const unsigned c = xb_ld(&bar[XB_XCNT(j)]); sum += c; cnt += (c > 0u) ? 1u : 0u; mine = (j == x) ? c : mine; }
        if (sum == G) break;
        __builtin_amdgcn_s_sleep(1);
        if ((++sp & 255u) == 0u) { if (xb_ld(&bar[XB_TMO])) break; if (sp > XB_SPIN_CAP) { atomicAdd(&bar[XB_TMO], 1u); break; } }
    }
    nloc = mine > 0u ? mine : 1u; nx = cnt > 0u ? cnt : 1u;
}
__device__ __forceinline__ void xcd_barrier(const XcdBarrier b, const int leader) {
    asm volatile("s_waitcnt vmcnt(0)" ::: "memory");
    __syncthreads();
    if (leader) {
        unsigned* bar = b.bar;
        __builtin_amdgcn_s_waitcnt(0);
        unsigned nloc = b.st[0], nx = b.st[1];
        if (nloc == 0u) { xcd_barrier_complete(bar, b.x, nloc, nx); b.st[0] = nloc; b.st[1] = nx; }
        const unsigned old = xb_add(&bar[XB_XSUB(b.x)], 1u);
        const unsigned gen = old / nloc;
        if (old + 1u == (gen + 1u) * nloc) {
            __builtin_amdgcn_fence(__ATOMIC_RELEASE, "agent");
            asm volatile("s_waitcnt vmcnt(0)" ::: "memory");
            const unsigned og = xb_add(&bar[XB_TOP], 1u);
            const unsigned tg = og / nx;
            if (og + 1u == (tg + 1u) * nx) xb_add(&bar[XB_TOPGEN], 1u);
            else XB_SPIN(xb_ld(&bar[XB_TOPGEN]) == tg, bar);
            __builtin_amdgcn_fence(__ATOMIC_ACQUIRE, "agent");
            xb_add(&bar[XB_XGEN(b.x)], 1u);
            asm volatile("s_waitcnt vmcnt(0)" ::: "memory");
        } else {
            XB_SPIN(xb_ld(&bar[XB_XGEN(b.x)]) == gen, bar);
            __builtin_amdgcn_fence(__ATOMIC_ACQUIRE, "agent");
            asm volatile("s_waitcnt vmcnt(0)" ::: "memory");
        }
    }
    __syncthreads();
}

DI int lane_id_fresh() { unsigned z = 0u; asm volatile("" : "+v"(z)); return (int)__builtin_amdgcn_mbcnt_hi(~0u, __builtin_amdgcn_mbcnt_lo(~0u, z)); }
template <int O> DI float swz_xor(float v) { return __builtin_bit_cast(float, __builtin_amdgcn_ds_swizzle(__builtin_bit_cast(int, v), (O << 10) | 0x1F)); }
DI float shx32(float v, int lane) { return __builtin_bit_cast(float, __builtin_amdgcn_ds_bpermute((lane ^ 32) << 2, __builtin_bit_cast(int, v))); }
DI float wave_sum(float v, int lane) {
    v += swz_xor<1>(v); v += swz_xor<2>(v); v += swz_xor<4>(v); v += swz_xor<8>(v); v += swz_xor<16>(v);
    return v + shx32(v, lane);
}
DI float sigmoidf_(float x) { return 1.0f / (1.0f + __expf(-x)); }
DI float siluf_(float x) { return x / (1.0f + __expf(-x)); }
DI unsigned pk_f16(float lo, float hi) { h2 v = {(f16)lo, (f16)hi}; return __builtin_bit_cast(unsigned, v); }
DI void rowinfo(int slab, int rs, int& R, int& sq, int& t) {
    if (rs < 8192) { R = slab * 8192 + rs; sq = R >> 11; t = R & 2047; }
    else { const int q = rs - 8192; R = NTOKP + q; sq = 16 + (q >> 6); t = q & 63; }
}
DI int posbase(int sq) { return sq < 16 ? sq * 2048 : 32768 + (sq - 16) * LSMP; }
__host__ __device__ inline int ts_of(int slab) { return slab == 0 ? 9216 : 8192; }
DI int proj_src_col(int n) {
    if (n < 8192) return n;
    if (n < 10240) return 8224 + (n - 8192);
    if (n < 12288) return 10784 + (n - 10240);
    if (n < 13312) return 12832 + (n - 12288);
    if (n < 15360) return 13936 + (n - 13312);
    if (n < 17408) return 15984 + (n - 15360);
    if (n < 17664) return 10272 + (n - 17408);
    if (n < 17920) return 10528 + (n - 17664);
    const int j = n - 17920;
    if (j < 64) return 13856 + j;
    if (j < 80) return 13920 + (j - 64);
    if (j < 96) return 8192 + (j - 80);
    if (j < 112) return 8208 + (j - 96);
    return -1;
}
DI int rel_bucket(int rel) {
    const int n = rel < 0 ? -rel : rel;
    const int v = n < 8 ? n : (n < 12 ? 8 : n < 16 ? 9 : n < 23 ? 10 : n < 32 ? 11 : n < 46 ? 12 : n < 64 ? 13 : n < 91 ? 14 : 15);
    return (rel > 0 ? 16 : 0) + v;
}

namespace pg8 {
constexpr int BM = 256, BK = 64, HALF = 128, HTB = HALF * BK * 2, STAGE_BYTES = 8 * HTB, NXCD = 8, WGM = 8;
DI int lds_byte(int r, int c) { const int st = (r >> 4) * 2 + (c >> 5), rr = r & 15, cc = c & 31, ob = rr * 64 + cc * 2; return st * 1024 + (ob ^ (((ob >> 9) & 1) << 5)); }
DI void stage_rc(int b, int& R, int& C) { const int st = b / 1024, sb = b % 1024, swz = sb ^ (((sb >> 9) & 1) << 5); R = (st >> 1) * 16 + swz / 64; C = (st & 1) * 32 + (swz % 64) / 2; }
DI int perm32(int rho) { const int n = rho >> 4, i = rho & 15; return 8 * (i >> 2) + 4 * n + (i & 3); }

struct Unit { int pm, pn, which; };
struct Gemm { GLB const f16* A0; GLB const f16* B0; GLB const f16* A1; GLB const f16* B1; int M, N, K; };

struct StaticOrder {
    int nM, nN, nwg, G, c;
    DI void init(int M, int N, int G_, int c_) { nM = M / BM; nN = N / BM; nwg = nM * nN; G = G_; c = c_; }
    DI bool tile(long L, Unit& u) const {
        if (L >= nwg) return false;
        int wgid = (int)L; { const int q = nwg / NXCD, r = nwg % NXCD, xcd = wgid % NXCD, off = wgid / NXCD; wgid = (xcd < r ? xcd * (q + 1) : r * (q + 1) + (xcd - r) * q) + off; }
        const int nig = WGM * nN, gid = wgid / nig, fm = gid * WGM, gsz = (nM - fm) < WGM ? (nM - fm) : WGM;
        u.pm = fm + ((wgid % nig) % gsz); u.pn = (wgid % nig) / gsz; return true;
    }
    DI bool next(int i, Unit& u) const { u.which = 0; return tile((long)i * G + c, u); }
};
struct DualOrder : StaticOrder {
    DI bool next(int i, Unit& u) const { u.which = i & 1; return tile((long)(i >> 1) * G + c, u); }
};

template <class Epi, class Sched, bool ALIGN_EPI = true>
DI void gemm_phase(LAS unsigned char* lds, const Gemm g, const Sched& S, const Epi& E, int wave_s) {
    int tid_ = lane_id_fresh() + wave_s * 64; asm volatile("" : "+v"(tid_));
    const int tid = tid_, wid = __builtin_amdgcn_readfirstlane(tid >> 6), lane = tid & 63, wr = wid >> 2, wc = wid & 3, fr = lane & 15, fq = lane >> 4;
    const int K = g.K, nt = K / BK;
    unsigned voffA[2], voffB[2];
#pragma unroll
    for (int i = 0; i < 2; ++i) { int R, C; stage_rc(tid * 16 + i * 8192, R, C); const int Rb = (R & ~31) + perm32(R & 31);
        voffA[i] = (unsigned)(R * K + C) * 2u; voffB[i] = (unsigned)(Rb * K + C) * 2u; }
    const size_t kstep = (size_t)(BK * 2);
    const size_t hstep = (size_t)HALF * K * 2;
    const size_t tstep = 2 * hstep;
    const unsigned ldsw = (unsigned)wid * 1024u;
    const int aoff = lds_byte(wr * 64 + fr, fq * 8), boff = lds_byte(wc * 32 + fr, fq * 8);
#define PG8_SA(b, h) (((b) * 2 + (h)) * HTB)
#define PG8_SB(b, h) ((4 + (b) * 2 + (h)) * HTB)
#define PG8_STAGE(bufoff, gbase, voff) do { _Pragma("unroll") for (int _i = 0; _i < 2; ++_i) \
        __builtin_amdgcn_global_load_lds((GLB const unsigned*)((GLB const char*)(gbase) + (voff)[_i]), (LAS unsigned*)(lds + (bufoff) + ldsw + _i * 8192), 16, 0, 0); } while (0)
#define PG8_LDA(dst, b, h) do { _Pragma("unroll") for (int m = 0; m < 4; ++m) _Pragma("unroll") for (int k = 0; k < 2; ++k) dst[m][k] = *(const LAS h8*)(lds + PG8_SA(b, h) + aoff + m * 2048 + k * 1024); } while (0)
#define PG8_LDB(dst, b, h) do { _Pragma("unroll") for (int n = 0; n < 2; ++n) _Pragma("unroll") for (int k = 0; k < 2; ++k) dst[n][k] = *(const LAS h8*)(lds + PG8_SB(b, h) + boff + n * 2048 + k * 1024); } while (0)
#define PG8_MMA(ai, bj, At, Bt) do { __builtin_amdgcn_s_setprio(1); _Pragma("unroll") for (int m = 0; m < 4; ++m) _Pragma("unroll") for (int n = 0; n < 2; ++n) _Pragma("unroll") for (int k = 0; k < 2; ++k) \
        acc[ai][bj][m][n] = __builtin_amdgcn_mfma_f32_16x16x32_f16(Bt[n][k], At[m][k], acc[ai][bj][m][n], 0, 0, 0); __builtin_amdgcn_s_setprio(0); } while (0)
#define PG8_WAIT_V(n) asm volatile("s_waitcnt vmcnt(" #n ")" ::: "memory")
#define PG8_WAIT_L(n) asm volatile("s_waitcnt lgkmcnt(" #n ")" ::: "memory")
#define PG8_BAR __builtin_amdgcn_s_barrier()
#define PG8_SCHED __builtin_amdgcn_sched_barrier(0)
    Unit cur, nxt; int ui = 0;
    if (!S.next(0, cur)) return;
    f32x4 acc[2][2][4][2];
#pragma unroll
    for (int a = 0; a < 2; ++a)
#pragma unroll
        for (int b = 0; b < 2; ++b)
#pragma unroll
            for (int m = 0; m < 4; ++m)
#pragma unroll
                for (int n = 0; n < 2; ++n) acc[a][b][m][n] = (f32x4){0.f, 0.f, 0.f, 0.f};
    h8 At[4][2], B0[2][2], B1[2][2];
    GLB const char* cA = (GLB const char*)(cur.which ? g.A1 : g.A0) + (size_t)cur.pm * tstep; GLB const char* cB = (GLB const char*)(cur.which ? g.B1 : g.B0) + (size_t)cur.pn * tstep;
    PG8_STAGE(PG8_SB(0, 0), cB, voffB); PG8_STAGE(PG8_SB(0, 1), cB + hstep, voffB); PG8_STAGE(PG8_SA(0, 0), cA, voffA); PG8_STAGE(PG8_SA(0, 1), cA + hstep, voffA);
    if (wr == 1) PG8_BAR;
    PG8_WAIT_V(2); PG8_BAR;
    PG8_STAGE(PG8_SB(1, 0), cB + kstep, voffB); PG8_STAGE(PG8_SA(1, 0), cA + kstep, voffA); PG8_STAGE(PG8_SB(1, 1), cB + hstep + kstep, voffB);
    PG8_WAIT_V(6); PG8_BAR;
    for (;;) {
        const bool has_next = S.next(ui + 1, nxt);
        GLB const char* nA = has_next ? (GLB const char*)(nxt.which ? g.A1 : g.A0) + (size_t)nxt.pm * tstep : cA; GLB const char* nB = has_next ? (GLB const char*)(nxt.which ? g.B1 : g.B0) + (size_t)nxt.pn * tstep : cB;
        for (int t = 0; t < nt; t += 2) {
            const bool last = (t == nt - 2);
            GLB const char* a1 = cA + (size_t)(t + 1) * kstep;
            GLB const char* a2 = last ? nA : cA + (size_t)(t + 2) * kstep; GLB const char* b2 = last ? nB : cB + (size_t)(t + 2) * kstep;
            GLB const char* a3 = a2 + kstep; GLB const char* b3 = b2 + kstep;
            PG8_LDB(B0, 0, 0); PG8_LDB(B1, 0, 1); PG8_SCHED; PG8_LDA(At, 0, 0); PG8_STAGE(PG8_SA(1, 1), a1 + hstep, voffA);
            PG8_WAIT_V(8); PG8_WAIT_L(0); PG8_BAR; PG8_MMA(0, 0, At, B0); PG8_MMA(0, 1, At, B1); PG8_BAR; PG8_SCHED;
            PG8_LDA(At, 0, 1); PG8_STAGE(PG8_SB(0, 0), b2, voffB); PG8_STAGE(PG8_SB(0, 1), b2 + hstep, voffB); PG8_STAGE(PG8_SA(0, 0), a2, voffA);
            PG8_WAIT_V(8); PG8_WAIT_L(0); PG8_BAR; PG8_MMA(1, 0, At, B0); PG8_MMA(1, 1, At, B1); PG8_BAR; PG8_SCHED;
            PG8_LDB(B0, 1, 0); PG8_LDB(B1, 1, 1); PG8_SCHED; PG8_LDA(At, 1, 0); PG8_STAGE(PG8_SA(0, 1), a2 + hstep, voffA);
            PG8_WAIT_V(8); PG8_WAIT_L(0); PG8_BAR; PG8_MMA(0, 0, At, B0); PG8_MMA(0, 1, At, B1); PG8_BAR; PG8_SCHED;
            PG8_LDA(At, 1, 1); PG8_STAGE(PG8_SB(1, 0), b3, voffB); PG8_STAGE(PG8_SB(1, 1), b3 + hstep, voffB); PG8_STAGE(PG8_SA(1, 0), a3, voffA);
            PG8_WAIT_V(8); PG8_WAIT_L(0); PG8_BAR; PG8_MMA(1, 0, At, B0); PG8_MMA(1, 1, At, B1); PG8_BAR; PG8_SCHED;
        }
        if constexpr (ALIGN_EPI) { if (wr == 0) PG8_BAR; }
        E(acc, cur, wr, wc, fr, fq);
        if (!has_next) break;
#pragma unroll
        for (int a = 0; a < 2; ++a)
#pragma unroll
            for (int b = 0; b < 2; ++b)
#pragma unroll
                for (int m = 0; m < 4; ++m)
#pragma unroll
                    for (int n = 0; n < 2; ++n) acc[a][b][m][n] = (f32x4){0.f, 0.f, 0.f, 0.f};
        cur = nxt; cA = nA; cB = nB; ++ui;
        if constexpr (ALIGN_EPI) { if (wr == 1) PG8_BAR; }
    }
    PG8_WAIT_V(0);
    if constexpr (!ALIGN_EPI) { if (wr == 0) PG8_BAR; }
    PG8_BAR;
#undef PG8_SA
#undef PG8_SB
#undef PG8_STAGE
#undef PG8_LDA
#undef PG8_LDB
#undef PG8_MMA
#undef PG8_WAIT_V
#undef PG8_WAIT_L
#undef PG8_BAR
#undef PG8_SCHED
}
}

struct Args { const float* in[22]; float* out; unsigned char* ws; int ph_lo, ph_hi; };
constexpr int LDS_TAB = LDS_MISC + 256;
DI unsigned long long ldtab(LAS unsigned char* lds, int i) {
    const unsigned vx = *(const volatile LAS unsigned*)(lds + LDS_TAB + 8 * i), vy = *(const volatile LAS unsigned*)(lds + LDS_TAB + 8 * i + 4); u32x2 v; v.x = vx; v.y = vy;
    return ((unsigned long long)(unsigned)__builtin_amdgcn_readfirstlane((int)v.y) << 32) | (unsigned)__builtin_amdgcn_readfirstlane((int)v.x);
}
struct Frame {
    LAS unsigned char* lds; int tid, lane, wave, G, bid;
    DI Frame fresh() const { Frame f = *this; int t = lane_id_fresh() + wave * 64; asm volatile("" : "+v"(t)); f.tid = t; f.lane = t & 63; f.wave = wave; return f; }
    DI GLB const float* in(int i) const { return (GLB const float*)ldtab(lds, i); }
    DI GLB float* out() const { return (GLB float*)ldtab(lds, 22); }
    DI GLB unsigned char* ws() const { return (GLB unsigned char*)ldtab(lds, 23); }
    DI unsigned* ctl() const { return (unsigned*)ldtab(lds, 23); }
    DI GLB float* ADA() const { return (GLB float*)(ws() + WS_ADA); }
    DI GLB f16* WIN() const { return (GLB f16*)(ws() + WS_WIN); }
    DI GLB f16* WA() const { return (GLB f16*)(ws() + WS_WA); }
    DI GLB f16* WB() const { return (GLB f16*)(ws() + WS_WB); }
    DI GLB f16* WO() const { return (GLB f16*)(ws() + WS_WO); }
    DI GLB f16* H() const { return (GLB f16*)(ws() + WS_H); }
    DI GLB f16* PROJ() const { return (GLB f16*)(ws() + WS_PROJ); }
    DI GLB f16* OA() const { return (GLB f16*)(ws() + WS_OA); }
    DI GLB f16* OB() const { return (GLB f16*)(ws() + WS_OB); }
    DI GLB f16* KU() const { return (GLB f16*)(ws() + WS_KU); }
    DI GLB f16* VU() const { return (GLB f16*)(ws() + WS_VU); }
    DI GLB f16* KIU() const { return (GLB f16*)(ws() + WS_KIU); }
    DI GLB float* WI() const { return (GLB float*)(ws() + WS_WI); }
    DI GLB float* BETA() const { return (GLB float*)(ws() + WS_BETA); }
    DI GLB float* GG() const { return (GLB float*)(ws() + WS_G); }
};
enum { I_XP = 0, I_XS, I_CP, I_CS, I_CK, I_CV, I_CIK, I_SG, I_SC, I_NW, I_WADA, I_BADA, I_WIN, I_WCONV, I_ALOG, I_DTB, I_GNW, I_WBA, I_WBB, I_WOUT, I_RELB, I_FNW };
constexpr int CW_BAR = 0, CW_Q = 4096;

struct EpiProj {
    static constexpr bool PERM = true;
    GLB f16* proj; GLB float* out; GLB f16 *KU, *VU, *KIU; GLB float *WI, *BETA, *GG; GLB const float *a_log, *dt_bias; int layer, slab;
    DI void operator()(const f32x4 (&acc)[2][2][4][2], const pg8::Unit& u, int wr, int wc, int fr_, int fq_) const {
        int fr = fr_, fq = fq_; asm volatile("" : "+v"(fr), "+v"(fq));
        const int pn = u.pn;
        const int rsb = u.pm * 256 + wr * 64 + fr;
        if (pn < 68) {
            const int act = ((pn >= 24 && pn < 32) || (pn >= 40 && pn < 48)) ? 1 : (pn >= 52 ? 2 : 0);
            const int col0 = pn * 256 + wc * 32 + 8 * fq;
#pragma unroll
            for (int ai = 0; ai < 2; ++ai)
#pragma unroll
                for (int m = 0; m < 4; ++m) {
                    GLB f16* rowp = proj + (size_t)(rsb + ai * 128 + m * 16) * PS + col0;
#pragma unroll
                    for (int bj = 0; bj < 2; ++bj) {
                        f32x4 v0 = acc[ai][bj][m][0], v1 = acc[ai][bj][m][1];
                        if (act == 1) {
#pragma unroll
                            for (int j = 0; j < 4; ++j) { v0[j] = siluf_(v0[j]); v1[j] = siluf_(v1[j]); }
                        } else if (act == 2) {
#pragma unroll
                            for (int j = 0; j < 4; ++j) { v0[j] = sigmoidf_(v0[j]); v1[j] = sigmoidf_(v1[j]); }
                        }
                        u32x4 w; w.x = pk_f16(v0[0], v0[1]); w.y = pk_f16(v0[2], v0[3]); w.z = pk_f16(v1[0], v1[1]); w.w = pk_f16(v1[2], v1[3]);
                        *(GLB u32x4*)(rowp + bj * 128) = w;
                    }
                }
            if (pn < 24 && fr >= 13) {
                const bool smp = u.pm >= 32;
                if (smp || (u.pm & 7) == 7) {
#pragma unroll
                    for (int ai = 0; ai < 2; ++ai) {
                        if (!smp && !(ai == 1 && wr == 1)) continue;
                        int R, sq, t; rowinfo(slab, rsb + ai * 128 + 48, R, sq, t);
                        const int T = smp ? 64 : 2048;
                        GLB float* base = out + (smp ? O_NCS : O_NCP) + ((size_t)(layer * 16 + (sq & 15)) * 3 + (t - (T - 3))) * 6144 + col0;
#pragma unroll
                        for (int bj = 0; bj < 2; ++bj) { *(GLB f32x4*)(base + bj * 128) = acc[ai][bj][3][0]; *(GLB f32x4*)(base + bj * 128 + 4) = acc[ai][bj][3][1]; }
                    }
                }
            }
        } else {
#pragma unroll
            for (int ai = 0; ai < 2; ++ai)
#pragma unroll
                for (int m = 0; m < 4; ++m) {
                    int R, sq, t; rowinfo(slab, rsb + ai * 128 + m * 16, R, sq, t);
                    const bool smp = sq >= 16; const int b = sq & 15;
                    const size_t pos = (size_t)posbase(sq) + (smp ? PAST : 0) + t;
#pragma unroll
                    for (int bj = 0; bj < 2; ++bj) {
                        const int c = bj * 128 + wc * 32 + 8 * fq;
                        const f32x4 v0 = acc[ai][bj][m][0], v1 = acc[ai][bj][m][1];
                        if (pn < 70) {
                            GLB float* o = out + (pn == 68 ? (smp ? O_NKS : O_NKP) : (smp ? O_NVS : O_NVP)) + ((size_t)(layer * 16 + b) * (smp ? 64 : 2048) + t) * 256 + c;
                            *(f32x4*)o = v0; *(GLB f32x4*)(o + 4) = v1;
                            u32x4 w; w.x = pk_f16(v0[0], v0[1]); w.y = pk_f16(v0[2], v0[3]); w.z = pk_f16(v1[0], v1[1]); w.w = pk_f16(v1[2], v1[3]);
                            *(GLB u32x4*)((pn == 68 ? KU : VU) + pos * 256 + c) = w;
                        } else if (c < 64) {
                            GLB float* o = out + (smp ? O_NIS : O_NIP) + ((size_t)(layer * 16 + b) * (smp ? 64 : 2048) + t) * 64 + c;
                            *(f32x4*)o = v0; *(GLB f32x4*)(o + 4) = v1;
                            u32x4 w; w.x = pk_f16(v0[0], v0[1]); w.y = pk_f16(v0[2], v0[3]); w.z = pk_f16(v1[0], v1[1]); w.w = pk_f16(v1[2], v1[3]);
                            *(GLB u32x4*)(KIU + pos * 64 + c) = w;
                        } else if (c < 80) {
                            GLB float* o = WI + (size_t)R * 16 + (c - 64);
                            *(f32x4*)o = v0 * 0.03125f; *(GLB f32x4*)(o + 4) = v1 * 0.03125f;
                        } else if (c < 96) {
                            GLB float* o = BETA + (size_t)R * 16 + (c - 80);
                            f32x4 a, bb;
#pragma unroll
                            for (int j = 0; j < 4; ++j) { a[j] = sigmoidf_(v0[j]); bb[j] = sigmoidf_(v1[j]); }
                            *(f32x4*)o = a; *(GLB f32x4*)(o + 4) = bb;
                        } else if (c < 112) {
                            GLB float* o = GG + (size_t)R * 16 + (c - 96);
                            f32x4 a, bb;
#pragma unroll
                            for (int j = 0; j < 4; ++j) {
                                const int h0 = (c - 96) + j, h1 = h0 + 4;
                                const float x0 = v0[j] + dt_bias[h0], x1 = v1[j] + dt_bias[h1];
                                const float s0 = x0 > 20.f ? x0 : log1pf(__expf(x0)), s1 = x1 > 20.f ? x1 : log1pf(__expf(x1));
                                a[j] = -__expf(a_log[h0]) * s0; bb[j] = -__expf(a_log[h1]) * s1;
                            }
                            *(f32x4*)o = a; *(GLB f32x4*)(o + 4) = bb;
                        }
                    }
                }
        }
    }
};
struct EpiAB {
    static constexpr bool PERM = true;
    GLB const f16* proj; GLB f16* mg;
    DI void operator()(const f32x4 (&acc)[2][2][4][2], const pg8::Unit& u, int wr, int wc, int fr_, int fq_) const {
        int fr = fr_, fq = fq_; asm volatile("" : "+v"(fr), "+v"(fq));
        const int rsb = u.pm * 256 + wr * 64 + fr, col0 = u.pn * 256 + wc * 32 + 8 * fq;
        const int gc = (u.which ? C_GB : C_GA) + col0;
#pragma unroll
        for (int ai = 0; ai < 2; ++ai)
#pragma unroll
            for (int m = 0; m < 4; ++m) {
                const size_t rs = (size_t)(rsb + ai * 128 + m * 16);
#pragma unroll
                for (int bj = 0; bj < 2; ++bj) {
                    const h8 gt = *(GLB const h8*)(proj + rs * PS + gc + bj * 128);
                    GLB f16* mp = mg + rs * 2048 + col0 + bj * 128;
                    float r[8];
#pragma unroll
                    for (int j = 0; j < 4; ++j) { r[j] = (float)gt[j] * acc[ai][bj][m][0][j]; r[4 + j] = (float)gt[4 + j] * acc[ai][bj][m][1][j]; }
                    if (u.which) { const h8 pv = *(const h8*)mp;
#pragma unroll
                        for (int j = 0; j < 8; ++j) r[j] += (float)pv[j]; }
                    u32x4 w; w.x = pk_f16(r[0], r[1]); w.y = pk_f16(r[2], r[3]); w.z = pk_f16(r[4], r[5]); w.w = pk_f16(r[6], r[7]);
                    *(u32x4*)mp = w;
                }
            }
    }
};
struct EpiOut {
    static constexpr bool PERM = true;
    GLB const float* xp; GLB const float* xs; GLB float* out; GLB const float* ada; int layer, slab;
    DI void operator()(const f32x4 (&acc)[2][2][4][2], const pg8::Unit& u, int wr, int wc, int fr_, int fq_) const {
        int fr = fr_, fq = fq_; asm volatile("" : "+v"(fr), "+v"(fq));
        const int rsb = u.pm * 256 + wr * 64 + fr, col0 = u.pn * 256 + wc * 32 + 8 * fq;
#pragma unroll
        for (int ai = 0; ai < 2; ++ai)
#pragma unroll
            for (int m = 0; m < 4; ++m) {
                int R, sq, t; rowinfo(slab, rsb + ai * 128 + m * 16, R, sq, t);
                GLB const float* xo = layer == 0 ? (R < NTOKP ? xp + (size_t)R * D : xs + (size_t)(R - NTOKP) * D) : out + (size_t)R * D;
                GLB const float* gp = ada + (size_t)sq * 6144 + 4096;
                GLB float* yo = out + (size_t)R * D;
#pragma unroll
                for (int bj = 0; bj < 2; ++bj) {
                    const int c = col0 + bj * 128;
                    const f32x4 x0 = *(GLB const f32x4*)(xo + c), x1 = *(GLB const f32x4*)(xo + c + 4), g0 = *(GLB const f32x4*)(gp + c), g1 = *(GLB const f32x4*)(gp + c + 4);
                    *(GLB f32x4*)(yo + c) = x0 + g0 * acc[ai][bj][m][0]; *(GLB f32x4*)(yo + c + 4) = x1 + g1 * acc[ai][bj][m][1];
                }
            }
    }
};

DI void p0_prologue(const Frame F0) {
    const Frame F = F0.fresh();
    LAS float* tile = (LAS float*)F.lds;
    const int tid = F.tid;
    for (int u = F.bid; u < 2 * 12160; u += F.G) {
        const int l = u / 12160; int v = u % 12160;
        GLB const float* src; GLB f16* dst; int ldn, nb, kb; bool isin;
        if (v < 9088) { isin = true; nb = v >> 5; kb = v & 31; src = F.in(I_WIN) + (size_t)l * 2048 * IN_DIM; ldn = IN_DIM; dst = F.WIN() + (size_t)l * NP * 2048; }
        else { v -= 9088; const int mat = v >> 10, w = v & 1023; isin = false; nb = w >> 5; kb = w & 31; src = F.in(I_WBA + mat) + (size_t)l * 2048 * 2048; ldn = 2048;
               dst = (mat == 0 ? F.WA() : mat == 1 ? F.WB() : F.WO()) + (size_t)l * 2048 * 2048; }
        {
            const int nn = tid & 63, np = nb * 64 + nn; const int o = isin ? proj_src_col(np) : np;
#pragma unroll
            for (int i = 0; i < 8; ++i) { const int kk = (tid >> 6) + 8 * i; tile[kk * 65 + nn] = o >= 0 ? src[(size_t)(kb * 64 + kk) * ldn + o] : 0.f; }
        }
        __syncthreads();
        {
            const int nn = tid >> 3, kg = tid & 7; h8 hv;
#pragma unroll
            for (int j = 0; j < 8; ++j) hv[j] = (f16)tile[(kg * 8 + j) * 65 + nn];
            *(GLB h8*)(dst + (size_t)(nb * 64 + nn) * 2048 + kb * 64 + kg * 8) = hv;
        }
        __syncthreads();
    }
    for (int u = F.bid; u < 2 * 96; u += F.G) {
        const int l = u / 96, cb = u % 96, kg = tid >> 6, n = tid & 63;
        float acc[32];
#pragma unroll
        for (int s = 0; s < 32; ++s) acc[s] = 0.f;
        GLB const float* W = F.in(I_WADA) + (size_t)l * 2048 * 6144 + cb * 64 + n;
        for (int kc = 0; kc < 4; ++kc) {
            for (int i = tid; i < 32 * 512; i += NTHR) { const int s = i >> 9, k = i & 511; const float c = (s < 16 ? F.in(I_CP) + s * 2048 : F.in(I_CS) + (s - 16) * 2048)[kc * 512 + k]; tile[i] = siluf_(c); }
            __syncthreads();
            for (int kk = 0; kk < 64; ++kk) { const int k = kg * 64 + kk; const float w = W[(size_t)(kc * 512 + k) * 6144];
#pragma unroll
                for (int s = 0; s < 32; ++s) acc[s] += tile[s * 512 + k] * w; }
            __syncthreads();
        }
#pragma unroll
        for (int s = 0; s < 32; ++s) tile[(kg * 32 + s) * 64 + n] = acc[s];
        __syncthreads();
        for (int o = tid; o < 2048; o += NTHR) { const int s = o >> 6, nn = o & 63; float r = F.in(I_BADA)[l * 6144 + cb * 64 + nn];
#pragma unroll
            for (int g = 0; g < 8; ++g) r += tile[(g * 32 + s) * 64 + nn];
            F.ADA()[(size_t)(l * 32 + s) * 6144 + cb * 64 + nn] = r; }
        __syncthreads();
    }
}

DI void phase_norm(const Frame F0, int l, int slab) {
    const Frame F = F0.fresh();
    const int Ts = ts_of(slab);
    GLB const float* nw = F.in(I_NW) + l * 2048;
    for (int rs = F.bid * NWAVES + F.wave; rs < Ts; rs += F.G * NWAVES) {
        int R, sq, t; rowinfo(slab, rs, R, sq, t);
        GLB const float* x = l == 0 ? (R < NTOKP ? F.in(I_XP) + (size_t)R * D : F.in(I_XS) + (size_t)(R - NTOKP) * D) : F.out() + (size_t)R * D;
        GLB const float* ad = F.ADA() + (size_t)(l * 32 + sq) * 6144;
        f32x4 v[8]; float ss = 0.f;
#pragma unroll
        for (int i = 0; i < 8; ++i) { v[i] = *(GLB const f32x4*)(x + (i * 64 + F.lane) * 4); ss += v[i][0] * v[i][0] + v[i][1] * v[i][1] + v[i][2] * v[i][2] + v[i][3] * v[i][3]; }
        ss = wave_sum(ss, F.lane);
        const float r = rsqrtf(ss * (1.0f / 2048.0f) + EPS);
#pragma unroll
        for (int i = 0; i < 8; ++i) { const int c = (i * 64 + F.lane) * 4;
            const f32x4 w = *(GLB const f32x4*)(nw + c), sh = *(GLB const f32x4*)(ad + c), sc = *(GLB const f32x4*)(ad + 2048 + c);
            const f32x4 hv = v[i] * r * w * (sc + 1.0f) + sh;
            u32x2 p; p.x = pk_f16(hv[0], hv[1]); p.y = pk_f16(hv[2], hv[3]);
            *(GLB u32x2*)(F.H() + (size_t)rs * 2048 + c) = p; }
    }
    if (slab == 0) {
        const size_t gid = (size_t)F.bid * NTHR + F.tid, gsz = (size_t)F.G * NTHR;
        const size_t nk = (size_t)16 * PAST * 32;
        for (size_t g = gid; g < nk; g += gsz) {
            const size_t b = g / (PAST * 32), rem = g % (PAST * 32), p = rem >> 5, c8 = (rem & 31) * 8;
            const size_t so = (size_t)l * 16 * PAST * 256 + g * 8, dof = ((size_t)32768 + b * LSMP + p) * 256 + c8;
            { const f32x4 a = *(GLB const f32x4*)(F.in(I_CK) + so), bb = *(GLB const f32x4*)(F.in(I_CK) + so + 4);
              u32x4 w; w.x = pk_f16(a[0], a[1]); w.y = pk_f16(a[2], a[3]); w.z = pk_f16(bb[0], bb[1]); w.w = pk_f16(bb[2], bb[3]); *(GLB u32x4*)(F.KU() + dof) = w; }
            { const f32x4 a = *(GLB const f32x4*)(F.in(I_CV) + so), bb = *(GLB const f32x4*)(F.in(I_CV) + so + 4);
              u32x4 w; w.x = pk_f16(a[0], a[1]); w.y = pk_f16(a[2], a[3]); w.z = pk_f16(bb[0], bb[1]); w.w = pk_f16(bb[2], bb[3]); *(GLB u32x4*)(F.VU() + dof) = w; }
        }
        const size_t ni = (size_t)16 * PAST * 8;
        for (size_t g = gid; g < ni; g += gsz) {
            const size_t b = g / (PAST * 8), rem = g % (PAST * 8), p = rem >> 3, c8 = (rem & 7) * 8;
            const size_t so = (size_t)l * 16 * PAST * 64 + g * 8, dof = ((size_t)32768 + b * LSMP + p) * 64 + c8;
            const f32x4 a = *(GLB const f32x4*)(F.in(I_CIK) + so), bb = *(GLB const f32x4*)(F.in(I_CIK) + so + 4);
            u32x4 w; w.x = pk_f16(a[0], a[1]); w.y = pk_f16(a[2], a[3]); w.z = pk_f16(bb[0], bb[1]); w.w = pk_f16(bb[2], bb[3]); *(GLB u32x4*)(F.KIU() + dof) = w;
        }
    }
}

DI unsigned sortable(float f) { const unsigned u = __float_as_uint(f); return (u & 0x80000000u) ? ~u : (u | 0x80000000u); }


typedef float f32x16 __attribute__((ext_vector_type(16)));
typedef __fp16 fp16x4_t __attribute__((__vector_size__(4 * sizeof(__fp16))));
#define MFMA32(a, b, c) __builtin_amdgcn_mfma_f32_32x32x16_f16((a), (b), (c), 0, 0, 0)
#define SB() __builtin_amdgcn_sched_barrier(0)
constexpr int AT_KV = 0, AT_BUF = 34816, AT_V = 17408, AT_ROW = 272;
constexpr int AT_QI = 0, AT_QIS = 1032;
constexpr int AT_MASK = 69632, AT_BT = AT_MASK + 32 * 65 * 8, AT_WI = AT_BT + 16 * 192 * 4, AT_END = AT_WI + 32 * 16 * 4;
static_assert(AT_END <= LDS_MISC && 32 * AT_QIS * 2 <= AT_MASK, "attention LDS map");
constexpr float LOG2E = 1.4426950408889634f, SCL2 = 0.08838834764831845f * LOG2E;


constexpr int GX = 0, GX_S = 264, GTF = 33792, GPT = GTF + 17408, GTAB = GPT + 4096, GAT = GTAB + 1536, GAT_S = 68, GTM = GAT + 17408, GT_S = 72, GKB = GTM + 9216, GVB = GKB + 18432, GPRE_END = GVB + 18432;
static_assert(GPRE_END <= LDS_MISC, "gdn pre LDS map");
DI void gdn_pre_unit(const Frame& F0, int l, int slab, int c, int hd) {
    const Frame F = F0.fresh();
    const int tid = F.tid, lane = F.lane, wave = F.wave, r32 = lane & 31, h2 = lane >> 5;
    LAS unsigned char* lds = F.lds;
    LAS f16* X = (LAS f16*)(lds + GX);
    LAS float* TF = (LAS float*)(lds + GTF);
    LAS float* PT = (LAS float*)(lds + GPT);
    LAS float* TAB = (LAS float*)(lds + GTAB);
    LAS float* AT = (LAS float*)(lds + GAT);
    LAS f16* TM = (LAS f16*)(lds + GTM);
    LAS f16* KB = (LAS f16*)(lds + GKB);
    LAS f16* VB = (LAS f16*)(lds + GVB);
    const bool smp = c >= 128;
    const int sq = smp ? 16 + (c - 128) : slab * 4 + (c >> 5), n = smp ? 0 : (c & 31), b = sq & 15;
    const int rsb = smp ? 8192 + (sq - 16) * 64 : (sq - slab * 4) * 2048 + n * 64;
    const int Rb = smp ? NTOKP + (sq - 16) * 64 : sq * 2048 + n * 64;
    GLB const f16* PROJ = F.PROJ();
    GLB unsigned char* gp = F.ws() + WS_GP + (size_t)(c * 16 + hd) * GP_STRIDE;
    {
        GLB const float* wcv = F.in(I_WCONV) + (size_t)l * 4 * 6144;
        GLB const float* scv = F.in(I_SC) + (size_t)(l * 16 + b) * 3 * 6144;
        if (tid < 384) {
            const int run = tid / 48, cg = tid % 48, part = cg >> 4, c8 = (cg & 15) * 8, gch = part * 2048 + hd * 128 + c8, tok0 = run * 8;
            h8 xr[11];
#pragma unroll
            for (int r = 0; r < 11; ++r) {
                const int tt = tok0 - 3 + r;
                if (tt >= 0 || n > 0) xr[r] = *(GLB const h8*)(PROJ + (size_t)(rsb + tt) * PS + gch);
                else if (smp) { const f32x4 a = *(GLB const f32x4*)(scv + (size_t)(3 + tt) * 6144 + gch), bq = *(GLB const f32x4*)(scv + (size_t)(3 + tt) * 6144 + gch + 4);
                    h8 t; t[0] = (f16)a[0]; t[1] = (f16)a[1]; t[2] = (f16)a[2]; t[3] = (f16)a[3]; t[4] = (f16)bq[0]; t[5] = (f16)bq[1]; t[6] = (f16)bq[2]; t[7] = (f16)bq[3]; xr[r] = t; }
                else {
#pragma unroll
                    for (int j = 0; j < 8; ++j) xr[r][j] = (f16)0.f; }
            }
            float w[4][8];
#pragma unroll
            for (int tap = 0; tap < 4; ++tap) { const f32x4 w0 = *(GLB const f32x4*)(wcv + tap * 6144 + gch), w1 = *(GLB const f32x4*)(wcv + tap * 6144 + gch + 4);
#pragma unroll
                for (int j = 0; j < 4; ++j) { w[tap][j] = w0[j]; w[tap][4 + j] = w1[j]; } }
            h8 y[8];
#pragma unroll
            for (int tq = 0; tq < 8; ++tq)
#pragma unroll
                for (int j = 0; j < 8; ++j) {
                    const float acc = w[0][j] * (float)xr[tq][j] + w[1][j] * (float)xr[tq + 1][j] + w[2][j] * (float)xr[tq + 2][j] + w[3][j] * (float)xr[tq + 3][j];
                    y[tq][j] = (f16)siluf_(acc);
                }
            if (part < 2) {
#pragma unroll
                for (int tq = 0; tq < 8; ++tq) *(LAS h8*)(X + (tok0 + tq) * GX_S + cg * 8) = y[tq];
            }
            if (part >= 1) {
                LAS f16* img = part == 1 ? KB : VB;
#pragma unroll
                for (int j = 0; j < 8; ++j) { h8 t;
#pragma unroll
                    for (int tq = 0; tq < 8; ++tq) t[tq] = y[tq][j];
                    *(LAS h8*)(img + (c8 + j) * GT_S + tok0) = t; }
            }
        }
        if (wave == 7) {
            const float be = F.BETA()[(size_t)(Rb + lane) * 16 + hd];
            float gcv = F.GG()[(size_t)(Rb + lane) * 16 + hd];
#pragma unroll
            for (int o = 1; o < 64; o <<= 1) { const float tv = __builtin_bit_cast(float, __builtin_amdgcn_ds_bpermute(((lane - o) & 63) << 2, __builtin_bit_cast(int, gcv))); if (lane >= o) gcv += tv; }
            const float gl = __builtin_bit_cast(float, __builtin_amdgcn_readlane(__builtin_bit_cast(int, gcv), 63));
            TAB[128 + lane] = be; TAB[192 + lane] = gcv; TAB[256 + lane] = __expf(gcv); TAB[320 + lane] = __expf(gl - gcv);
            if (lane == 63) ((GLB float*)(F.ws() + WS_GL))[c * 16 + hd] = __expf(gl);
        }
    }
    __syncthreads();
    {
        const int tok = tid >> 3, part = tid & 7;
        float sq_ = 0.f, sk_ = 0.f;
#pragma unroll
        for (int u = 0; u < 2; ++u) { const h8 a = *(const LAS h8*)(X + tok * GX_S + part * 16 + u * 8), k = *(const LAS h8*)(X + tok * GX_S + 128 + part * 16 + u * 8);
#pragma unroll
            for (int j = 0; j < 8; ++j) { sq_ += (float)a[j] * (float)a[j]; sk_ += (float)k[j] * (float)k[j]; } }
        { sq_ += swz_xor<4>(sq_); sk_ += swz_xor<4>(sk_); sq_ += swz_xor<2>(sq_); sk_ += swz_xor<2>(sk_); sq_ += swz_xor<1>(sq_); sk_ += swz_xor<1>(sk_); }
        if (part == 0) { TAB[tok] = rsqrtf(sq_ + EPS) * 0.08838834764831845f; TAB[64 + tok] = rsqrtf(sk_ + EPS); }
    }
    __syncthreads();
    if (wave < 6) {
        const bool isqk = wave >= 3; const int ti = isqk ? wave - 3 : wave;
        const int rt = isqk ? (ti == 2 ? 1 : 0) : (wave == 2 ? 1 : 0), ct = isqk ? (ti == 0 ? 0 : 1) : (wave == 0 ? 0 : 1);
        f32x16 acc;
#pragma unroll
        for (int i = 0; i < 16; ++i) acc[i] = 0.f;
        {
            h8 fa[8], fb[8];
#pragma unroll
            for (int s = 0; s < 8; ++s) { fa[s] = *(const LAS h8*)(X + (32 * rt + r32) * GX_S + 128 + 16 * s + 8 * h2);
                fb[s] = *(const LAS h8*)(X + (32 * ct + r32) * GX_S + (isqk ? 0 : 128) + 16 * s + 8 * h2); }
            SB();
#pragma unroll
            for (int s = 0; s < 8; ++s) acc = MFMA32(fa[s], fb[s], acc);
            SB();
        }
        const int col = 32 * ct + r32;
        if (!isqk) {
            const float bk = TAB[128 + col] * TAB[64 + col], gck = TAB[192 + col];
#pragma unroll
            for (int g = 0; g < 4; ++g) { const int j0 = 32 * rt + 8 * g + 4 * h2;
                const f32x4 rk = *(const LAS f32x4*)(TAB + 64 + j0), gj = *(const LAS f32x4*)(TAB + 192 + j0);
                f32x4 v;
#pragma unroll
                for (int jj = 0; jj < 4; ++jj) v[jj] = (col > j0 + jj) ? bk * rk[jj] * acc[4 * g + jj] * __expf(fminf(gck - gj[jj], 0.f)) : 0.f;
                *(LAS f32x4*)(AT + col * GAT_S + j0) = v; }
        } else {
            const float rqi = TAB[col], gci = TAB[192 + col];
#pragma unroll
            for (int g = 0; g < 4; ++g) { const int j0 = 32 * rt + 8 * g + 4 * h2;
                const f32x4 rk = *(const LAS f32x4*)(TAB + 64 + j0), gj = *(const LAS f32x4*)(TAB + 192 + j0);
                h4 v;
#pragma unroll
                for (int jj = 0; jj < 4; ++jj) v[jj] = (f16)((col >= j0 + jj) ? rqi * rk[jj] * acc[4 * g + jj] * __expf(fminf(gci - gj[jj], 0.f)) : 0.f);
                *(GLB h4*)(gp + GP_QK + (col * 64 + j0) * 2) = v; }
        }
    } else if (wave == 6) {
#pragma unroll
        for (int u = 0; u < 4; ++u) { const int p = lane + 64 * u, i = p >> 3, j0 = 32 + (p & 7) * 4; *(GLB h4*)(gp + GP_QK + (i * 64 + j0) * 2) = (h4){(f16)0.f, (f16)0.f, (f16)0.f, (f16)0.f}; }
    }
    if (wave == 0 || wave == 2) {
        const int bs = wave == 0 ? 0 : 32;
        asm volatile("s_waitcnt lgkmcnt(0)" ::: "memory");
        {
            const int o = bs + 16 * ((lane >> 4) & 1), cc = lane & 15;
            float T[16];
#pragma unroll
            for (int i = 0; i < 16; ++i) {
                float sacc = (i == cc) ? 1.f : 0.f;
#pragma unroll
                for (int jg = 0; jg < (i + 3) / 4; ++jg) { const f32x4 a4 = *(const LAS f32x4*)(AT + (o + i) * GAT_S + o + 4 * jg);
#pragma unroll
                    for (int jj = 0; jj < 4; ++jj) if (4 * jg + jj < i) sacc -= a4[jj] * T[4 * jg + jj]; }
                T[i] = sacc;
            }
            if (lane < 32) {
#pragma unroll
                for (int i = 0; i < 16; ++i) TF[(o + i) * GAT_S + o + cc] = T[i];
            }
        }
        asm volatile("s_waitcnt lgkmcnt(0)" ::: "memory");
        {
            const int i = lane >> 2, c4 = (lane & 3) * 4;
            f32x4 p = {0.f, 0.f, 0.f, 0.f};
#pragma unroll
            for (int k = 0; k < 16; ++k) { const float a = AT[(bs + 16 + i) * GAT_S + bs + k]; const f32x4 t4 = *(const LAS f32x4*)(TF + (bs + k) * GAT_S + bs + c4); p += a * t4; }
            *(LAS f32x4*)(PT + (bs >> 5) * 256 + i * 16 + c4) = p;
            { float zz = 0.f; asm volatile("" : "+v"(zz)); *(LAS f32x4*)(TF + (bs + i) * GAT_S + bs + 16 + c4) = (f32x4){zz, zz, zz, zz}; }
            asm volatile("s_waitcnt lgkmcnt(0)" ::: "memory");
            f32x4 v = {0.f, 0.f, 0.f, 0.f};
#pragma unroll
            for (int k = 0; k < 16; ++k) { const float a = TF[(bs + 16 + i) * GAT_S + bs + 16 + k]; const f32x4 p4 = *(const LAS f32x4*)(PT + (bs >> 5) * 256 + k * 16 + c4); v -= a * p4; }
            *(LAS f32x4*)(TF + (bs + 16 + i) * GAT_S + bs + c4) = v;
        }
    } else {
        const int e = (wave == 1 ? 0 : wave - 2) * 64 + lane;
#pragma unroll 1
        for (int item = e; item < 4096; item += 384) {
            const int kind = item >> 10, rem = item & 1023;
            if (kind < 2) {
                const int d = rem >> 3, tg = rem & 7;
                LAS f16* p = (kind ? VB : KB) + d * GT_S + 8 * tg;
                const h8 xv = *(const LAS h8*)p;
                const f32x4 b0 = *(const LAS f32x4*)(TAB + 128 + 8 * tg), b1 = *(const LAS f32x4*)(TAB + 128 + 8 * tg + 4);
                f32x4 s0 = b0, s1 = b1;
                if (!kind) { s0 = s0 * *(const LAS f32x4*)(TAB + 64 + 8 * tg) * *(const LAS f32x4*)(TAB + 256 + 8 * tg); s1 = s1 * *(const LAS f32x4*)(TAB + 64 + 8 * tg + 4) * *(const LAS f32x4*)(TAB + 256 + 8 * tg + 4); }
                h8 o;
#pragma unroll
                for (int j = 0; j < 4; ++j) { o[j] = (f16)((float)xv[j] * s0[j]); o[4 + j] = (f16)((float)xv[4 + j] * s1[j]); }
                *(LAS h8*)p = o;
            } else {
                const int tok = rem >> 4, c8 = (rem & 15) * 8, which = kind - 2;
                const h8 xv = *(const LAS h8*)(X + tok * GX_S + (which ? 128 : 0) + c8);
                const float sc = which ? TAB[64 + tok] * TAB[320 + tok] : TAB[tok] * TAB[256 + tok];
                h8 o;
#pragma unroll
                for (int j = 0; j < 8; ++j) o[j] = (f16)((float)xv[j] * sc);
                *(GLB h8*)(gp + (which ? GP_KD : GP_QD) + (tok * 128 + c8) * 2) = o;
            }
        }
    }
    __syncthreads();
    {
        float p[2];
#pragma unroll
        for (int u = 0; u < 2; ++u) { const int e = tid + NTHR * u, i = e >> 5, cc = e & 31; float a = 0.f;
#pragma unroll 8
            for (int k = 0; k < 32; ++k) a += AT[(32 + i) * GAT_S + k] * TF[k * GAT_S + cc];
            p[u] = a; }
        PT[tid] = p[0]; PT[tid + NTHR] = p[1];
        __syncthreads();
#pragma unroll
        for (int u = 0; u < 2; ++u) { const int e = tid + NTHR * u, i = e >> 5, cc = e & 31; float v = 0.f;
#pragma unroll 8
            for (int k = 0; k < 32; ++k) v -= TF[(32 + i) * GAT_S + 32 + k] * PT[k * 32 + cc];
            TF[(32 + i) * GAT_S + cc] = v; }
    }
    __syncthreads();
    {
        const int i = tid >> 3, jg = tid & 7; h8 o;
#pragma unroll
        for (int jj = 0; jj < 8; ++jj) o[jj] = (i < 32 && jg >= 4) ? (f16)0.f : (f16)TF[i * GAT_S + 8 * jg + jj];
        *(LAS h8*)(TM + i * GT_S + 8 * jg) = o;
    }
    __syncthreads();
    {
        const int mt = wave & 3, nt = wave >> 2;
        f32x16 aw, au;
#pragma unroll
        for (int i = 0; i < 16; ++i) { aw[i] = 0.f; au[i] = 0.f; }
        {
            h8 tb[4], ka[4], vb[4];
#pragma unroll
            for (int s = 0; s < 4; ++s) {
                tb[s] = *(const LAS h8*)(TM + (32 * nt + r32) * GT_S + 16 * s + 8 * h2);
                ka[s] = *(const LAS h8*)(KB + (32 * mt + r32) * GT_S + 16 * s + 8 * h2);
                vb[s] = *(const LAS h8*)(VB + (32 * mt + r32) * GT_S + 16 * s + 8 * h2);
            }
            SB();
#pragma unroll
            for (int s = 0; s < 4; ++s) { aw = MFMA32(ka[s], tb[s], aw); au = MFMA32(tb[s], vb[s], au); }
            SB();
        }
#pragma unroll
        for (int g = 0; g < 4; ++g) {
            h4 w4, u4;
#pragma unroll
            for (int jj = 0; jj < 4; ++jj) { w4[jj] = (f16)aw[4 * g + jj]; u4[jj] = (f16)au[4 * g + jj]; }
            *(GLB h4*)(gp + GP_W + ((32 * nt + r32) * 128 + 32 * mt + 8 * g + 4 * h2) * 2) = w4;
            *(GLB h4*)(gp + GP_U + (((mt * 2 + nt) * 4 + g) * 64 + lane) * 8) = u4;
        }
    }
    __syncthreads();
}

constexpr int SC_W = 0, SC_QD = 17408, SC_KD = 34816, SC_QK = 52224, SC_BUF = 61440, SC_SSQ = 2 * SC_BUF, SC_END = SC_SSQ + 1024;
static_assert(SC_END <= LDS_MISC, "gdn scan LDS map");
DI void gdn_scan_unit(const Frame& F0, int l, int slab, int sq, int hd) {
    const Frame F = F0.fresh();
    const int tid = F.tid, lane = F.lane, wave = F.wave, r32 = lane & 31, h2 = lane >> 5;
    const int i16 = lane & 15, q4 = i16 >> 2, p4 = i16 & 3, blk = (lane >> 4) & 1;
    LAS unsigned char* lds = F.lds;
    LAS float* ssq = (LAS float*)(lds + SC_SSQ);
    const bool smp = sq >= 16; const int b = sq & 15, nch = smp ? 1 : 32;
    const int c0 = smp ? 128 + (sq - 16) : (sq - slab * 4) * 32;
    const int rs0 = smp ? 8192 + (sq - 16) * 64 : (sq - slab * 4) * 2048;
    GLB const unsigned char* gpb = F.ws() + WS_GP + (size_t)hd * GP_STRIDE;
    GLB const float* GLp = (GLB const float*)(F.ws() + WS_GL);
    const int w = wave;
    f32x16 S[4];
    if (wave < 4) {
        GLB const float* s0 = F.in(I_SG) + ((size_t)(l * 16 + b) * 16 + hd) * 16384;
#pragma unroll
        for (int mt = 0; mt < 4; ++mt)
#pragma unroll
            for (int i = 0; i < 16; ++i) S[mt][i] = smp ? s0[(32 * mt + (i & 3) + 8 * (i >> 2) + 4 * h2) * 128 + 32 * w + r32] : 0.f;
    }
    const int lt = tid - 256;
    h4 uf[2][4];
    if (wave < 4) { GLB const unsigned char* up = gpb + (size_t)c0 * 16 * GP_STRIDE + GP_U;
#pragma unroll
        for (int tm = 0; tm < 2; ++tm)
#pragma unroll
            for (int g = 0; g < 4; ++g) uf[tm][g] = *(GLB const h4*)(up + (((w * 2 + tm) * 4 + g) * 64 + lane) * 8); }
#define SC_LOAD(cc) do { GLB const unsigned char* src = gpb + (size_t)(cc) * 16 * GP_STRIDE; \
        _Pragma("unroll") for (int it = 0; it < 4; ++it) { const int i = lt + 256 * it, row = i >> 4, c8 = (i & 15) * 8; const int go = (row * 128 + c8) * 2; \
            t0[it] = *(GLB const u32x4*)(src + GP_W + go); t1[it] = *(GLB const u32x4*)(src + GP_QD + go); t2[it] = *(GLB const u32x4*)(src + GP_KD + go); } \
        _Pragma("unroll") for (int it = 0; it < 2; ++it) { const int i = lt + 256 * it, row = i >> 3, c8 = (i & 7) * 8; t3[it] = *(GLB const u32x4*)(src + GP_QK + (row * 64 + c8) * 2); } } while (0)
#define SC_STORE(bufi) do { LAS unsigned char* dst = lds + (bufi) * SC_BUF; \
        _Pragma("unroll") for (int it = 0; it < 4; ++it) { const int i = lt + 256 * it, row = i >> 4, c8 = (i & 15) * 8; const int lo = row * 272 + c8 * 2; \
            *(LAS u32x4*)(dst + SC_W + lo) = t0[it]; *(LAS u32x4*)(dst + SC_QD + lo) = t1[it]; *(LAS u32x4*)(dst + SC_KD + lo) = t2[it]; } \
        _Pragma("unroll") for (int it = 0; it < 2; ++it) { const int i = lt + 256 * it, row = i >> 3, c8 = (i & 7) * 8; *(LAS u32x4*)(dst + SC_QK + row * 144 + c8 * 2) = t3[it]; } } while (0)
    u32x4 t0[4], t1[4], t2[4], t3[2];
    if (wave >= 4) { SC_LOAD(c0); SC_STORE(0); }
    __syncthreads();
    const float gnw0 = 0.f; (void)gnw0;
    if (wave >= 4) {
#pragma unroll 1
        for (int n = 0; n < nch; ++n) {
            int tl_ = lane_id_fresh() + wave * 64; asm volatile("" : "+v"(tl_));
            const int lt = tl_ - 256; const bool more = (n + 1) < nch;
            if (more) SC_LOAD(c0 + n + 1);
        asm volatile("s_waitcnt lgkmcnt(0)" ::: "memory"); __builtin_amdgcn_s_barrier(); asm volatile("" ::: "memory");
            if (more) SC_STORE((n + 1) & 1);
        asm volatile("s_waitcnt lgkmcnt(0)" ::: "memory"); __builtin_amdgcn_s_barrier(); asm volatile("" ::: "memory");
        }
    } else {
#pragma unroll 1
    for (int n = 0; n < nch; ++n) {
        const int c = c0 + n;
        int tl_ = lane_id_fresh() + wave * 64; asm volatile("" : "+v"(tl_));
        const int lt = tl_ - 256, lane = tl_ & 63, r32 = lane & 31, h2 = lane >> 5, i16 = lane & 15, q4 = i16 >> 2, p4 = i16 & 3, blk = (lane >> 4) & 1;
        LAS unsigned char* bufp = lds + (n & 1) * SC_BUF;
        f32x16 oT[2];
        h8 VNp[2][2];
        const bool more = (n + 1) < nch;
        float gl = 0.f; h4 zaf[2][4];
            gl = GLp[c * 16 + hd];
            h8 Sp[4][2];
#pragma unroll
            for (int mt = 0; mt < 4; ++mt)
#pragma unroll
                for (int ks = 0; ks < 2; ++ks) { h8 t;
#pragma unroll
                    for (int jj = 0; jj < 8; ++jj) t[jj] = (f16)S[mt][8 * ks + jj];
                    Sp[mt][ks] = t; }
#pragma unroll
            for (int tm = 0; tm < 2; ++tm) {
                h8 wf[8];
#pragma unroll
                for (int kq = 0; kq < 8; ++kq) {
                    LAS unsigned char* ap = bufp + SC_W + (32 * tm + r32) * 272 + 2 * (16 * kq + 4 * h2);
                    const h4 lo = *(const LAS h4*)ap, hi = *(const LAS h4*)(ap + 16);
                    wf[kq] = __builtin_shufflevector(lo, hi, 0, 1, 2, 3, 4, 5, 6, 7);
                }
                f32x16 ws;
#pragma unroll
                for (int i = 0; i < 16; ++i) ws[i] = 0.f;
                SB();
#pragma unroll
                for (int kq = 0; kq < 8; ++kq) ws = MFMA32(wf[kq], Sp[kq >> 1][kq & 1], ws);
                SB();
#pragma unroll
                for (int g = 0; g < 4; ++g)
#pragma unroll
                    for (int jj = 0; jj < 4; ++jj) ws[4 * g + jj] = (float)uf[tm][g][jj] - ws[4 * g + jj];
#pragma unroll
                for (int ks = 0; ks < 2; ++ks) { h8 t;
#pragma unroll
                    for (int jj = 0; jj < 8; ++jj) t[jj] = (f16)ws[8 * ks + jj];
                    VNp[tm][ks] = t; }
            }
#pragma unroll
            for (int tn = 0; tn < 2; ++tn) {
                f32x16 o;
#pragma unroll
                for (int i = 0; i < 16; ++i) o[i] = 0.f;
#pragma unroll
                for (int hb = 0; hb < 2; ++hb) {
                    h8 bf[4];
#pragma unroll
                    for (int kq = 0; kq < 4; ++kq) {
                        LAS unsigned char* bp = bufp + SC_QD + (32 * tn + r32) * 272 + 2 * (16 * (4 * hb + kq) + 4 * h2);
                        const h4 lo = *(const LAS h4*)bp, hi = *(const LAS h4*)(bp + 16);
                        bf[kq] = __builtin_shufflevector(lo, hi, 0, 1, 2, 3, 4, 5, 6, 7);
                    }
                    SB();
#pragma unroll
                    for (int kq = 0; kq < 4; ++kq) o = MFMA32(Sp[(4 * hb + kq) >> 1][kq & 1], bf[kq], o);
                    SB();
                }
                {
                    h8 bf[4];
#pragma unroll
                    for (int kq = 0; kq < 4; ++kq) {
                        LAS unsigned char* bp = bufp + SC_QK + (32 * tn + r32) * 144 + 2 * (16 * kq + 4 * h2);
                        const h4 lo = *(const LAS h4*)bp, hi = *(const LAS h4*)(bp + 16);
                        bf[kq] = __builtin_shufflevector(lo, hi, 0, 1, 2, 3, 4, 5, 6, 7);
                    }
                    SB();
#pragma unroll
                    for (int kq = 0; kq < 4; ++kq) o = MFMA32(VNp[kq >> 1][kq & 1], bf[kq], o);
                    SB();
                }
                oT[tn] = o;
                float sacc = 0.f;
#pragma unroll
                for (int i = 0; i < 16; ++i) sacc += o[i] * o[i];
                sacc += shx32(sacc, lane);
                if (h2 == 0) ssq[w * 64 + 32 * tn + r32] = sacc;
            }
            if (n + 1 < nch) {
                GLB const unsigned char* up = gpb + (size_t)(c + 1) * 16 * GP_STRIDE + GP_U;
#pragma unroll
                for (int tm = 0; tm < 2; ++tm)
#pragma unroll
                    for (int g = 0; g < 4; ++g) uf[tm][g] = *(GLB const h4*)(up + (((w * 2 + tm) * 4 + g) * 64 + lane) * 8);
            }
            {
                GLB const f16* PROJ = F.PROJ();
#pragma unroll
                for (int tn = 0; tn < 2; ++tn)
#pragma unroll
                    for (int g = 0; g < 4; ++g) zaf[tn][g] = *(GLB const h4*)(PROJ + (size_t)(rs0 + 64 * n + 32 * tn + r32) * PS + C_ZA + hd * 128 + 32 * w + 8 * g + 4 * h2);
            }
        asm volatile("s_waitcnt lgkmcnt(0)" ::: "memory"); __builtin_amdgcn_s_barrier(); asm volatile("" ::: "memory");
        {
            GLB const float* gnw = F.in(I_GNW) + l * 128;
#pragma unroll
            for (int tn = 0; tn < 2; ++tn) {
                const int tok = 32 * tn + r32;
                const float tot = ssq[tok] + ssq[64 + tok] + ssq[128 + tok] + ssq[192 + tok];
                const float rstd = rsqrtf(tot * (1.0f / 128.0f) + EPS);
                const size_t rs = (size_t)(rs0 + 64 * n + tok);
#pragma unroll
                for (int g = 0; g < 4; ++g) {
                    const int dv0 = 32 * w + 8 * g + 4 * h2;
                    const f32x4 gw = *(GLB const f32x4*)(gnw + dv0);
                    const h4 za = zaf[tn][g];
                    h4 ov;
#pragma unroll
                    for (int jj = 0; jj < 4; ++jj) ov[jj] = (f16)(oT[tn][4 * g + jj] * rstd * gw[jj] * (float)za[jj]);
                    *(GLB h4*)(F.OA() + rs * 2048 + hd * 128 + dv0) = ov;
                }
            }
#pragma unroll
            for (int mp = 0; mp < 2; ++mp) {
                h8 kf[2][4];
#pragma unroll
                for (int ml = 0; ml < 2; ++ml)
#pragma unroll
                    for (int kq = 0; kq < 4; ++kq) {
                        LAS unsigned char* ap = bufp + SC_KD + (16 * kq + 4 * h2 + q4) * 272 + 64 * (2 * mp + ml) + 8 * (4 * blk + p4);
                        const fp16x4_t lo = __builtin_amdgcn_ds_read_tr16_b64_v4f16((LAS fp16x4_t*)ap);
                        const fp16x4_t hi = __builtin_amdgcn_ds_read_tr16_b64_v4f16((LAS fp16x4_t*)(ap + 8 * 272));
                        kf[ml][kq] = __builtin_shufflevector(__builtin_bit_cast(h4, lo), __builtin_bit_cast(h4, hi), 0, 1, 2, 3, 4, 5, 6, 7);
                    }
#pragma unroll
                for (int i = 0; i < 16; ++i) { S[2 * mp][i] *= gl; S[2 * mp + 1][i] *= gl; }
                SB();
#pragma unroll
                for (int kq = 0; kq < 4; ++kq) { S[2 * mp] = MFMA32(kf[0][kq], VNp[kq >> 1][kq & 1], S[2 * mp]); S[2 * mp + 1] = MFMA32(kf[1][kq], VNp[kq >> 1][kq & 1], S[2 * mp + 1]); }
                SB();
            }
        }
        asm volatile("s_waitcnt lgkmcnt(0)" ::: "memory"); __builtin_amdgcn_s_barrier(); asm volatile("" ::: "memory");
    }
    }
#undef SC_LOAD
#undef SC_STORE
    if (wave < 4) {
        GLB float* so = F.out() + (smp ? O_NGS : O_NGP) + ((size_t)(l * 16 + b) * 16 + hd) * 16384;
#pragma unroll
        for (int mt = 0; mt < 4; ++mt)
#pragma unroll
            for (int i = 0; i < 16; ++i) so[(32 * mt + (i & 3) + 8 * (i >> 2) + 4 * h2) * 128 + 32 * w + r32] = S[mt][i];
    }
    __syncthreads();
}

template <int NKMAX>
DI void select_rows(GLB const float* scr, LAS unsigned long long* mask, int wave, int lane, int nk, int nvis) {
#pragma unroll 1
    for (int r = 0; r < 4; ++r) {
        const int q = wave * 4 + r;
        unsigned u[NKMAX];
#pragma unroll
        for (int k = 0; k < NKMAX; ++k) u[k] = (k < nk) ? sortable(scr[(size_t)q * LDR + 64 * k + lane]) : 0u;
        unsigned thr = 0u;
        if (nvis > 256) {
#pragma unroll 1
            for (int bit = 31; bit >= 0; --bit) {
                const unsigned cand = thr | (1u << bit);
                int c = 0;
#pragma unroll
                for (int k = 0; k < NKMAX; ++k) c += (int)__popcll(__ballot(u[k] >= cand));
                if (c >= 256) thr = cand;
            }
        }
#pragma unroll
        for (int k = 0; k < NKMAX; ++k) { const unsigned long long bal = __ballot(u[k] >= thr); if (k < nk && lane == 0) mask[q * 65 + k] = bal; }
    }
}

DI void attn_step3(const Frame& F, LAS unsigned char* lds, LAS unsigned long long* mask, LAS float* bt, GLB const f16* PROJ, int rs0, int qpos0, int nk, int pb);
DI void attn_unit(const Frame& F0, int l, int slab, int rs0) {
    const Frame F = F0.fresh();
    const int tid = F.tid, lane = F.lane, wave = F.wave, r32 = lane & 31, h2 = lane >> 5;
    LAS unsigned char* lds = F.lds;
    LAS unsigned long long* mask = (LAS unsigned long long*)(lds + AT_MASK);
    LAS float* bt = (LAS float*)(lds + AT_BT);
    LAS float* wil = (LAS float*)(lds + AT_WI);
    int R0, sq, t0; rowinfo(slab, rs0, R0, sq, t0);
    const bool smp = sq >= 16;
    const int qpos0 = (smp ? PAST : 0) + t0, nvis = 64 * (qpos0 / 64 + 1), nk = nvis >> 6, pb = posbase(sq);
    GLB float* scr = (GLB float*)(F.ws() + WS_SCR) + (size_t)F.bid * 32 * LDR;
    GLB const f16* PROJ = F.PROJ();
#pragma unroll
    for (int it = 0; it < 8; ++it) { const int i = tid + NTHR * it, row = i >> 7, c8 = (i & 127) * 8;
        *(LAS h8*)(lds + AT_QI + (row * AT_QIS + c8) * 2) = *(GLB const h8*)(PROJ + (size_t)(rs0 + row) * PS + C_QI + c8); }
    { GLB const float* rb = F.in(I_RELB);
      for (int i = tid; i < 16 * 192; i += NTHR) { const int h = i / 192, rel = (i % 192) - 128; bt[i] = rb[rel_bucket(rel) * 16 + h] * LOG2E; } }
    wil[tid] = F.WI()[(size_t)(R0 + (tid >> 4)) * 16 + (tid & 15)];
    __syncthreads();
    {
    {
        GLB const f16* KI = F.KIU();
#pragma unroll 1
        for (int pp = wave; pp < ((PROBE_REP & 512) ? 2 * nk : nk); pp += 8) { const int p = pp >= nk ? pp - nk : pp;
            h8 a[2][4];
#pragma unroll
            for (int tl = 0; tl < 2; ++tl)
#pragma unroll
                for (int s = 0; s < 4; ++s) a[tl][s] = *(GLB const h8*)(KI + (size_t)(pb + 64 * p + 32 * tl + r32) * 64 + 16 * s + 8 * h2);
            f32x16 sc0, sc1;
#pragma unroll
            for (int i = 0; i < 16; ++i) { sc0[i] = 0.f; sc1[i] = 0.f; }
#pragma unroll 2
            for (int h = 0; h < 16; ++h) {
                h8 b[4];
#pragma unroll
                for (int s = 0; s < 4; ++s) b[s] = *(const LAS h8*)(lds + AT_QI + (r32 * AT_QIS + h * 64 + 16 * s + 8 * h2) * 2);
                f32x16 c0, c1;
#pragma unroll
                for (int i = 0; i < 16; ++i) { c0[i] = 0.f; c1[i] = 0.f; }
#pragma unroll
                for (int s = 0; s < 4; ++s) { c0 = MFMA32(a[0][s], b[s], c0); c1 = MFMA32(a[1][s], b[s], c1); }
                const float w = wil[r32 * 16 + h];
#pragma unroll
                for (int i = 0; i < 16; ++i) { sc0[i] += w * fmaxf(c0[i], 0.f); sc1[i] += w * fmaxf(c1[i], 0.f); }
            }
            GLB float* o = scr + (size_t)r32 * LDR + 64 * p + 4 * h2;
#pragma unroll
            for (int g = 0; g < 4; ++g) { *(GLB f32x4*)(o + 8 * g) = (f32x4){sc0[4 * g], sc0[4 * g + 1], sc0[4 * g + 2], sc0[4 * g + 3]};
                                          *(GLB f32x4*)(o + 32 + 8 * g) = (f32x4){sc1[4 * g], sc1[4 * g + 1], sc1[4 * g + 2], sc1[4 * g + 3]}; }
        }
    }
    asm volatile("s_waitcnt vmcnt(0)" ::: "memory");
    __syncthreads();
    __builtin_amdgcn_fence(__ATOMIC_ACQUIRE, "agent");
    { int lane2 = lane; asm volatile("" : "+v"(lane2));
      if (smp) select_rows<65>(scr, mask, wave, lane2, nk, nvis); else select_rows<32>(scr, mask, wave, lane2, nk, nvis); }
    __syncthreads();
    }
    attn_step3(F, lds, mask, bt, PROJ, rs0, qpos0, nk, pb);
    if (PROBE_REP & 128) attn_step3(F, lds, mask, bt, PROJ, rs0, qpos0, nk, pb);
}
DI void attn_step3(const Frame& F, LAS unsigned char* lds, LAS unsigned long long* mask, LAS float* bt, GLB const f16* PROJ, int rs0, int qpos0, int nk, int pb) {
    int tid = lane_id_fresh() + F.wave * 64; asm volatile("" : "+v"(tid));
    const int lane = tid & 63, wave = F.wave, r32 = lane & 31, h2 = lane >> 5;
    GLB const f16* KU = F.KU(); GLB const f16* VU = F.VU();
    const int i16 = lane & 15, q4 = i16 >> 2, p4 = i16 & 3, blk = (lane >> 4) & 1;
#pragma unroll 1
    for (int n = 0; n < 2; ++n) {
        const int hq = 8 * n + wave;
        h8 qf[8];
#pragma unroll
        for (int s = 0; s < 8; ++s) qf[s] = *(GLB const h8*)(PROJ + (size_t)(rs0 + r32) * PS + C_QB + hq * 128 + 16 * s + 8 * h2);
        const float b15 = bt[hq * 192];
        f32x16 O[4];
#pragma unroll
        for (int mt = 0; mt < 4; ++mt)
#pragma unroll
            for (int i = 0; i < 16; ++i) O[mt][i] = 0.f;
        float m = -1e30f, lsum = 0.f;
        u32x4 kreg[2], vreg[2];
        const int srow = tid >> 4, sc8 = (tid & 15) * 8;
#define AT_LOAD(j) do { _Pragma("unroll") for (int it = 0; it < 2; ++it) { const size_t go = (size_t)(pb + 64 * (j) + srow + 32 * it) * 256 + n * 128 + sc8; \
            kreg[it] = *(GLB const u32x4*)(KU + go); vreg[it] = *(GLB const u32x4*)(VU + go); } } while (0)
#define AT_STORE(b) do { _Pragma("unroll") for (int it = 0; it < 2; ++it) { const int lo = AT_KV + (b) * AT_BUF + (srow + 32 * it) * AT_ROW + sc8 * 2; \
            *(LAS u32x4*)(lds + lo) = kreg[it]; *(LAS u32x4*)(lds + lo + AT_V) = vreg[it]; } } while (0)
        const bool grpB = wave >= 4;
        AT_LOAD(0); AT_STORE(0);
        if (grpB && nk > 1) AT_LOAD(1);
            asm volatile("s_waitcnt lgkmcnt(0)" ::: "memory"); __builtin_amdgcn_s_barrier(); asm volatile("" ::: "memory");
        if (grpB) {
            asm volatile("s_waitcnt lgkmcnt(0)" ::: "memory"); __builtin_amdgcn_s_barrier(); asm volatile("" ::: "memory");
        }
#pragma unroll 1
        for (int j = 0; j < nk; ++j) {
            const bool more = (j + 1) < nk;
            if (!grpB && more) AT_LOAD(j + 1);
            LAS unsigned char* kb = lds + AT_KV + (j & 1) * AT_BUF;
            LAS unsigned char* vb = kb + AT_V;
            f32x16 st[2];
#pragma unroll
            for (int sub = 0; sub < 2; ++sub) {
                h8 ka[8];
#pragma unroll
                for (int s = 0; s < 8; ++s) ka[s] = *(const LAS h8*)(kb + (32 * sub + r32) * AT_ROW + 32 * s + 16 * h2);
                f32x16 c0;
#pragma unroll
                for (int i = 0; i < 16; ++i) c0[i] = 0.f;
                SB();
#pragma unroll
                for (int s = 0; s < 8; ++s) c0 = MFMA32(ka[s], qf[s], c0);
                SB();
                st[sub] = c0;
            }
            const bool far = (64 * j + 63 - qpos0) <= -128;
            float mx = -1e30f;
            if (far) {
#pragma unroll
                for (int sub = 0; sub < 2; ++sub)
#pragma unroll
                    for (int i = 0; i < 16; ++i) { st[sub][i] = st[sub][i] * SCL2 + b15; mx = fmaxf(mx, st[sub][i]); }
            } else {
                const int relb = 64 * j + 4 * h2 - (qpos0 + r32) + 128;
#pragma unroll
                for (int sub = 0; sub < 2; ++sub)
#pragma unroll
                    for (int i = 0; i < 16; ++i) { int ri = relb + 32 * sub + (i & 3) + 8 * (i >> 2); ri = ri < 0 ? 0 : ri;
                        st[sub][i] = st[sub][i] * SCL2 + bt[hq * 192 + ri]; mx = fmaxf(mx, st[sub][i]); }
            }
            mx = fmaxf(mx, shx32(mx, lane));
            const float mnew = fmaxf(m, mx), alpha = __builtin_amdgcn_exp2f(m - mnew);
            m = mnew;
            lsum *= alpha;
            if (__any(alpha != 1.0f)) {
#pragma unroll
                for (int mt = 0; mt < 4; ++mt)
#pragma unroll
                    for (int i = 0; i < 16; ++i) O[mt][i] *= alpha;
            }
            if (grpB && more) AT_STORE((j + 1) & 1);
            asm volatile("s_waitcnt lgkmcnt(0)" ::: "memory"); __builtin_amdgcn_s_barrier(); asm volatile("" ::: "memory");
            if (grpB && (j + 2) < nk) AT_LOAD(j + 2);
            const unsigned long long mw = mask[r32 * 65 + j];
            float ps = 0.f;
            h8 pf[2][2];
#pragma unroll
            for (int sub = 0; sub < 2; ++sub) {
                const unsigned wsh = ((unsigned)(mw >> (32 * sub))) >> (4 * h2);
#pragma unroll
                for (int i = 0; i < 16; ++i) { const float e = __builtin_amdgcn_exp2f(st[sub][i] - mnew);
                    const float pv = (wsh & (1u << ((i & 3) + 8 * (i >> 2)))) ? e : 0.f; st[sub][i] = pv; ps += pv; }
#pragma unroll
                for (int ks = 0; ks < 2; ++ks) { h8 t;
#pragma unroll
                    for (int jj = 0; jj < 8; ++jj) t[jj] = (f16)st[sub][8 * ks + jj];
                    pf[sub][ks] = t; }
            }
            lsum += ps;
#pragma unroll
            for (int mp = 0; mp < 2; ++mp) {
                h8 va[2][4];
#pragma unroll
                for (int ml = 0; ml < 2; ++ml)
#pragma unroll
                    for (int sub = 0; sub < 2; ++sub)
#pragma unroll
                        for (int ks = 0; ks < 2; ++ks) {
                            LAS unsigned char* ap = vb + (32 * sub + 16 * ks + 4 * h2 + q4) * AT_ROW + 64 * (2 * mp + ml) + 8 * (4 * blk + p4);
                            const fp16x4_t lo = __builtin_amdgcn_ds_read_tr16_b64_v4f16((LAS fp16x4_t*)ap);
                            const fp16x4_t hi = __builtin_amdgcn_ds_read_tr16_b64_v4f16((LAS fp16x4_t*)(ap + 8 * AT_ROW));
                            va[ml][sub * 2 + ks] = __builtin_shufflevector(__builtin_bit_cast(h4, lo), __builtin_bit_cast(h4, hi), 0, 1, 2, 3, 4, 5, 6, 7);
                        }
                SB();
#pragma unroll
                for (int kk = 0; kk < 4; ++kk) { O[2 * mp] = MFMA32(va[0][kk], pf[kk >> 1][kk & 1], O[2 * mp]); O[2 * mp + 1] = MFMA32(va[1][kk], pf[kk >> 1][kk & 1], O[2 * mp + 1]); }
                SB();
            }
            if (!grpB && more) AT_STORE((j + 1) & 1);
            asm volatile("s_waitcnt lgkmcnt(0)" ::: "memory"); __builtin_amdgcn_s_barrier(); asm volatile("" ::: "memory");
        }
        if (!grpB) {
            asm volatile("s_waitcnt lgkmcnt(0)" ::: "memory"); __builtin_amdgcn_s_barrier(); asm volatile("" ::: "memory");
        }
#undef AT_LOAD
#undef AT_STORE
        const float ltot = lsum + shx32(lsum, lane), inv = 1.0f / ltot;
        const size_t orow = (size_t)(rs0 + r32);
#pragma unroll
        for (int mt = 0; mt < 4; ++mt)
#pragma unroll
            for (int g = 0; g < 4; ++g) {
                const int d = hq * 128 + 32 * mt + 8 * g + 4 * h2;
                const h4 zb = *(GLB const h4*)(PROJ + orow * PS + C_ZB + d);
                h4 ov;
#pragma unroll
                for (int jj = 0; jj < 4; ++jj) ov[jj] = (f16)(O[mt][4 * g + jj] * inv * (float)zb[jj]);
                *(GLB h4*)(F.OB() + orow * 2048 + d) = ov;
            }
    }
    __syncthreads();
}

DI void phase_mix(const Frame F0, int l, int slab, int rep = 0) {
    const Frame F = F0.fresh();
    LAS int* ubox = (LAS int*)(F.lds + LDS_MISC + 64);
    const int xcc = (int)(xb_xcc_id() & 7u);
    const int nsc = 8 + (slab == 0 ? 32 : 0), nsb = slab == 0 ? 4 : 0, total = nsc + nsb + 32;
#pragma unroll 1
    for (int qq = 0; qq < 8; ++qq) {
        const int q = (xcc + qq) & 7;
        unsigned* ctr = F.ctl() + CW_Q + ((rep * 8 + l * NSLAB + slab) * 8 + q) * 64;
        for (;;) {
            if (F.tid == 0) ubox[0] = (int)__hip_atomic_fetch_add(ctr, 1u, __ATOMIC_RELAXED, __HIP_MEMORY_SCOPE_AGENT);
            __syncthreads();
            const int u = ubox[0];
            __syncthreads();
            if (u >= total) break;
            if (u < 8) { const int cu = u * 8 + q; gdn_scan_unit(F, l, slab, slab * 4 + (cu >> 4), cu & 15);
                if (PROBE_REP & 256) gdn_scan_unit(F, l, slab, slab * 4 + (cu >> 4), cu & 15); }
            else if (u < nsc) { const int v = (u - 8) * 8 + q; gdn_scan_unit(F, l, slab, 16 + (v >> 4), v & 15); }
            else if (u < nsc + nsb) attn_unit(F, l, slab, 8192 + 32 * ((u - nsc) * 8 + q));
            else { const int k = u - nsc - nsb; attn_unit(F, l, slab, (q & 3) * 2048 + (63 - (2 * k + (q >> 2))) * 32); }
        }
    }
}
DI void phase_pre(const Frame F0, int l, int slab) {
    const int nc = slab == 0 ? 144 : 128;
    for (int u = F0.bid; u < nc * 16; u += F0.G) gdn_pre_unit(F0, l, slab, u >> 4, u & 15);
}
DI void phase_final(const Frame F0) {
    const Frame F = F0.fresh();
    GLB const float* nw = F.in(I_FNW);
    for (int R = F.bid * NWAVES + F.wave; R < NTOK; R += F.G * NWAVES) {
        GLB float* x = F.out() + (size_t)R * D;
        f32x4 v[8]; float ss = 0.f;
#pragma unroll
        for (int i = 0; i < 8; ++i) { v[i] = *(GLB const f32x4*)(x + (i * 64 + F.lane) * 4); ss += v[i][0] * v[i][0] + v[i][1] * v[i][1] + v[i][2] * v[i][2] + v[i][3] * v[i][3]; }
        ss = wave_sum(ss, F.lane);
        const float r = rsqrtf(ss * (1.0f / 2048.0f) + EPS);
#pragma unroll
        for (int i = 0; i < 8; ++i) { const int c = (i * 64 + F.lane) * 4; *(GLB f32x4*)(x + c) = v[i] * r * *(GLB const f32x4*)(nw + c); }
    }
}

DI void phase_inproj(const Frame F, int l, int s) {
    const int Ts = ts_of(s);
    pg8::Gemm g{F.H(), F.WIN() + (size_t)l * NP * 2048, F.H(), F.WIN() + (size_t)l * NP * 2048, Ts, NP, 2048};
    pg8::StaticOrder S; S.init(Ts, NP, F.G, F.bid);
    EpiProj E{F.PROJ(), F.out(), F.KU(), F.VU(), F.KIU(), F.WI(), F.BETA(), F.GG(), F.in(I_ALOG) + l * 16, F.in(I_DTB) + l * 16, l, s};
    pg8::gemm_phase<EpiProj, pg8::StaticOrder>(F.lds, g, S, E, F.wave);
}
DI void phase_ab(const Frame F, int l, int s) {
    const int Ts = ts_of(s);
    pg8::Gemm g{F.OA(), F.WA() + (size_t)l * 2048 * 2048, F.OB(), F.WB() + (size_t)l * 2048 * 2048, Ts, 2048, 2048};
    pg8::DualOrder S; S.init(Ts, 2048, F.G, F.bid);
    EpiAB E{F.PROJ(), F.H()};
    pg8::gemm_phase<EpiAB, pg8::DualOrder>(F.lds, g, S, E, F.wave);
}
DI void phase_outp(const Frame F, int l, int s) {
    const int Ts = ts_of(s);
    pg8::Gemm g{F.H(), F.WO() + (size_t)l * 2048 * 2048, F.H(), F.WO() + (size_t)l * 2048 * 2048, Ts, 2048, 2048};
    pg8::StaticOrder S; S.init(Ts, 2048, F.G, F.bid);
    EpiOut E{F.in(I_XP), F.in(I_XS), F.out(), F.ADA() + (size_t)l * 32 * 6144, l, s};
    pg8::gemm_phase<EpiOut, pg8::StaticOrder>(F.lds, g, S, E, F.wave);
}
constexpr int NPH = 6;
constexpr int N_PHASES = 1 + 2 * NSLAB * NPH + 1;
__global__ void __launch_bounds__(NTHR, 2) fwd_kernel(Args args) {
    extern __shared__ __attribute__((aligned(16))) unsigned char lds[];
    Frame F;
    F.lds = (LAS unsigned char*)lds;
    F.tid = threadIdx.x; F.lane = F.tid & 63; F.wave = __builtin_amdgcn_readfirstlane(F.tid >> 6); F.G = gridDim.x; F.bid = blockIdx.x;
    if (F.tid < 22) *(LAS unsigned long long*)(F.lds + LDS_TAB + 8 * F.tid) = (unsigned long long)args.in[F.tid];
    if (F.tid == 22) *(LAS unsigned long long*)(F.lds + LDS_TAB + 8 * 22) = (unsigned long long)args.out;
    if (F.tid == 23) *(LAS unsigned long long*)(F.lds + LDS_TAB + 8 * 23) = (unsigned long long)args.ws;
    volatile LAS unsigned* MISC = (volatile LAS unsigned*)(F.lds + LDS_MISC);
    if (F.tid < 64) MISC[F.tid] = 0u;
    __syncthreads();
    const int lo = args.ph_lo, hi = args.ph_hi;
    const bool multi = (hi - lo) > 1;
    if (multi) (void)xcd_barrier_post(F.ctl() + CW_BAR, MISC);
#define IN(k) (lo <= (k) && (k) < hi)
#define GBAR() do { XcdBarrier bar_; bar_.bar = F.ctl() + CW_BAR; bar_.x = xb_xcc_id(); bar_.st = MISC; xcd_barrier(bar_, (int)(lane_id_fresh() == 0 && F.wave == 0)); } while (0)
#define SEAM(k) do { if (IN(k) && IN((k) + 1)) { XcdBarrier bar_; bar_.bar = F.ctl() + CW_BAR; bar_.x = xb_xcc_id(); bar_.st = MISC; xcd_barrier(bar_, (int)(lane_id_fresh() == 0 && F.wave == 0)); } } while (0)
    if (IN(0)) { p0_prologue(F); if (PROBE_REP & 64) { GBAR(); p0_prologue(F); } }
    SEAM(0);
    for (int l = 0; l < 2; ++l)
        for (int s = 0; s < NSLAB; ++s) {
            const int pb = 1 + (l * NSLAB + s) * NPH;
            if (IN(pb)) { phase_norm(F, l, s); if (PROBE_REP & 1) { GBAR(); phase_norm(F, l, s); } }
            SEAM(pb);
            if (IN(pb + 1)) { phase_inproj(F, l, s); if (PROBE_REP & 2) { GBAR(); phase_inproj(F, l, s); } }
            SEAM(pb + 1);
            if (IN(pb + 2)) { phase_pre(F, l, s); if (PROBE_REP & 4) { GBAR(); phase_pre(F, l, s); } }
            SEAM(pb + 2);
            if (IN(pb + 3)) { phase_mix(F, l, s); if (PROBE_REP & 8) { GBAR(); phase_mix(F, l, s, 1); } }
            SEAM(pb + 3);
            if (IN(pb + 4)) { phase_ab(F, l, s); if (PROBE_REP & 16) { GBAR(); phase_ab(F, l, s); } }
            SEAM(pb + 4);
            if (IN(pb + 5)) { phase_outp(F, l, s); if (PROBE_REP & 32) { GBAR(); phase_outp(F, l, s); } }
            SEAM(pb + 5);
        }
    if (IN(N_PHASES - 1)) phase_final(F);
#undef IN
#undef SEAM
}

extern "C" void kernel_launch(void* const* d_in, const int* in_sizes, int n_in, void* d_out, int out_size, void* d_ws, size_t ws_size, hipStream_t stream) {
    static int grid = 0;
    if (grid == 0) {
        if (n_in != 22 || (size_t)out_size != O_END || ws_size < WS_END) { fprintf(stderr, "kernel_launch: unexpected shapes (n_in %d out %d ws %zu, need %zu)\n", n_in, out_size, ws_size, (size_t)WS_END); grid = -1; return; }
        int dev = 0, cus = 0, per_cu = 0;
        if (hipGetDevice(&dev) != hipSuccess || hipDeviceGetAttribute(&cus, hipDeviceAttributeMultiprocessorCount, dev) != hipSuccess) { grid = -1; return; }
        if (hipFuncSetAttribute((const void*)fwd_kernel, hipFuncAttributeMaxDynamicSharedMemorySize, LDS_BYTES) != hipSuccess) { fprintf(stderr, "kernel_launch: hipFuncSetAttribute failed\n"); grid = -1; return; }
        if (hipOccupancyMaxActiveBlocksPerMultiprocessor(&per_cu, (const void*)fwd_kernel, NTHR, LDS_BYTES) != hipSuccess || per_cu < 1) { fprintf(stderr, "kernel_launch: occupancy query says %d\n", per_cu); }
        (void)hipGetLastError();
        grid = cus;
    }
    if (grid < 0) return;
    (void)hipMemsetAsync((char*)d_ws + WS_CTL, 0, CTL_BYTES, stream);
    Args a{};
    for (int i = 0; i < 22; ++i) a.in[i] = (const float*)d_in[i];
    a.out = (float*)d_out; a.ws = (unsigned char*)d_ws;
#if MK_ONE_LAUNCH
    a.ph_lo = 0; a.ph_hi = N_PHASES;
    hipLaunchKernelGGL(fwd_kernel, dim3(grid), dim3(NTHR), LDS_BYTES, stream, a);
#else
    for (int p = 0; p < N_PHASES; ++p) { a.ph_lo = p; a.ph_hi = p + 1; hipLaunchKernelGGL(fwd_kernel, dim3(grid), dim3(NTHR), LDS_BYTES, stream, a); }
#endif
}
```

```cpp
#include <hip/hip_runtime.h>
#include <cstdio>
#include <cstdint>

#ifndef PROBE_REP
#define PROBE_REP 0
#endif
#ifndef MK_ONE_LAUNCH
#define MK_ONE_LAUNCH 1
#endif

#define LAS __attribute__((address_space(3)))
#define GLB __attribute__((address_space(1)))
typedef _Float16 f16;
typedef _Float16 h8 __attribute__((ext_vector_type(8)));
typedef _Float16 h4 __attribute__((ext_vector_type(4)));
typedef _Float16 h2 __attribute__((ext_vector_type(2)));
typedef float f32x4 __attribute__((ext_vector_type(4)));
typedef float f32x2 __attribute__((ext_vector_type(2)));
typedef unsigned u32x4 __attribute__((ext_vector_type(4)));
typedef unsigned u32x2 __attribute__((ext_vector_type(2)));
#define DI __device__ __forceinline__

constexpr int D = 2048, NTOKP = 32768, NTOKS = 1024, NTOK = NTOKP + NTOKS;
constexpr int IN_DIM = 18032, NP = 18176, PS = 17408;
constexpr int LSMP = 4160, PAST = 4096;
constexpr int NSLAB = 4, NWAVES = 8, NTHR = 512;
constexpr int C_QKV = 0, C_ZA = 6144, C_QB = 8192, C_ZB = 10240, C_QI = 12288, C_GA = 13312, C_GB = 15360;
constexpr float EPS = 1e-6f;
constexpr int NPOS = 16 * 2048 + 16 * LSMP;

constexpr size_t O_YP = 0, O_YS = O_YP + (size_t)NTOKP * D, O_NKP = O_YS + (size_t)NTOKS * D, O_NVP = O_NKP + (size_t)2 * 16 * 2048 * 256,
    O_NIP = O_NVP + (size_t)2 * 16 * 2048 * 256, O_NGP = O_NIP + (size_t)2 * 16 * 2048 * 64, O_NCP = O_NGP + (size_t)2 * 16 * 16 * 16384,
    O_NKS = O_NCP + (size_t)2 * 16 * 3 * 6144, O_NVS = O_NKS + (size_t)2 * 16 * 64 * 256, O_NIS = O_NVS + (size_t)2 * 16 * 64 * 256,
    O_NGS = O_NIS + (size_t)2 * 16 * 64 * 64, O_NCS = O_NGS + (size_t)2 * 16 * 16 * 16384, O_END = O_NCS + (size_t)2 * 16 * 3 * 6144;
static_assert(O_END == 126091264ull, "output size");

constexpr size_t al256(size_t x) { return (x + 255) & ~(size_t)255; }
constexpr size_t WS_CTL = 0, CTL_BYTES = 1u << 20;
constexpr size_t WS_ADA = WS_CTL + CTL_BYTES;
constexpr size_t WS_WIN = al256(WS_ADA + (size_t)2 * 32 * 6144 * 4);
constexpr size_t WS_WA = al256(WS_WIN + (size_t)2 * NP * 2048 * 2);
constexpr size_t WS_WB = al256(WS_WA + (size_t)2 * 2048 * 2048 * 2);
constexpr size_t WS_WO = al256(WS_WB + (size_t)2 * 2048 * 2048 * 2);
constexpr size_t WS_H = al256(WS_WO + (size_t)2 * 2048 * 2048 * 2);
constexpr size_t WS_PROJ = al256(WS_H + (size_t)9216 * 2048 * 2);
constexpr size_t WS_OA = al256(WS_PROJ + (size_t)9216 * PS * 2);
constexpr size_t WS_OB = al256(WS_OA + (size_t)9216 * 2048 * 2);
constexpr size_t WS_KU = al256(WS_OB + (size_t)9216 * 2048 * 2);
constexpr size_t WS_VU = al256(WS_KU + (size_t)NPOS * 256 * 2);
constexpr size_t WS_KIU = al256(WS_VU + (size_t)NPOS * 256 * 2);
constexpr size_t WS_WI = al256(WS_KIU + (size_t)NPOS * 64 * 2);
constexpr size_t WS_BETA = al256(WS_WI + (size_t)NTOK * 16 * 4);
constexpr size_t WS_G = al256(WS_BETA + (size_t)NTOK * 16 * 4);
constexpr int LDR = 4160;
constexpr size_t WS_SCR = al256(WS_G + (size_t)NTOK * 16 * 4);
constexpr int GP_W = 0, GP_QD = 16384, GP_KD = 32768, GP_U = 49152, GP_QK = 65536, GP_STRIDE = 73728;
constexpr size_t WS_GP = al256(WS_SCR + (size_t)256 * 32 * LDR * 4);
constexpr size_t WS_GL = al256(WS_GP + (size_t)144 * 16 * GP_STRIDE);
constexpr size_t WS_MASK = al256(WS_GL + (size_t)144 * 16 * 4);
constexpr size_t WS_END = al256(WS_MASK + (size_t)288 * 32 * 65 * 8);

constexpr int LDS_BYTES = 147456, LDS_MISC = 131072;

#define XB_TMO      128
#define XB_XCNT(j)  (256  + 64 * (j))
#define XB_XSUB(j)  (1280 + 64 * (j))
#define XB_XGEN(j)  (2304 + 64 * (j))
#define XB_TOP      3328
#define XB_TOPGEN   3392
#define XCD_BAR_WORDS 3456
#define XB_SPIN_CAP (1u << 18)
__device__ __forceinline__ unsigned xb_ld(unsigned* p)              { return __hip_atomic_load(p, __ATOMIC_RELAXED, __HIP_MEMORY_SCOPE_AGENT); }
__device__ __forceinline__ unsigned xb_add(unsigned* p, unsigned v) { return __hip_atomic_fetch_add(p, v, __ATOMIC_RELAXED, __HIP_MEMORY_SCOPE_AGENT); }
__device__ __forceinline__ unsigned xb_xcc_id() { return (unsigned)__builtin_amdgcn_s_getreg((3 << 11) | 20) & 0xFu; }
#define XB_SPIN(cond, bar) do { unsigned _sp = 0; while (cond) { __builtin_amdgcn_s_sleep(1); \
    if ((++_sp & 255u) == 0u) { if (xb_ld(&(bar)[XB_TMO])) break; if (_sp > XB_SPIN_CAP) { atomicAdd(&(bar)[XB_TMO], 1u); break; } } } } while (0)
struct XcdBarrier { unsigned* bar; unsigned x; volatile LAS unsigned* st; };
__device__ __forceinline__ XcdBarrier xcd_barrier_post(unsigned* bar, volatile LAS unsigned* st) {
    XcdBarrier b; b.bar = bar; b.x = xb_xcc_id(); b.st = st;
    if (threadIdx.x == 0) (void)xb_add(&bar[XB_XCNT(b.x)], 1u);
    return b;
}
__device__ __forceinline__ void xcd_barrier_complete(unsigned* bar, unsigned x, unsigned& nloc, unsigned& nx) {
    const unsigned G = gridDim.x * gridDim.y * gridDim.z;
    unsigned sum, cnt, mine, sp = 0u;
    for (;;) {
        sum = 0u; cnt = 0u; mine = 0u;
#pragma unroll
        for (unsigned j = 0; j < 16; ++j) { const unsigned c = xb_ld(&bar[XB_XCNT(j)]); sum += c; cnt += (c > 0u) ? 1u : 0u; mine = (j == x) ? c : mine; }
        if (sum == G) break;
        __builtin_amdgcn_s_sleep(1);
        if ((++sp & 255u) == 0u) { if (xb_ld(&bar[XB_TMO])) break; if (sp > XB_SPIN_CAP) { atomicAdd(&bar[XB_TMO], 1u); break; } }
    }
    nloc = mine > 0u ? mine : 1u; nx = cnt > 0u ? cnt : 1u;
}
__device__ __forceinline__ void xcd_barrier(const XcdBarrier b, const int leader) {
    asm volatile("s_waitcnt vmcnt(0)" ::: "memory");
    __syncthreads();
    if (leader) {
        unsigned* bar = b.bar;
        __builtin_amdgcn_s_waitcnt(0);
        unsigned nloc = b.st[0], nx = b.st[1];
        if (nloc == 0u) { xcd_barrier_complete(bar, b.x, nloc, nx); b.st[0] = nloc; b.st[1] = nx; }
        const unsigned old = xb_add(&bar[XB_XSUB(b.x)], 1u);
        const unsigned gen = old / nloc;
        if (old + 1u == (gen + 1u) * nloc) {
            __builtin_amdgcn_fence(__ATOMIC_RELEASE, "agent");
            asm volatile("s_waitcnt vmcnt(0)" ::: "memory");
            const unsigned og = xb_add(&bar[XB_TOP], 1u);
            const unsigned tg = og / nx;
            if (og + 1u == (tg + 1u) * nx) xb_add(&bar[XB_TOPGEN], 1u);
            else XB_SPIN(xb_ld(&bar[XB_TOPGEN]) == tg, bar);
            __builtin_amdgcn_fence(__ATOMIC_ACQUIRE, "agent");
            xb_add(&bar[XB_XGEN(b.x)], 1u);
            asm volatile("s_waitcnt vmcnt(0)" ::: "memory");
        } else {
            XB_SPIN(xb_ld(&bar[XB_XGEN(b.x)]) == gen, bar);
            __builtin_amdgcn_fence(__ATOMIC_ACQUIRE, "agent");
            asm volatile("s_waitcnt vmcnt(0)" ::: "memory");
        }
    }
    __syncthreads();
}

DI int lane_id_fresh() { unsigned z = 0u; asm volatile("" : "+v"(z)); return (int)__builtin_amdgcn_mbcnt_hi(~0u, __builtin_amdgcn_mbcnt_lo(~0u, z)); }
template <int O> DI float swz_xor(float v) { return __builtin_bit_cast(float, __builtin_amdgcn_ds_swizzle(__builtin_bit_cast(int, v), (O << 10) | 0x1F)); }
DI float shx32(float v, int lane) { return __builtin_bit_cast(float, __builtin_amdgcn_ds_bpermute((lane ^ 32) << 2, __builtin_bit_cast(int, v))); }
DI float wave_sum(float v, int lane) {
    v += swz_xor<1>(v); v += swz_xor<2>(v); v += swz_xor<4>(v); v += swz_xor<8>(v); v += swz_xor<16>(v);
    return v + shx32(v, lane);
}
DI float sigmoidf_(float x) { return 1.0f / (1.0f + __expf(-x)); }
DI float siluf_(float x) { return x / (1.0f + __expf(-x)); }
DI unsigned pk_f16(float lo, float hi) { h2 v = {(f16)lo, (f16)hi}; return __builtin_bit_cast(unsigned, v); }
DI void rowinfo(int slab, int rs, int& R, int& sq, int& t) {
    if (rs < 8192) { R = slab * 8192 + rs; sq = R >> 11; t = R & 2047; }
    else { const int q = rs - 8192; R = NTOKP + q; sq = 16 + (q >> 6); t = q & 63; }
}
DI int posbase(int sq) { return sq < 16 ? sq * 2048 : 32768 + (sq - 16) * LSMP; }
__host__ __device__ inline int ts_of(int slab) { return slab == 0 ? 9216 : 8192; }
DI int proj_src_col(int n) {
    if (n < 8192) return n;
    if (n < 10240) return 8224 + (n - 8192);
    if (n < 12288) return 10784 + (n - 10240);
    if (n < 13312) return 12832 + (n - 12288);
    if (n < 15360) return 13936 + (n - 13312);
    if (n < 17408) return 15984 + (n - 15360);
    if (n < 17664) return 10272 + (n - 17408);
    if (n < 17920) return 10528 + (n - 17664);
    const int j = n - 17920;
    if (j < 64) return 13856 + j;
    if (j < 80) return 13920 + (j - 64);
    if (j < 96) return 8192 + (j - 80);
    if (j < 112) return 8208 + (j - 96);
    return -1;
}
DI int rel_bucket(int rel) {
    const int n = rel < 0 ? -rel : rel;
    const int v = n < 8 ? n : (n < 12 ? 8 : n < 16 ? 9 : n < 23 ? 10 : n < 32 ? 11 : n < 46 ? 12 : n < 64 ? 13 : n < 91 ? 14 : 15);
    return (rel > 0 ? 16 : 0) + v;
}

namespace pg8 {
constexpr int BM = 256, BK = 64, HALF = 128, HTB = HALF * BK * 2, STAGE_BYTES = 8 * HTB, NXCD = 8, WGM = 8;
DI int lds_byte(int r, int c) { const int st = (r >> 4) * 2 + (c >> 5), rr = r & 15, cc = c & 31, ob = rr * 64 + cc * 2; return st * 1024 + (ob ^ (((ob >> 9) & 1) << 5)); }
DI void stage_rc(int b, int& R, int& C) { const int st = b / 1024, sb = b % 1024, swz = sb ^ (((sb >> 9) & 1) << 5); R = (st >> 1) * 16 + swz / 64; C = (st & 1) * 32 + (swz % 64) / 2; }
DI int perm32(int rho) { const int n = rho >> 4, i = rho & 15; return 8 * (i >> 2) + 4 * n + (i & 3); }

struct Unit { int pm, pn, which; };
struct Gemm { GLB const f16* A0; GLB const f16* B0; GLB const f16* A1; GLB const f16* B1; int M, N, K; };

struct StaticOrder {
    int nM, nN, nwg, G, c;
    DI void init(int M, int N, int G_, int c_) { nM = M / BM; nN = N / BM; nwg = nM * nN; G = G_; c = c_; }
    DI bool tile(long L, Unit& u) const {
        if (L >= nwg) return false;
        int wgid = (int)L; { const int q = nwg / NXCD, r = nwg % NXCD, xcd = wgid % NXCD, off = wgid / NXCD; wgid = (xcd < r ? xcd * (q + 1) : r * (q + 1) + (xcd - r) * q) + off; }
        const int nig = WGM * nN, gid = wgid / nig, fm = gid * WGM, gsz = (nM - fm) < WGM ? (nM - fm) : WGM;
        u.pm = fm + ((wgid % nig) % gsz); u.pn = (wgid % nig) / gsz; return true;
    }
    DI bool next(int i, Unit& u) const { u.which = 0; return tile((long)i * G + c, u); }
};
struct DualOrder : StaticOrder {
    DI bool next(int i, Unit& u) const { u.which = i & 1; return tile((long)(i >> 1) * G + c, u); }
};

template <class Epi, class Sched, bool ALIGN_EPI = true>
DI void gemm_phase(LAS unsigned char* lds, const Gemm g, const Sched& S, const Epi& E, int wave_s) {
    int tid_ = lane_id_fresh() + wave_s * 64; asm volatile("" : "+v"(tid_));
    const int tid = tid_, wid = __builtin_amdgcn_readfirstlane(tid >> 6), lane = tid & 63, wr = wid >> 2, wc = wid & 3, fr = lane & 15, fq = lane >> 4;
    const int K = g.K, nt = K / BK;
    unsigned voffA[2], voffB[2];
#pragma unroll
    for (int i = 0; i < 2; ++i) { int R, C; stage_rc(tid * 16 + i * 8192, R, C); const int Rb = (R & ~31) + perm32(R & 31);
        voffA[i] = (unsigned)(R * K + C) * 2u; voffB[i] = (unsigned)(Rb * K + C) * 2u; }
    const size_t kstep = (size_t)(BK * 2);
    const size_t hstep = (size_t)HALF * K * 2;
    const size_t tstep = 2 * hstep;
    const unsigned ldsw = (unsigned)wid * 1024u;
    const int aoff = lds_byte(wr * 64 + fr, fq * 8), boff = lds_byte(wc * 32 + fr, fq * 8);
#define PG8_SA(b, h) (((b) * 2 + (h)) * HTB)
#define PG8_SB(b, h) ((4 + (b) * 2 + (h)) * HTB)
#define PG8_STAGE(bufoff, gbase, voff) do { _Pragma("unroll") for (int _i = 0; _i < 2; ++_i) \
        __builtin_amdgcn_global_load_lds((GLB const unsigned*)((GLB const char*)(gbase) + (voff)[_i]), (LAS unsigned*)(lds + (bufoff) + ldsw + _i * 8192), 16, 0, 0); } while (0)
#define PG8_LDA(dst, b, h) do { _Pragma("unroll") for (int m = 0; m < 4; ++m) _Pragma("unroll") for (int k = 0; k < 2; ++k) dst[m][k] = *(const LAS h8*)(lds + PG8_SA(b, h) + aoff + m * 2048 + k * 1024); } while (0)
#define PG8_LDB(dst, b, h) do { _Pragma("unroll") for (int n = 0; n < 2; ++n) _Pragma("unroll") for (int k = 0; k < 2; ++k) dst[n][k] = *(const LAS h8*)(lds + PG8_SB(b, h) + boff + n * 2048 + k * 1024); } while (0)
#define PG8_MMA(ai, bj, At, Bt) do { __builtin_amdgcn_s_setprio(1); _Pragma("unroll") for (int m = 0; m < 4; ++m) _Pragma("unroll") for (int n = 0; n < 2; ++n) _Pragma("unroll") for (int k = 0; k < 2; ++k) \
        acc[ai][bj][m][n] = __builtin_amdgcn_mfma_f32_16x16x32_f16(Bt[n][k], At[m][k], acc[ai][bj][m][n], 0, 0, 0); __builtin_amdgcn_s_setprio(0); } while (0)
#define PG8_WAIT_V(n) asm volatile("s_waitcnt vmcnt(" #n ")" ::: "memory")
#define PG8_WAIT_L(n) asm volatile("s_waitcnt lgkmcnt(" #n ")" ::: "memory")
#define PG8_BAR __builtin_amdgcn_s_barrier()
#define PG8_SCHED __builtin_amdgcn_sched_barrier(0)
    Unit cur, nxt; int ui = 0;
    if (!S.next(0, cur)) return;
    f32x4 acc[2][2][4][2];
#pragma unroll
    for (int a = 0; a < 2; ++a)
#pragma unroll
        for (int b = 0; b < 2; ++b)
#pragma unroll
            for (int m = 0; m < 4; ++m)
#pragma unroll
                for (int n = 0; n < 2; ++n) acc[a][b][m][n] = (f32x4){0.f, 0.f, 0.f, 0.f};
    h8 At[4][2], B0[2][2], B1[2][2];
    GLB const char* cA = (GLB const char*)(cur.which ? g.A1 : g.A0) + (size_t)cur.pm * tstep; GLB const char* cB = (GLB const char*)(cur.which ? g.B1 : g.B0) + (size_t)cur.pn * tstep;
    PG8_STAGE(PG8_SB(0, 0), cB, voffB); PG8_STAGE(PG8_SB(0, 1), cB + hstep, voffB); PG8_STAGE(PG8_SA(0, 0), cA, voffA); PG8_STAGE(PG8_SA(0, 1), cA + hstep, voffA);
    if (wr == 1) PG8_BAR;
    PG8_WAIT_V(2); PG8_BAR;
    PG8_STAGE(PG8_SB(1, 0), cB + kstep, voffB); PG8_STAGE(PG8_SA(1, 0), cA + kstep, voffA); PG8_STAGE(PG8_SB(1, 1), cB + hstep + kstep, voffB);
    PG8_WAIT_V(6); PG8_BAR;
    for (;;) {
        const bool has_next = S.next(ui + 1, nxt);
        GLB const char* nA = has_next ? (GLB const char*)(nxt.which ? g.A1 : g.A0) + (size_t)nxt.pm * tstep : cA; GLB const char* nB = has_next ? (GLB const char*)(nxt.which ? g.B1 : g.B0) + (size_t)nxt.pn * tstep : cB;
        for (int t = 0; t < nt; t += 2) {
            const bool last = (t == nt - 2);
            GLB const char* a1 = cA + (size_t)(t + 1) * kstep;
            GLB const char* a2 = last ? nA : cA + (size_t)(t + 2) * kstep; GLB const char* b2 = last ? nB : cB + (size_t)(t + 2) * kstep;
            GLB const char* a3 = a2 + kstep; GLB const char* b3 = b2 + kstep;
            PG8_LDB(B0, 0, 0); PG8_LDB(B1, 0, 1); PG8_SCHED; PG8_LDA(At, 0, 0); PG8_STAGE(PG8_SA(1, 1), a1 + hstep, voffA);
            PG8_WAIT_V(8); PG8_WAIT_L(0); PG8_BAR; PG8_MMA(0, 0, At, B0); PG8_MMA(0, 1, At, B1); PG8_BAR; PG8_SCHED;
            PG8_LDA(At, 0, 1); PG8_STAGE(PG8_SB(0, 0), b2, voffB); PG8_STAGE(PG8_SB(0, 1), b2 + hstep, voffB); PG8_STAGE(PG8_SA(0, 0), a2, voffA);
            PG8_WAIT_V(8); PG8_WAIT_L(0); PG8_BAR; PG8_MMA(1, 0, At, B0); PG8_MMA(1, 1, At, B1); PG8_BAR; PG8_SCHED;
            PG8_LDB(B0, 1, 0); PG8_LDB(B1, 1, 1); PG8_SCHED; PG8_LDA(At, 1, 0); PG8_STAGE(PG8_SA(0, 1), a2 + hstep, voffA);
            PG8_WAIT_V(8); PG8_WAIT_L(0); PG8_BAR; PG8_MMA(0, 0, At, B0); PG8_MMA(0, 1, At, B1); PG8_BAR; PG8_SCHED;
            PG8_LDA(At, 1, 1); PG8_STAGE(PG8_SB(1, 0), b3, voffB); PG8_STAGE(PG8_SB(1, 1), b3 + hstep, voffB); PG8_STAGE(PG8_SA(1, 0), a3, voffA);
            PG8_WAIT_V(8); PG8_WAIT_L(0); PG8_BAR; PG8_MMA(1, 0, At, B0); PG8_MMA(1, 1, At, B1); PG8_BAR; PG8_SCHED;
        }
        if constexpr (ALIGN_EPI) { if (wr == 0) PG8_BAR; }
        E(acc, cur, wr, wc, fr, fq);
        if (!has_next) break;
#pragma unroll
        for (int a = 0; a < 2; ++a)
#pragma unroll
            for (int b = 0; b < 2; ++b)
#pragma unroll
                for (int m = 0; m < 4; ++m)
#pragma unroll
                    for (int n = 0; n < 2; ++n) acc[a][b][m][n] = (f32x4){0.f, 0.f, 0.f, 0.f};
        cur = nxt; cA = nA; cB = nB; ++ui;
        if constexpr (ALIGN_EPI) { if (wr == 1) PG8_BAR; }
    }
    PG8_WAIT_V(0);
    if constexpr (!ALIGN_EPI) { if (wr == 0) PG8_BAR; }
    PG8_BAR;
#undef PG8_SA
#undef PG8_SB
#undef PG8_STAGE
#undef PG8_LDA
#undef PG8_LDB
#undef PG8_MMA
#undef PG8_WAIT_V
#undef PG8_WAIT_L
#undef PG8_BAR
#undef PG8_SCHED
}
}

struct Args { const float* in[22]; float* out; unsigned char* ws; int ph_lo, ph_hi; };
constexpr int LDS_TAB = LDS_MISC + 256;
DI unsigned long long ldtab(LAS unsigned char* lds, int i) {
    const unsigned vx = *(const volatile LAS unsigned*)(lds + LDS_TAB + 8 * i), vy = *(const volatile LAS unsigned*)(lds + LDS_TAB + 8 * i + 4); u32x2 v; v.x = vx; v.y = vy;
    return ((unsigned long long)(unsigned)__builtin_amdgcn_readfirstlane((int)v.y) << 32) | (unsigned)__builtin_amdgcn_readfirstlane((int)v.x);
}
struct Frame {
    LAS unsigned char* lds; int tid, lane, wave, G, bid;
    DI Frame fresh() const { Frame f = *this; int t = lane_id_fresh() + wave * 64; asm volatile("" : "+v"(t)); f.tid = t; f.lane = t & 63; f.wave = wave; return f; }
    DI GLB const float* in(int i) const { return (GLB const float*)ldtab(lds, i); }
    DI GLB float* out() const { return (GLB float*)ldtab(lds, 22); }
    DI GLB unsigned char* ws() const { return (GLB unsigned char*)ldtab(lds, 23); }
    DI unsigned* ctl() const { return (unsigned*)ldtab(lds, 23); }
    DI GLB float* ADA() const { return (GLB float*)(ws() + WS_ADA); }
    DI GLB f16* WIN() const { return (GLB f16*)(ws() + WS_WIN); }
    DI GLB f16* WA() const { return (GLB f16*)(ws() + WS_WA); }
    DI GLB f16* WB() const { return (GLB f16*)(ws() + WS_WB); }
    DI GLB f16* WO() const { return (GLB f16*)(ws() + WS_WO); }
    DI GLB f16* H() const { return (GLB f16*)(ws() + WS_H); }
    DI GLB f16* PROJ() const { return (GLB f16*)(ws() + WS_PROJ); }
    DI GLB f16* OA() const { return (GLB f16*)(ws() + WS_OA); }
    DI GLB f16* OB() const { return (GLB f16*)(ws() + WS_OB); }
    DI GLB f16* KU() const { return (GLB f16*)(ws() + WS_KU); }
    DI GLB f16* VU() const { return (GLB f16*)(ws() + WS_VU); }
    DI GLB f16* KIU() const { return (GLB f16*)(ws() + WS_KIU); }
    DI GLB float* WI() const { return (GLB float*)(ws() + WS_WI); }
    DI GLB float* BETA() const { return (GLB float*)(ws() + WS_BETA); }
    DI GLB float* GG() const { return (GLB float*)(ws() + WS_G); }
};
enum { I_XP = 0, I_XS, I_CP, I_CS, I_CK, I_CV, I_CIK, I_SG, I_SC, I_NW, I_WADA, I_BADA, I_WIN, I_WCONV, I_ALOG, I_DTB, I_GNW, I_WBA, I_WBB, I_WOUT, I_RELB, I_FNW };
constexpr int CW_BAR = 0, CW_Q = 4096;

struct EpiProj {
    static constexpr bool PERM = true;
    GLB f16* proj; GLB float* out; GLB f16 *KU, *VU, *KIU; GLB float *WI, *BETA, *GG; GLB const float *a_log, *dt_bias; int layer, slab;
    DI void operator()(const f32x4 (&acc)[2][2][4][2], const pg8::Unit& u, int wr, int wc, int fr_, int fq_) const {
        int fr = fr_, fq = fq_; asm volatile("" : "+v"(fr), "+v"(fq));
        const int pn = u.pn;
        const int rsb = u.pm * 256 + wr * 64 + fr;
        if (pn < 68) {
            const int act = ((pn >= 24 && pn < 32) || (pn >= 40 && pn < 48)) ? 1 : (pn >= 52 ? 2 : 0);
            const int col0 = pn * 256 + wc * 32 + 8 * fq;
#pragma unroll
            for (int ai = 0; ai < 2; ++ai)
#pragma unroll
                for (int m = 0; m < 4; ++m) {
                    GLB f16* rowp = proj + (size_t)(rsb + ai * 128 + m * 16) * PS + col0;
#pragma unroll
                    for (int bj = 0; bj < 2; ++bj) {
                        f32x4 v0 = acc[ai][bj][m][0], v1 = acc[ai][bj][m][1];
                        if (act == 1) {
#pragma unroll
                            for (int j = 0; j < 4; ++j) { v0[j] = siluf_(v0[j]); v1[j] = siluf_(v1[j]); }
                        } else if (act == 2) {
#pragma unroll
                            for (int j = 0; j < 4; ++j) { v0[j] = sigmoidf_(v0[j]); v1[j] = sigmoidf_(v1[j]); }
                        }
                        u32x4 w; w.x = pk_f16(v0[0], v0[1]); w.y = pk_f16(v0[2], v0[3]); w.z = pk_f16(v1[0], v1[1]); w.w = pk_f16(v1[2], v1[3]);
                        *(GLB u32x4*)(rowp + bj * 128) = w;
                    }
                }
            if (pn < 24 && fr >= 13) {
                const bool smp = u.pm >= 32;
                if (smp || (u.pm & 7) == 7) {
#pragma unroll
                    for (int ai = 0; ai < 2; ++ai) {
                        if (!smp && !(ai == 1 && wr == 1)) continue;
                        int R, sq, t; rowinfo(slab, rsb + ai * 128 + 48, R, sq, t);
                        const int T = smp ? 64 : 2048;
                        GLB float* base = out + (smp ? O_NCS : O_NCP) + ((size_t)(layer * 16 + (sq & 15)) * 3 + (t - (T - 3))) * 6144 + col0;
#pragma unroll
                        for (int bj = 0; bj < 2; ++bj) { *(GLB f32x4*)(base + bj * 128) = acc[ai][bj][3][0]; *(GLB f32x4*)(base + bj * 128 + 4) = acc[ai][bj][3][1]; }
                    }
                }
            }
        } else {
#pragma unroll
            for (int ai = 0; ai < 2; ++ai)
#pragma unroll
                for (int m = 0; m < 4; ++m) {
                    int R, sq, t; rowinfo(slab, rsb + ai * 128 + m * 16, R, sq, t);
                    const bool smp = sq >= 16; const int b = sq & 15;
                    const size_t pos = (size_t)posbase(sq) + (smp ? PAST : 0) + t;
#pragma unroll
                    for (int bj = 0; bj < 2; ++bj) {
                        const int c = bj * 128 + wc * 32 + 8 * fq;
                        const f32x4 v0 = acc[ai][bj][m][0], v1 = acc[ai][bj][m][1];
                        if (pn < 70) {
                            GLB float* o = out + (pn == 68 ? (smp ? O_NKS : O_NKP) : (smp ? O_NVS : O_NVP)) + ((size_t)(layer * 16 + b) * (smp ? 64 : 2048) + t) * 256 + c;
                            *(f32x4*)o = v0; *(GLB f32x4*)(o + 4) = v1;
                            u32x4 w; w.x = pk_f16(v0[0], v0[1]); w.y = pk_f16(v0[2], v0[3]); w.z = pk_f16(v1[0], v1[1]); w.w = pk_f16(v1[2], v1[3]);
                            *(GLB u32x4*)((pn == 68 ? KU : VU) + pos * 256 + c) = w;
                        } else if (c < 64) {
                            GLB float* o = out + (smp ? O_NIS : O_NIP) + ((size_t)(layer * 16 + b) * (smp ? 64 : 2048) + t) * 64 + c;
                            *(f32x4*)o = v0; *(GLB f32x4*)(o + 4) = v1;
                            u32x4 w; w.x = pk_f16(v0[0], v0[1]); w.y = pk_f16(v0[2], v0[3]); w.z = pk_f16(v1[0], v1[1]); w.w = pk_f16(v1[2], v1[3]);
                            *(GLB u32x4*)(KIU + pos * 64 + c) = w;
                        } else if (c < 80) {
                            GLB float* o = WI + (size_t)R * 16 + (c - 64);
                            *(f32x4*)o = v0 * 0.03125f; *(GLB f32x4*)(o + 4) = v1 * 0.03125f;
                        } else if (c < 96) {
                            GLB float* o = BETA + (size_t)R * 16 + (c - 80);
                            f32x4 a, bb;
#pragma unroll
                            for (int j = 0; j < 4; ++j) { a[j] = sigmoidf_(v0[j]); bb[j] = sigmoidf_(v1[j]); }
                            *(f32x4*)o = a; *(GLB f32x4*)(o + 4) = bb;
                        } else if (c < 112) {
                            GLB float* o = GG + (size_t)R * 16 + (c - 96);
                            f32x4 a, bb;
#pragma unroll
                            for (int j = 0; j < 4; ++j) {
                                const int h0 = (c - 96) + j, h1 = h0 + 4;
                                const float x0 = v0[j] + dt_bias[h0], x1 = v1[j] + dt_bias[h1];
                                const float s0 = x0 > 20.f ? x0 : log1pf(__expf(x0)), s1 = x1 > 20.f ? x1 : log1pf(__expf(x1));
                                a[j] = -__expf(a_log[h0]) * s0; bb[j] = -__expf(a_log[h1]) * s1;
                            }
                            *(f32x4*)o = a; *(GLB f32x4*)(o + 4) = bb;
                        }
                    }
                }
        }
    }
};
struct EpiAB {
    static constexpr bool PERM = true;
    GLB const f16* proj; GLB f16* mg;
    DI void operator()(const f32x4 (&acc)[2][2][4][2], const pg8::Unit& u, int wr, int wc, int fr_, int fq_) const {
        int fr = fr_, fq = fq_; asm volatile("" : "+v"(fr), "+v"(fq));
        const int rsb = u.pm * 256 + wr * 64 + fr, col0 = u.pn * 256 + wc * 32 + 8 * fq;
        const int gc = (u.which ? C_GB : C_GA) + col0;
#pragma unroll
        for (int ai = 0; ai < 2; ++ai)
#pragma unroll
            for (int m = 0; m < 4; ++m) {
                const size_t rs = (size_t)(rsb + ai * 128 + m * 16);
#pragma unroll
                for (int bj = 0; bj < 2; ++bj) {
                    const h8 gt = *(GLB const h8*)(proj + rs * PS + gc + bj * 128);
                    GLB f16* mp = mg + rs * 2048 + col0 + bj * 128;
                    float r[8];
#pragma unroll
                    for (int j = 0; j < 4; ++j) { r[j] = (float)gt[j] * acc[ai][bj][m][0][j]; r[4 + j] = (float)gt[4 + j] * acc[ai][bj][m][1][j]; }
                    if (u.which) { const h8 pv = *(const h8*)mp;
#pragma unroll
                        for (int j = 0; j < 8; ++j) r[j] += (float)pv[j]; }
                    u32x4 w; w.x = pk_f16(r[0], r[1]); w.y = pk_f16(r[2], r[3]); w.z = pk_f16(r[4], r[5]); w.w = pk_f16(r[6], r[7]);
                    *(u32x4*)mp = w;
                }
            }
    }
};
struct EpiOut {
    static constexpr bool PERM = true;
    GLB const float* xp; GLB const float* xs; GLB float* out; GLB const float* ada; int layer, slab;
    DI void operator()(const f32x4 (&acc)[2][2][4][2], const pg8::Unit& u, int wr, int wc, int fr_, int fq_) const {
        int fr = fr_, fq = fq_; asm volatile("" : "+v"(fr), "+v"(fq));
        const int rsb = u.pm * 256 + wr * 64 + fr, col0 = u.pn * 256 + wc * 32 + 8 * fq;
#pragma unroll
        for (int ai = 0; ai < 2; ++ai)
#pragma unroll
            for (int m = 0; m < 4; ++m) {
                int R, sq, t; rowinfo(slab, rsb + ai * 128 + m * 16, R, sq, t);
                GLB const float* xo = layer == 0 ? (R < NTOKP ? xp + (size_t)R * D : xs + (size_t)(R - NTOKP) * D) : out + (size_t)R * D;
                GLB const float* gp = ada + (size_t)sq * 6144 + 4096;
                GLB float* yo = out + (size_t)R * D;
#pragma unroll
                for (int bj = 0; bj < 2; ++bj) {
                    const int c = col0 + bj * 128;
                    const f32x4 x0 = *(GLB const f32x4*)(xo + c), x1 = *(GLB const f32x4*)(xo + c + 4), g0 = *(GLB const f32x4*)(gp + c), g1 = *(GLB const f32x4*)(gp + c + 4);
                    *(GLB f32x4*)(yo + c) = x0 + g0 * acc[ai][bj][m][0]; *(GLB f32x4*)(yo + c + 4) = x1 + g1 * acc[ai][bj][m][1];
                }
            }
    }
};

DI void p0_prologue(const Frame F0) {
    const Frame F = F0.fresh();
    LAS float* tile = (LAS float*)F.lds;
    const int tid = F.tid;
    for (int u = F.bid; u < 2 * 12160; u += F.G) {
        const int l = u / 12160; int v = u % 12160;
        GLB const float* src; GLB f16* dst; int ldn, nb, kb; bool isin;
        if (v < 9088) { isin = true; nb = v >> 5; kb = v & 31; src = F.in(I_WIN) + (size_t)l * 2048 * IN_DIM; ldn = IN_DIM; dst = F.WIN() + (size_t)l * NP * 2048; }
        else { v -= 9088; const int mat = v >> 10, w = v & 1023; isin = false; nb = w >> 5; kb = w & 31; src = F.in(I_WBA + mat) + (size_t)l * 2048 * 2048; ldn = 2048;
               dst = (mat == 0 ? F.WA() : mat == 1 ? F.WB() : F.WO()) + (size_t)l * 2048 * 2048; }
        {
            const int nn = tid & 63, np = nb * 64 + nn; const int o = isin ? proj_src_col(np) : np;
#pragma unroll
            for (int i = 0; i < 8; ++i) { const int kk = (tid >> 6) + 8 * i; tile[kk * 65 + nn] = o >= 0 ? src[(size_t)(kb * 64 + kk) * ldn + o] : 0.f; }
        }
        __syncthreads();
        {
            const int nn = tid >> 3, kg = tid & 7; h8 hv;
#pragma unroll
            for (int j = 0; j < 8; ++j) hv[j] = (f16)tile[(kg * 8 + j) * 65 + nn];
            *(GLB h8*)(dst + (size_t)(nb * 64 + nn) * 2048 + kb * 64 + kg * 8) = hv;
        }
        __syncthreads();
    }
    for (int u = F.bid; u < 2 * 96; u += F.G) {
        const int l = u / 96, cb = u % 96, kg = tid >> 6, n = tid & 63;
        float acc[32];
#pragma unroll
        for (int s = 0; s < 32; ++s) acc[s] = 0.f;
        GLB const float* W = F.in(I_WADA) + (size_t)l * 2048 * 6144 + cb * 64 + n;
        for (int kc = 0; kc < 4; ++kc) {
            for (int i = tid; i < 32 * 512; i += NTHR) { const int s = i >> 9, k = i & 511; const float c = (s < 16 ? F.in(I_CP) + s * 2048 : F.in(I_CS) + (s - 16) * 2048)[kc * 512 + k]; tile[i] = siluf_(c); }
            __syncthreads();
            for (int kk = 0; kk < 64; ++kk) { const int k = kg * 64 + kk; const float w = W[(size_t)(kc * 512 + k) * 6144];
#pragma unroll
                for (int s = 0; s < 32; ++s) acc[s] += tile[s * 512 + k] * w; }
            __syncthreads();
        }
#pragma unroll
        for (int s = 0; s < 32; ++s) tile[(kg * 32 + s) * 64 + n] = acc[s];
        __syncthreads();
        for (int o = tid; o < 2048; o += NTHR) { const int s = o >> 6, nn = o & 63; float r = F.in(I_BADA)[l * 6144 + cb * 64 + nn];
#pragma unroll
            for (int g = 0; g < 8; ++g) r += tile[(g * 32 + s) * 64 + nn];
            F.ADA()[(size_t)(l * 32 + s) * 6144 + cb * 64 + nn] = r; }
        __syncthreads();
    }
}

DI void phase_norm(const Frame F0, int l, int slab) {
    const Frame F = F0.fresh();
    const int Ts = ts_of(slab);
    GLB const float* nw = F.in(I_NW) + l * 2048;
    for (int rs = F.bid * NWAVES + F.wave; rs < Ts; rs += F.G * NWAVES) {
        int R, sq, t; rowinfo(slab, rs, R, sq, t);
        GLB const float* x = l == 0 ? (R < NTOKP ? F.in(I_XP) + (size_t)R * D : F.in(I_XS) + (size_t)(R - NTOKP) * D) : F.out() + (size_t)R * D;
        GLB const float* ad = F.ADA() + (size_t)(l * 32 + sq) * 6144;
        f32x4 v[8]; float ss = 0.f;
#pragma unroll
        for (int i = 0; i < 8; ++i) { v[i] = *(GLB const f32x4*)(x + (i * 64 + F.lane) * 4); ss += v[i][0] * v[i][0] + v[i][1] * v[i][1] + v[i][2] * v[i][2] + v[i][3] * v[i][3]; }
        ss = wave_sum(ss, F.lane);
        const float r = rsqrtf(ss * (1.0f / 2048.0f) + EPS);
#pragma unroll
        for (int i = 0; i < 8; ++i) { const int c = (i * 64 + F.lane) * 4;
            const f32x4 w = *(GLB const f32x4*)(nw + c), sh = *(GLB const f32x4*)(ad + c), sc = *(GLB const f32x4*)(ad + 2048 + c);
            const f32x4 hv = v[i] * r * w * (sc + 1.0f) + sh;
            u32x2 p; p.x = pk_f16(hv[0], hv[1]); p.y = pk_f16(hv[2], hv[3]);
            *(GLB u32x2*)(F.H() + (size_t)rs * 2048 + c) = p; }
    }
    if (slab == 0) {
        const size_t gid = (size_t)F.bid * NTHR + F.tid, gsz = (size_t)F.G * NTHR;
        const size_t nk = (size_t)16 * PAST * 32;
        for (size_t g = gid; g < nk; g += gsz) {
            const size_t b = g / (PAST * 32), rem = g % (PAST * 32), p = rem >> 5, c8 = (rem & 31) * 8;
            const size_t so = (size_t)l * 16 * PAST * 256 + g * 8, dof = ((size_t)32768 + b * LSMP + p) * 256 + c8;
            { const f32x4 a = *(GLB const f32x4*)(F.in(I_CK) + so), bb = *(GLB const f32x4*)(F.in(I_CK) + so + 4);
              u32x4 w; w.x = pk_f16(a[0], a[1]); w.y = pk_f16(a[2], a[3]); w.z = pk_f16(bb[0], bb[1]); w.w = pk_f16(bb[2], bb[3]); *(GLB u32x4*)(F.KU() + dof) = w; }
            { const f32x4 a = *(GLB const f32x4*)(F.in(I_CV) + so), bb = *(GLB const f32x4*)(F.in(I_CV) + so + 4);
              u32x4 w; w.x = pk_f16(a[0], a[1]); w.y = pk_f16(a[2], a[3]); w.z = pk_f16(bb[0], bb[1]); w.w = pk_f16(bb[2], bb[3]); *(GLB u32x4*)(F.VU() + dof) = w; }
        }
        const size_t ni = (size_t)16 * PAST * 8;
        for (size_t g = gid; g < ni; g += gsz) {
            const size_t b = g / (PAST * 8), rem = g % (PAST * 8), p = rem >> 3, c8 = (rem & 7) * 8;
            const size_t so = (size_t)l * 16 * PAST * 64 + g * 8, dof = ((size_t)32768 + b * LSMP + p) * 64 + c8;
            const f32x4 a = *(GLB const f32x4*)(F.in(I_CIK) + so), bb = *(GLB const f32x4*)(F.in(I_CIK) + so + 4);
            u32x4 w; w.x = pk_f16(a[0], a[1]); w.y = pk_f16(a[2], a[3]); w.z = pk_f16(bb[0], bb[1]); w.w = pk_f16(bb[2], bb[3]); *(GLB u32x4*)(F.KIU() + dof) = w;
        }
    }
}

DI unsigned sortable(float f) { const unsigned u = __float_as_uint(f); return (u & 0x80000000u) ? ~u : (u | 0x80000000u); }


typedef float f32x16 __attribute__((ext_vector_type(16)));
typedef __fp16 fp16x4_t __attribute__((__vector_size__(4 * sizeof(__fp16))));
#define MFMA32(a, b, c) __builtin_amdgcn_mfma_f32_32x32x16_f16((a), (b), (c), 0, 0, 0)
#define SB() __builtin_amdgcn_sched_barrier(0)
#define PRIO(n) __builtin_amdgcn_s_setprio(n)
constexpr int AT_KV = 0, AT_BUF = 35840, AT_V = 17408, AT_ROW = 272, AT_VROW = 288;
constexpr int AT_QI = 0, AT_QIS = 1032;
constexpr int AT_MASK = 71680, AT_BT = AT_MASK + 32 * 65 * 8, AT_WI = AT_BT + 16 * 192 * 4, AT_END = AT_WI + 32 * 16 * 4;
static_assert(AT_END <= LDS_MISC && 32 * AT_QIS * 2 <= AT_MASK, "attention LDS map");
constexpr float LOG2E = 1.4426950408889634f, SCL2 = 0.08838834764831845f * LOG2E;


constexpr int GX = 0, GX_S = 264, GTF = 33792, GPT = GTF + 17408, GTAB = GPT + 4096, GAT = GTAB + 1536, GAT_S = 68, GTM = GAT + 17408, GT_S = 72, GKB = GTM + 9216, GVB = GKB + 18432, GPRE_END = GVB + 18432;
static_assert(GPRE_END <= LDS_MISC, "gdn pre LDS map");
DI void gdn_pre_unit(const Frame& F0, int l, int slab, int c, int hd) {
    const Frame F = F0.fresh();
    const int tid = F.tid, lane = F.lane, wave = F.wave, r32 = lane & 31, h2 = lane >> 5;
    LAS unsigned char* lds = F.lds;
    LAS f16* X = (LAS f16*)(lds + GX);
    LAS float* TF = (LAS float*)(lds + GTF);
    LAS float* PT = (LAS float*)(lds + GPT);
    LAS float* TAB = (LAS float*)(lds + GTAB);
    LAS float* AT = (LAS float*)(lds + GAT);
    LAS f16* TM = (LAS f16*)(lds + GTM);
    LAS f16* KB = (LAS f16*)(lds + GKB);
    LAS f16* VB = (LAS f16*)(lds + GVB);
    const bool smp = c >= 128;
    const int sq = smp ? 16 + (c - 128) : slab * 4 + (c >> 5), n = smp ? 0 : (c & 31), b = sq & 15;
    const int rsb = smp ? 8192 + (sq - 16) * 64 : (sq - slab * 4) * 2048 + n * 64;
    const int Rb = smp ? NTOKP + (sq - 16) * 64 : sq * 2048 + n * 64;
    GLB const f16* PROJ = F.PROJ();
    GLB unsigned char* gp = F.ws() + WS_GP + (size_t)(c * 16 + hd) * GP_STRIDE;
    {
        GLB const float* wcv = F.in(I_WCONV) + (size_t)l * 4 * 6144;
        GLB const float* scv = F.in(I_SC) + (size_t)(l * 16 + b) * 3 * 6144;
        if (tid < 384) {
            const int run = tid / 48, cg = tid % 48, part = cg >> 4, c8 = (cg & 15) * 8, gch = part * 2048 + hd * 128 + c8, tok0 = run * 8;
            h8 xr[11];
#pragma unroll
            for (int r = 0; r < 11; ++r) {
                const int tt = tok0 - 3 + r;
                if (tt >= 0 || n > 0) xr[r] = *(GLB const h8*)(PROJ + (size_t)(rsb + tt) * PS + gch);
                else if (smp) { const f32x4 a = *(GLB const f32x4*)(scv + (size_t)(3 + tt) * 6144 + gch), bq = *(GLB const f32x4*)(scv + (size_t)(3 + tt) * 6144 + gch + 4);
                    h8 t; t[0] = (f16)a[0]; t[1] = (f16)a[1]; t[2] = (f16)a[2]; t[3] = (f16)a[3]; t[4] = (f16)bq[0]; t[5] = (f16)bq[1]; t[6] = (f16)bq[2]; t[7] = (f16)bq[3]; xr[r] = t; }
                else {
#pragma unroll
                    for (int j = 0; j < 8; ++j) xr[r][j] = (f16)0.f; }
            }
            float w[4][8];
#pragma unroll
            for (int tap = 0; tap < 4; ++tap) { const f32x4 w0 = *(GLB const f32x4*)(wcv + tap * 6144 + gch), w1 = *(GLB const f32x4*)(wcv + tap * 6144 + gch + 4);
#pragma unroll
                for (int j = 0; j < 4; ++j) { w[tap][j] = w0[j]; w[tap][4 + j] = w1[j]; } }
            h8 y[8];
#pragma unroll
            for (int tq = 0; tq < 8; ++tq)
#pragma unroll
                for (int j = 0; j < 8; ++j) {
                    const float acc = w[0][j] * (float)xr[tq][j] + w[1][j] * (float)xr[tq + 1][j] + w[2][j] * (float)xr[tq + 2][j] + w[3][j] * (float)xr[tq + 3][j];
                    y[tq][j] = (f16)siluf_(acc);
                }
            if (part < 2) {
#pragma unroll
                for (int tq = 0; tq < 8; ++tq) *(LAS h8*)(X + (tok0 + tq) * GX_S + cg * 8) = y[tq];
            }
            if (part >= 1) {
                LAS f16* img = part == 1 ? KB : VB;
#pragma unroll
                for (int j = 0; j < 8; ++j) { h8 t;
#pragma unroll
                    for (int tq = 0; tq < 8; ++tq) t[tq] = y[tq][j];
                    *(LAS h8*)(img + (c8 + j) * GT_S + tok0) = t; }
            }
        }
        if (wave == 7) {
            const float be = F.BETA()[(size_t)(Rb + lane) * 16 + hd];
            float gcv = F.GG()[(size_t)(Rb + lane) * 16 + hd];
#pragma unroll
            for (int o = 1; o < 64; o <<= 1) { const float tv = __builtin_bit_cast(float, __builtin_amdgcn_ds_bpermute(((lane - o) & 63) << 2, __builtin_bit_cast(int, gcv))); if (lane >= o) gcv += tv; }
            const float gl = __builtin_bit_cast(float, __builtin_amdgcn_readlane(__builtin_bit_cast(int, gcv), 63));
            TAB[128 + lane] = be; TAB[192 + lane] = gcv; TAB[256 + lane] = __expf(gcv); TAB[320 + lane] = __expf(gl - gcv);
            if (lane == 63) ((GLB float*)(F.ws() + WS_GL))[c * 16 + hd] = __expf(gl);
        }
    }
    __syncthreads();
    {
        const int tok = tid >> 3, part = tid & 7;
        float sq_ = 0.f, sk_ = 0.f;
#pragma unroll
        for (int u = 0; u < 2; ++u) { const h8 a = *(const LAS h8*)(X + tok * GX_S + part * 16 + u * 8), k = *(const LAS h8*)(X + tok * GX_S + 128 + part * 16 + u * 8);
#pragma unroll
            for (int j = 0; j < 8; ++j) { sq_ += (float)a[j] * (float)a[j]; sk_ += (float)k[j] * (float)k[j]; } }
        { sq_ += swz_xor<4>(sq_); sk_ += swz_xor<4>(sk_); sq_ += swz_xor<2>(sq_); sk_ += swz_xor<2>(sk_); sq_ += swz_xor<1>(sq_); sk_ += swz_xor<1>(sk_); }
        if (part == 0) { TAB[tok] = rsqrtf(sq_ + EPS) * 0.08838834764831845f; TAB[64 + tok] = rsqrtf(sk_ + EPS); }
    }
    __syncthreads();
    if (wave < 6) {
        const bool isqk = wave >= 3; const int ti = isqk ? wave - 3 : wave;
        const int rt = isqk ? (ti == 2 ? 1 : 0) : (wave == 2 ? 1 : 0), ct = isqk ? (ti == 0 ? 0 : 1) : (wave == 0 ? 0 : 1);
        f32x16 acc;
#pragma unroll
        for (int i = 0; i < 16; ++i) acc[i] = 0.f;
        {
            h8 fa[8], fb[8];
#pragma unroll
            for (int s = 0; s < 8; ++s) { fa[s] = *(const LAS h8*)(X + (32 * rt + r32) * GX_S + 128 + 16 * s + 8 * h2);
                fb[s] = *(const LAS h8*)(X + (32 * ct + r32) * GX_S + (isqk ? 0 : 128) + 16 * s + 8 * h2); }
            SB();
#pragma unroll
            for (int s = 0; s < 8; ++s) acc = MFMA32(fa[s], fb[s], acc);
            SB();
        }
        const int col = 32 * ct + r32;
        if (!isqk) {
            const float bk = TAB[128 + col] * TAB[64 + col], gck = TAB[192 + col];
#pragma unroll
            for (int g = 0; g < 4; ++g) { const int j0 = 32 * rt + 8 * g + 4 * h2;
                const f32x4 rk = *(const LAS f32x4*)(TAB + 64 + j0), gj = *(const LAS f32x4*)(TAB + 192 + j0);
                f32x4 v;
#pragma unroll
                for (int jj = 0; jj < 4; ++jj) v[jj] = (col > j0 + jj) ? bk * rk[jj] * acc[4 * g + jj] * __expf(fminf(gck - gj[jj], 0.f)) : 0.f;
                *(LAS f32x4*)(AT + col * GAT_S + j0) = v; }
        } else {
            const float rqi = TAB[col], gci = TAB[192 + col];
#pragma unroll
            for (int g = 0; g < 4; ++g) { const int j0 = 32 * rt + 8 * g + 4 * h2;
                const f32x4 rk = *(const LAS f32x4*)(TAB + 64 + j0), gj = *(const LAS f32x4*)(TAB + 192 + j0);
                h4 v;
#pragma unroll
                for (int jj = 0; jj < 4; ++jj) v[jj] = (f16)((col >= j0 + jj) ? rqi * rk[jj] * acc[4 * g + jj] * __expf(fminf(gci - gj[jj], 0.f)) : 0.f);
                *(GLB h4*)(gp + GP_QK + (col * 64 + j0) * 2) = v; }
        }
    } else if (wave == 6) {
#pragma unroll
        for (int u = 0; u < 4; ++u) { const int p = lane + 64 * u, i = p >> 3, j0 = 32 + (p & 7) * 4; *(GLB h4*)(gp + GP_QK + (i * 64 + j0) * 2) = (h4){(f16)0.f, (f16)0.f, (f16)0.f, (f16)0.f}; }
    }
    if (wave == 0 || wave == 2) {
        const int bs = wave == 0 ? 0 : 32;
        asm volatile("s_waitcnt lgkmcnt(0)" ::: "memory");
        {
            const int o = bs + 16 * ((lane >> 4) & 1), cc = lane & 15;
            float T[16];
#pragma unroll
            for (int i = 0; i < 16; ++i) {
                float sacc = (i == cc) ? 1.f : 0.f;
#pragma unroll
                for (int jg = 0; jg < (i + 3) / 4; ++jg) { const f32x4 a4 = *(const LAS f32x4*)(AT + (o + i) * GAT_S + o + 4 * jg);
#pragma unroll
                    for (int jj = 0; jj < 4; ++jj) if (4 * jg + jj < i) sacc -= a4[jj] * T[4 * jg + jj]; }
                T[i] = sacc;
            }
            if (lane < 32) {
#pragma unroll
                for (int i = 0; i < 16; ++i) TF[(o + i) * GAT_S + o + cc] = T[i];
            }
        }
        asm volatile("s_waitcnt lgkmcnt(0)" ::: "memory");
        {
            const int i = lane >> 2, c4 = (lane & 3) * 4;
            f32x4 p = {0.f, 0.f, 0.f, 0.f};
#pragma unroll
            for (int k = 0; k < 16; ++k) { const float a = AT[(bs + 16 + i) * GAT_S + bs + k]; const f32x4 t4 = *(const LAS f32x4*)(TF + (bs + k) * GAT_S + bs + c4); p += a * t4; }
            *(LAS f32x4*)(PT + (bs >> 5) * 256 + i * 16 + c4) = p;
            { float zz = 0.f; asm volatile("" : "+v"(zz)); *(LAS f32x4*)(TF + (bs + i) * GAT_S + bs + 16 + c4) = (f32x4){zz, zz, zz, zz}; }
            asm volatile("s_waitcnt lgkmcnt(0)" ::: "memory");
            f32x4 v = {0.f, 0.f, 0.f, 0.f};
#pragma unroll
            for (int k = 0; k < 16; ++k) { const float a = TF[(bs + 16 + i) * GAT_S + bs + 16 + k]; const f32x4 p4 = *(const LAS f32x4*)(PT + (bs >> 5) * 256 + k * 16 + c4); v -= a * p4; }
            *(LAS f32x4*)(TF + (bs + 16 + i) * GAT_S + bs + c4) = v;
        }
    } else {
        const int e = (wave == 1 ? 0 : wave - 2) * 64 + lane;
#pragma unroll 1
        for (int item = e; item < 4096; item += 384) {
            const int kind = item >> 10, rem = item & 1023;
            if (kind < 2) {
                const int d = rem >> 3, tg = rem & 7;
                LAS f16* p = (kind ? VB : KB) + d * GT_S + 8 * tg;
                const h8 xv = *(const LAS h8*)p;
                const f32x4 b0 = *(const LAS f32x4*)(TAB + 128 + 8 * tg), b1 = *(const LAS f32x4*)(TAB + 128 + 8 * tg + 4);
                f32x4 s0 = b0, s1 = b1;
                if (!kind) { s0 = s0 * *(const LAS f32x4*)(TAB + 64 + 8 * tg) * *(const LAS f32x4*)(TAB + 256 + 8 * tg); s1 = s1 * *(const LAS f32x4*)(TAB + 64 + 8 * tg + 4) * *(const LAS f32x4*)(TAB + 256 + 8 * tg + 4); }
                h8 o;
#pragma unroll
                for (int j = 0; j < 4; ++j) { o[j] = (f16)((float)xv[j] * s0[j]); o[4 + j] = (f16)((float)xv[4 + j] * s1[j]); }
                *(LAS h8*)p = o;
            } else {
                const int tok = rem >> 4, c8 = (rem & 15) * 8, which = kind - 2;
                const h8 xv = *(const LAS h8*)(X + tok * GX_S + (which ? 128 : 0) + c8);
                const float sc = which ? TAB[64 + tok] * TAB[320 + tok] : TAB[tok] * TAB[256 + tok];
                h8 o;
#pragma unroll
                for (int j = 0; j < 8; ++j) o[j] = (f16)((float)xv[j] * sc);
                *(GLB h8*)(gp + (which ? GP_KD : GP_QD) + (tok * 128 + c8) * 2) = o;
            }
        }
    }
    __syncthreads();
    {
        float p[2];
#pragma unroll
        for (int u = 0; u < 2; ++u) { const int e = tid + NTHR * u, i = e >> 5, cc = e & 31; float a = 0.f;
#pragma unroll 8
            for (int k = 0; k < 32; ++k) a += AT[(32 + i) * GAT_S + k] * TF[k * GAT_S + cc];
            p[u] = a; }
        PT[tid] = p[0]; PT[tid + NTHR] = p[1];
        __syncthreads();
#pragma unroll
        for (int u = 0; u < 2; ++u) { const int e = tid + NTHR * u, i = e >> 5, cc = e & 31; float v = 0.f;
#pragma unroll 8
            for (int k = 0; k < 32; ++k) v -= TF[(32 + i) * GAT_S + 32 + k] * PT[k * 32 + cc];
            TF[(32 + i) * GAT_S + cc] = v; }
    }
    __syncthreads();
    {
        const int i = tid >> 3, jg = tid & 7; h8 o;
#pragma unroll
        for (int jj = 0; jj < 8; ++jj) o[jj] = (i < 32 && jg >= 4) ? (f16)0.f : (f16)TF[i * GAT_S + 8 * jg + jj];
        *(LAS h8*)(TM + i * GT_S + 8 * jg) = o;
    }
    __syncthreads();
    {
        const int mt = wave & 3, nt = wave >> 2;
        f32x16 aw, au;
#pragma unroll
        for (int i = 0; i < 16; ++i) { aw[i] = 0.f; au[i] = 0.f; }
        {
            h8 tb[4], ka[4], vb[4];
#pragma unroll
            for (int s = 0; s < 4; ++s) {
                tb[s] = *(const LAS h8*)(TM + (32 * nt + r32) * GT_S + 16 * s + 8 * h2);
                ka[s] = *(const LAS h8*)(KB + (32 * mt + r32) * GT_S + 16 * s + 8 * h2);
                vb[s] = *(const LAS h8*)(VB + (32 * mt + r32) * GT_S + 16 * s + 8 * h2);
            }
            SB();
#pragma unroll
            for (int s = 0; s < 4; ++s) { aw = MFMA32(ka[s], tb[s], aw); au = MFMA32(tb[s], vb[s], au); }
            SB();
        }
#pragma unroll
        for (int g = 0; g < 4; ++g) {
            h4 w4, u4;
#pragma unroll
            for (int jj = 0; jj < 4; ++jj) { w4[jj] = (f16)aw[4 * g + jj]; u4[jj] = (f16)au[4 * g + jj]; }
            *(GLB h4*)(gp + GP_W + ((32 * nt + r32) * 128 + 32 * mt + 8 * g + 4 * h2) * 2) = w4;
            *(GLB h4*)(gp + GP_U + (((mt * 2 + nt) * 4 + g) * 64 + lane) * 8) = u4;
        }
    }
    __syncthreads();
}

constexpr int SC_W = 0, SC_QD = 17408, SC_KD = 34816, SC_QK = 53248, SC_BUF = 62464, SC_KROW = 288, SC_SSQ = 2 * SC_BUF, SC_END = SC_SSQ + 1024;
static_assert(SC_END <= LDS_MISC, "gdn scan LDS map");
DI void gdn_scan_unit(const Frame& F0, int l, int slab, int sq, int hd) {
    const Frame F = F0.fresh();
    const int tid = F.tid, lane = F.lane, wave = F.wave, r32 = lane & 31, h2 = lane >> 5;
    const int i16 = lane & 15, q4 = i16 >> 2, p4 = i16 & 3, blk = (lane >> 4) & 1;
    LAS unsigned char* lds = F.lds;
    LAS float* ssq = (LAS float*)(lds + SC_SSQ);
    const bool smp = sq >= 16; const int b = sq & 15, nch = smp ? 1 : 32;
    const int c0 = smp ? 128 + (sq - 16) : (sq - slab * 4) * 32;
    const int rs0 = smp ? 8192 + (sq - 16) * 64 : (sq - slab * 4) * 2048;
    GLB const unsigned char* gpb = F.ws() + WS_GP + (size_t)hd * GP_STRIDE;
    GLB const float* GLp = (GLB const float*)(F.ws() + WS_GL);
    const int w = wave;
    f32x16 S[4];
    if (wave < 4) {
        GLB const float* s0 = F.in(I_SG) + ((size_t)(l * 16 + b) * 16 + hd) * 16384;
#pragma unroll
        for (int mt = 0; mt < 4; ++mt)
#pragma unroll
            for (int i = 0; i < 16; ++i) S[mt][i] = smp ? s0[(32 * mt + (i & 3) + 8 * (i >> 2) + 4 * h2) * 128 + 32 * w + r32] : 0.f;
    }
    const int lt = tid - 256;
    h4 uf[2][4];
    if (wave < 4) { GLB const unsigned char* up = gpb + (size_t)c0 * 16 * GP_STRIDE + GP_U;
#pragma unroll
        for (int tm = 0; tm < 2; ++tm)
#pragma unroll
            for (int g = 0; g < 4; ++g) uf[tm][g] = *(GLB const h4*)(up + (((w * 2 + tm) * 4 + g) * 64 + lane) * 8); }
#define SC_LOAD(cc) do { GLB const unsigned char* src = gpb + (size_t)(cc) * 16 * GP_STRIDE; \
        _Pragma("unroll") for (int it = 0; it < 4; ++it) { const int i = lt + 256 * it, row = i >> 4, c8 = (i & 15) * 8; const int go = (row * 128 + c8) * 2; \
            t0[it] = *(GLB const u32x4*)(src + GP_W + go); t1[it] = *(GLB const u32x4*)(src + GP_QD + go); t2[it] = *(GLB const u32x4*)(src + GP_KD + go); } \
        _Pragma("unroll") for (int it = 0; it < 2; ++it) { const int i = lt + 256 * it, row = i >> 3, c8 = (i & 7) * 8; t3[it] = *(GLB const u32x4*)(src + GP_QK + (row * 64 + c8) * 2); } } while (0)
#define SC_STORE(bufi) do { LAS unsigned char* dst = lds + (bufi) * SC_BUF; \
        _Pragma("unroll") for (int it = 0; it < 4; ++it) { const int i = lt + 256 * it, row = i >> 4, c8 = (i & 15) * 8; const int lo = row * 272 + c8 * 2; \
            *(LAS u32x4*)(dst + SC_W + lo) = t0[it]; *(LAS u32x4*)(dst + SC_QD + lo) = t1[it]; *(LAS u32x4*)(dst + SC_KD + row * SC_KROW + c8 * 2) = t2[it]; } \
        _Pragma("unroll") for (int it = 0; it < 2; ++it) { const int i = lt + 256 * it, row = i >> 3, c8 = (i & 7) * 8; *(LAS u32x4*)(dst + SC_QK + row * 144 + c8 * 2) = t3[it]; } } while (0)
    u32x4 t0[4], t1[4], t2[4], t3[2];
    if (wave >= 4) { SC_LOAD(c0); SC_STORE(0); }
    __syncthreads();
    const float gnw0 = 0.f; (void)gnw0;
    if (wave >= 4) {
#pragma unroll 1
        for (int n = 0; n < nch; ++n) {
            int tl_ = lane_id_fresh() + wave * 64; asm volatile("" : "+v"(tl_));
            const int lt = tl_ - 256; const bool more = (n + 1) < nch;
            if (more) SC_LOAD(c0 + n + 1);
        asm volatile("s_waitcnt lgkmcnt(0)" ::: "memory"); __builtin_amdgcn_s_barrier(); asm volatile("" ::: "memory");
            if (more) SC_STORE((n + 1) & 1);
        asm volatile("s_waitcnt lgkmcnt(0)" ::: "memory"); __builtin_amdgcn_s_barrier(); asm volatile("" ::: "memory");
        }
    } else {
#pragma unroll 1
    for (int n = 0; n < nch; ++n) {
        const int c = c0 + n;
        int tl_ = lane_id_fresh() + wave * 64; asm volatile("" : "+v"(tl_));
        const int lt = tl_ - 256, lane = tl_ & 63, r32 = lane & 31, h2 = lane >> 5, i16 = lane & 15, q4 = i16 >> 2, p4 = i16 & 3, blk = (lane >> 4) & 1;
        LAS unsigned char* bufp = lds + (n & 1) * SC_BUF;
        f32x16 oT[2];
        h8 VNp[2][2];
        const bool more = (n + 1) < nch;
        float gl = 0.f; h4 zaf[2][4];
            gl = GLp[c * 16 + hd];
            h8 Sp[4][2];
#pragma unroll
            for (int mt = 0; mt < 4; ++mt)
#pragma unroll
                for (int ks = 0; ks < 2; ++ks) { h8 t;
#pragma unroll
                    for (int jj = 0; jj < 8; ++jj) t[jj] = (f16)S[mt][8 * ks + jj];
                    Sp[mt][ks] = t; }
#pragma unroll
            for (int tm = 0; tm < 2; ++tm) {
                h8 wf[8];
#pragma unroll
                for (int kq = 0; kq < 8; ++kq) {
                    LAS unsigned char* ap = bufp + SC_W + (32 * tm + r32) * 272 + 2 * (16 * kq + 4 * h2);
                    const h4 lo = *(const LAS h4*)ap, hi = *(const LAS h4*)(ap + 16);
                    wf[kq] = __builtin_shufflevector(lo, hi, 0, 1, 2, 3, 4, 5, 6, 7);
                }
                f32x16 ws;
#pragma unroll
                for (int i = 0; i < 16; ++i) ws[i] = 0.f;
                SB();
#pragma unroll
                for (int kq = 0; kq < 8; ++kq) ws = MFMA32(wf[kq], Sp[kq >> 1][kq & 1], ws);
                SB();
#pragma unroll
                for (int g = 0; g < 4; ++g)
#pragma unroll
                    for (int jj = 0; jj < 4; ++jj) ws[4 * g + jj] = (float)uf[tm][g][jj] - ws[4 * g + jj];
#pragma unroll
                for (int ks = 0; ks < 2; ++ks) { h8 t;
#pragma unroll
                    for (int jj = 0; jj < 8; ++jj) t[jj] = (f16)ws[8 * ks + jj];
                    VNp[tm][ks] = t; }
            }
#pragma unroll
            for (int tn = 0; tn < 2; ++tn) {
                f32x16 o;
#pragma unroll
                for (int i = 0; i < 16; ++i) o[i] = 0.f;
#pragma unroll
                for (int hb = 0; hb < 2; ++hb) {
                    h8 bf[4];
#pragma unroll
                    for (int kq = 0; kq < 4; ++kq) {
                        LAS unsigned char* bp = bufp + SC_QD + (32 * tn + r32) * 272 + 2 * (16 * (4 * hb + kq) + 4 * h2);
                        const h4 lo = *(const LAS h4*)bp, hi = *(const LAS h4*)(bp + 16);
                        bf[kq] = __builtin_shufflevector(lo, hi, 0, 1, 2, 3, 4, 5, 6, 7);
                    }
                    SB();
#pragma unroll
                    for (int kq = 0; kq < 4; ++kq) o = MFMA32(Sp[(4 * hb + kq) >> 1][kq & 1], bf[kq], o);
                    SB();
                }
                {
                    h8 bf[4];
#pragma unroll
                    for (int kq = 0; kq < 4; ++kq) {
                        LAS unsigned char* bp = bufp + SC_QK + (32 * tn + r32) * 144 + 2 * (16 * kq + 4 * h2);
                        const h4 lo = *(const LAS h4*)bp, hi = *(const LAS h4*)(bp + 16);
                        bf[kq] = __builtin_shufflevector(lo, hi, 0, 1, 2, 3, 4, 5, 6, 7);
                    }
                    SB();
#pragma unroll
                    for (int kq = 0; kq < 4; ++kq) o = MFMA32(VNp[kq >> 1][kq & 1], bf[kq], o);
                    SB();
                }
                oT[tn] = o;
                float sacc = 0.f;
#pragma unroll
                for (int i = 0; i < 16; ++i) sacc += o[i] * o[i];
                sacc += shx32(sacc, lane);
                if (h2 == 0) ssq[w * 64 + 32 * tn + r32] = sacc;
            }
            if (n + 1 < nch) {
                GLB const unsigned char* up = gpb + (size_t)(c + 1) * 16 * GP_STRIDE + GP_U;
#pragma unroll
                for (int tm = 0; tm < 2; ++tm)
#pragma unroll
                    for (int g = 0; g < 4; ++g) uf[tm][g] = *(GLB const h4*)(up + (((w * 2 + tm) * 4 + g) * 64 + lane) * 8);
            }
            {
                GLB const f16* PROJ = F.PROJ();
#pragma unroll
                for (int tn = 0; tn < 2; ++tn)
#pragma unroll
                    for (int g = 0; g < 4; ++g) zaf[tn][g] = *(GLB const h4*)(PROJ + (size_t)(rs0 + 64 * n + 32 * tn + r32) * PS + C_ZA + hd * 128 + 32 * w + 8 * g + 4 * h2);
            }
        asm volatile("s_waitcnt lgkmcnt(0)" ::: "memory"); __builtin_amdgcn_s_barrier(); asm volatile("" ::: "memory");
        {
            GLB const float* gnw = F.in(I_GNW) + l * 128;
#pragma unroll
            for (int tn = 0; tn < 2; ++tn) {
                const int tok = 32 * tn + r32;
                const float tot = ssq[tok] + ssq[64 + tok] + ssq[128 + tok] + ssq[192 + tok];
                const float rstd = rsqrtf(tot * (1.0f / 128.0f) + EPS);
                const size_t rs = (size_t)(rs0 + 64 * n + tok);
#pragma unroll
                for (int g = 0; g < 4; ++g) {
                    const int dv0 = 32 * w + 8 * g + 4 * h2;
                    const f32x4 gw = *(GLB const f32x4*)(gnw + dv0);
                    const h4 za = zaf[tn][g];
                    h4 ov;
#pragma unroll
                    for (int jj = 0; jj < 4; ++jj) ov[jj] = (f16)(oT[tn][4 * g + jj] * rstd * gw[jj] * (float)za[jj]);
                    *(GLB h4*)(F.OA() + rs * 2048 + hd * 128 + dv0) = ov;
                }
            }
#pragma unroll
            for (int mp = 0; mp < 2; ++mp) {
                h8 kf[2][4];
#pragma unroll
                for (int ml = 0; ml < 2; ++ml)
#pragma unroll
                    for (int kq = 0; kq < 4; ++kq) {
                        LAS unsigned char* ap = bufp + SC_KD + (16 * kq + 4 * h2 + q4) * SC_KROW + 64 * (2 * mp + ml) + 8 * (4 * blk + p4);
                        const fp16x4_t lo = __builtin_amdgcn_ds_read_tr16_b64_v4f16((LAS fp16x4_t*)ap);
                        const fp16x4_t hi = __builtin_amdgcn_ds_read_tr16_b64_v4f16((LAS fp16x4_t*)(ap + 8 * SC_KROW));
                        kf[ml][kq] = __builtin_shufflevector(__builtin_bit_cast(h4, lo), __builtin_bit_cast(h4, hi), 0, 1, 2, 3, 4, 5, 6, 7);
                    }
#pragma unroll
                for (int i = 0; i < 16; ++i) { S[2 * mp][i] *= gl; S[2 * mp + 1][i] *= gl; }
                SB();
#pragma unroll
                for (int kq = 0; kq < 4; ++kq) { S[2 * mp] = MFMA32(kf[0][kq], VNp[kq >> 1][kq & 1], S[2 * mp]); S[2 * mp + 1] = MFMA32(kf[1][kq], VNp[kq >> 1][kq & 1], S[2 * mp + 1]); }
                SB();
            }
        }
        asm volatile("s_waitcnt lgkmcnt(0)" ::: "memory"); __builtin_amdgcn_s_barrier(); asm volatile("" ::: "memory");
    }
    }
#undef SC_LOAD
#undef SC_STORE
    if (wave < 4) {
        GLB float* so = F.out() + (smp ? O_NGS : O_NGP) + ((size_t)(l * 16 + b) * 16 + hd) * 16384;
#pragma unroll
        for (int mt = 0; mt < 4; ++mt)
#pragma unroll
            for (int i = 0; i < 16; ++i) so[(32 * mt + (i & 3) + 8 * (i >> 2) + 4 * h2) * 128 + 32 * w + r32] = S[mt][i];
    }
    __syncthreads();
}

template <int NKMAX>
DI void select_rows(GLB const float* scr, GLB unsigned long long* mask, int wave, int lane, int nk, int nvis) {
#pragma unroll 1
    for (int r = 0; r < 4; ++r) {
        const int q = wave * 4 + r;
        unsigned u[NKMAX];
#pragma unroll
        for (int k = 0; k < NKMAX; ++k) u[k] = (k < nk) ? sortable(scr[(size_t)q * LDR + 64 * k + lane]) : 0u;
        unsigned thr = 0u;
        if (nvis > 256) {
#pragma unroll 1
            for (int bit = 31; bit >= 0; --bit) {
                const unsigned cand = thr | (1u << bit);
                int c = 0;
#pragma unroll
                for (int k = 0; k < NKMAX; ++k) c += (int)__popcll(__ballot(u[k] >= cand));
                if (c >= 256) thr = cand;
            }
        }
#pragma unroll
        for (int k = 0; k < NKMAX; ++k) { const unsigned long long bal = __ballot(u[k] >= thr); if (k < nk && lane == 0) mask[q * 65 + k] = bal; }
    }
}

DI void attn_sel_unit(const Frame& F0, int l, int slab, int rs0) {
    const Frame F = F0.fresh();
    const int tid = F.tid, lane = F.lane, wave = F.wave, r32 = lane & 31, h2 = lane >> 5;
    LAS unsigned char* lds = F.lds;
    GLB unsigned long long* mask = (GLB unsigned long long*)(F.ws() + WS_MASK) + (size_t)(rs0 >> 5) * 32 * 65;
    LAS float* wil = (LAS float*)(lds + AT_WI);
    int R0, sq, t0; rowinfo(slab, rs0, R0, sq, t0);
    const bool smp = sq >= 16;
    const int qpos0 = (smp ? PAST : 0) + t0, nvis = 64 * (qpos0 / 64 + 1), nk = nvis >> 6, pb = posbase(sq);
    GLB float* scr = (GLB float*)(F.ws() + WS_SCR) + (size_t)F.bid * 32 * LDR;
    GLB const f16* PROJ = F.PROJ();
#pragma unroll
    for (int it = 0; it < 8; ++it) { const int i = tid + NTHR * it, row = i >> 7, c8 = (i & 127) * 8;
        *(LAS h8*)(lds + AT_QI + (row * AT_QIS + c8) * 2) = *(GLB const h8*)(PROJ + (size_t)(rs0 + row) * PS + C_QI + c8); }
    wil[tid] = F.WI()[(size_t)(R0 + (tid >> 4)) * 16 + (tid & 15)];
    __syncthreads();
    {
    {
        GLB const f16* KI = F.KIU();
#pragma unroll 1
        for (int pp = wave; pp < ((PROBE_REP & 512) ? 2 * nk : nk); pp += 8) { const int p = pp >= nk ? pp - nk : pp;
            h8 a[2][4];
#pragma unroll
            for (int tl = 0; tl < 2; ++tl)
#pragma unroll
                for (int s = 0; s < 4; ++s) a[tl][s] = *(GLB const h8*)(KI + (size_t)(pb + 64 * p + 32 * tl + r32) * 64 + 16 * s + 8 * h2);
            f32x16 sc0, sc1;
#pragma unroll
            for (int i = 0; i < 16; ++i) { sc0[i] = 0.f; sc1[i] = 0.f; }
#pragma unroll 2
            for (int h = 0; h < 16; ++h) {
                h8 b[4];
#pragma unroll
                for (int s = 0; s < 4; ++s) b[s] = *(const LAS h8*)(lds + AT_QI + (r32 * AT_QIS + h * 64 + 16 * s + 8 * h2) * 2);
                f32x16 c0, c1;
#pragma unroll
                for (int i = 0; i < 16; ++i) { c0[i] = 0.f; c1[i] = 0.f; }
#pragma unroll
                for (int s = 0; s < 4; ++s) { c0 = MFMA32(a[0][s], b[s], c0); c1 = MFMA32(a[1][s], b[s], c1); }
                const float w = wil[r32 * 16 + h];
#pragma unroll
                for (int i = 0; i < 16; ++i) { sc0[i] += w * fmaxf(c0[i], 0.f); sc1[i] += w * fmaxf(c1[i], 0.f); }
            }
            GLB float* o = scr + (size_t)r32 * LDR + 64 * p + 4 * h2;
#pragma unroll
            for (int g = 0; g < 4; ++g) { *(GLB f32x4*)(o + 8 * g) = (f32x4){sc0[4 * g], sc0[4 * g + 1], sc0[4 * g + 2], sc0[4 * g + 3]};
                                          *(GLB f32x4*)(o + 32 + 8 * g) = (f32x4){sc1[4 * g], sc1[4 * g + 1], sc1[4 * g + 2], sc1[4 * g + 3]}; }
        }
    }
    asm volatile("s_waitcnt vmcnt(0)" ::: "memory");
    __syncthreads();
    __builtin_amdgcn_fence(__ATOMIC_ACQUIRE, "agent");
    { int lane2 = lane; asm volatile("" : "+v"(lane2));
      if (smp) select_rows<65>(scr, mask, wave, lane2, nk, nvis); else select_rows<32>(scr, mask, wave, lane2, nk, nvis); }
    __syncthreads();
    }
}
DI void attn_pv_unit(const Frame& F0, int l, int slab, int rs0, int n) {
    const Frame F = F0.fresh();
    const int tid = F.tid, lane = F.lane, wave = F.wave, r32 = lane & 31, h2 = lane >> 5;
    LAS unsigned char* lds = F.lds;
    LAS unsigned long long* mask = (LAS unsigned long long*)(lds + AT_MASK);
    LAS float* bt = (LAS float*)(lds + AT_BT);
    int R0, sq, t0; rowinfo(slab, rs0, R0, sq, t0);
    const bool smp = sq >= 16;
    const int qpos0 = (smp ? PAST : 0) + t0, nk = qpos0 / 64 + 1, pb = posbase(sq);
    GLB const f16* PROJ = F.PROJ();
    {
        GLB const unsigned long long* mg = (GLB const unsigned long long*)(F.ws() + WS_MASK) + (size_t)(rs0 >> 5) * 32 * 65;
        for (int i = tid; i < 32 * nk; i += NTHR) { const int q = i / nk, k = i - q * nk; mask[q * 65 + k] = mg[q * 65 + k]; }
        GLB const float* rb = F.in(I_RELB);
        for (int i = tid; i < 8 * 192; i += NTHR) { const int h = i / 192, rel = (i % 192) - 128; bt[(8 * n + h) * 192 + (i % 192)] = rb[rel_bucket(rel) * 16 + 8 * n + h] * LOG2E; }
    }
    __syncthreads();
    GLB const f16* KU = F.KU(); GLB const f16* VU = F.VU();
    const int i16 = lane & 15, q4 = i16 >> 2, p4 = i16 & 3, blk = (lane >> 4) & 1;
    {
        const int hq = 8 * n + wave;
        h8 qf[8];
#pragma unroll
        for (int s = 0; s < 8; ++s) qf[s] = *(GLB const h8*)(PROJ + (size_t)(rs0 + r32) * PS + C_QB + hq * 128 + 16 * s + 8 * h2);
        const float b15 = bt[hq * 192];
        f32x16 O[4];
#pragma unroll
        for (int mt = 0; mt < 4; ++mt)
#pragma unroll
            for (int i = 0; i < 16; ++i) O[mt][i] = 0.f;
        float m = -1e30f, lsum = 0.f;
        u32x4 kreg[2], vreg[2];
        const int srow = tid >> 4, sc8 = (tid & 15) * 8;
#define AT_LOAD(j) do { _Pragma("unroll") for (int it = 0; it < 2; ++it) { const size_t go = (size_t)(pb + 64 * (j) + srow + 32 * it) * 256 + n * 128 + sc8; \
            kreg[it] = *(GLB const u32x4*)(KU + go); vreg[it] = *(GLB const u32x4*)(VU + go); } } while (0)
#define AT_STORE(b) do { _Pragma("unroll") for (int it = 0; it < 2; ++it) { const int lo = AT_KV + (b) * AT_BUF + (srow + 32 * it) * AT_ROW + sc8 * 2; \
            *(LAS u32x4*)(lds + lo) = kreg[it]; *(LAS u32x4*)(lds + AT_KV + (b) * AT_BUF + AT_V + (srow + 32 * it) * AT_VROW + sc8 * 2) = vreg[it]; } } while (0)
        const bool grpB = wave >= 4;
        AT_LOAD(0); AT_STORE(0);
        if (grpB && nk > 1) AT_LOAD(1);
            asm volatile("s_waitcnt lgkmcnt(0)" ::: "memory"); __builtin_amdgcn_s_barrier(); asm volatile("" ::: "memory");
        if (grpB) {
            asm volatile("s_waitcnt lgkmcnt(0)" ::: "memory"); __builtin_amdgcn_s_barrier(); asm volatile("" ::: "memory");
        }
#pragma unroll 1
        for (int j = 0; j < nk; ++j) {
            const bool more = (j + 1) < nk;
            if (!grpB && more) AT_LOAD(j + 1);
            LAS unsigned char* kb = lds + AT_KV + (j & 1) * AT_BUF;
            LAS unsigned char* vb = kb + AT_V;
            f32x16 st[2];
#pragma unroll 1
            for (int prb_ = 0; prb_ < ((PROBE_REP & 2048) ? 2 : 1); ++prb_)
#pragma unroll
            for (int sub = 0; sub < 2; ++sub) {
                h8 ka[8];
#pragma unroll
                for (int s = 0; s < 8; ++s) ka[s] = *(const LAS h8*)(kb + (32 * sub + r32) * AT_ROW + 32 * s + 16 * h2);
                f32x16 c0;
#pragma unroll
                for (int i = 0; i < 16; ++i) c0[i] = 0.f;
                SB(); PRIO(1);
#pragma unroll
                for (int s = 0; s < 8; ++s) c0 = MFMA32(ka[s], qf[s], c0);
                PRIO(0); SB();
                st[sub] = c0;
            }
            const bool far = (64 * j + 63 - qpos0) <= -128;
            float mx = -1e30f;
            if (far) {
#pragma unroll
                for (int sub = 0; sub < 2; ++sub)
#pragma unroll
                    for (int i = 0; i < 16; ++i) { st[sub][i] = st[sub][i] * SCL2 + b15; mx = fmaxf(mx, st[sub][i]); }
            } else {
                const int relb = 64 * j + 4 * h2 - (qpos0 + r32) + 128;
#pragma unroll
                for (int sub = 0; sub < 2; ++sub)
#pragma unroll
                    for (int i = 0; i < 16; ++i) { int ri = relb + 32 * sub + (i & 3) + 8 * (i >> 2); ri = ri < 0 ? 0 : ri;
                        st[sub][i] = st[sub][i] * SCL2 + bt[hq * 192 + ri]; mx = fmaxf(mx, st[sub][i]); }
            }
            mx = fmaxf(mx, shx32(mx, lane));
            const float mnew = fmaxf(m, mx), alpha = __builtin_amdgcn_exp2f(m - mnew);
            m = mnew;
            lsum *= alpha;
            if (__any(alpha != 1.0f)) {
#pragma unroll
                for (int mt = 0; mt < 4; ++mt)
#pragma unroll
                    for (int i = 0; i < 16; ++i) O[mt][i] *= alpha;
            }
            if (grpB && more) AT_STORE((j + 1) & 1);
            asm volatile("s_waitcnt lgkmcnt(0)" ::: "memory"); __builtin_amdgcn_s_barrier(); asm volatile("" ::: "memory");
            if (grpB && (j + 2) < nk) AT_LOAD(j + 2);
            const unsigned long long mw = mask[r32 * 65 + j];
            float ps = 0.f;
            h8 pf[2][2];
#pragma unroll
            for (int sub = 0; sub < 2; ++sub) {
                const unsigned wsh = ((unsigned)(mw >> (32 * sub))) >> (4 * h2);
#pragma unroll
                for (int i = 0; i < 16; ++i) { const float e = __builtin_amdgcn_exp2f(st[sub][i] - mnew);
                    const float pv = (wsh & (1u << ((i & 3) + 8 * (i >> 2)))) ? e : 0.f; st[sub][i] = pv; ps += pv; }
#pragma unroll
                for (int ks = 0; ks < 2; ++ks) { h8 t;
#pragma unroll
                    for (int jj = 0; jj < 8; ++jj) t[jj] = (f16)st[sub][8 * ks + jj];
                    pf[sub][ks] = t; }
            }
            lsum += ps;
#pragma unroll 1
            for (int prb_ = (PROBE_REP & 4096) ? 0 : 1; prb_ < 2; ++prb_) {
            h8 pu[2][2];
            { float zr = prb_ ? 1.0f : 0.0f; asm volatile("" : "+v"(zr));
#pragma unroll
              for (int a_ = 0; a_ < 2; ++a_)
#pragma unroll
                for (int b_ = 0; b_ < 2; ++b_) { h8 t = pf[a_][b_];
                    if (PROBE_REP & 4096) {
#pragma unroll
                        for (int jj = 0; jj < 8; ++jj) t[jj] = (f16)((float)t[jj] * zr); }
                    pu[a_][b_] = t; } }
#pragma unroll
            for (int mp = 0; mp < 2; ++mp) {
                h8 va[2][4];
#pragma unroll
                for (int ml = 0; ml < 2; ++ml)
#pragma unroll
                    for (int sub = 0; sub < 2; ++sub)
#pragma unroll
                        for (int ks = 0; ks < 2; ++ks) {
                            LAS unsigned char* ap = vb + (32 * sub + 16 * ks + 4 * h2 + q4) * AT_VROW + 64 * (2 * mp + ml) + 8 * (4 * blk + p4);
                            const fp16x4_t lo = __builtin_amdgcn_ds_read_tr16_b64_v4f16((LAS fp16x4_t*)ap);
                            const fp16x4_t hi = __builtin_amdgcn_ds_read_tr16_b64_v4f16((LAS fp16x4_t*)(ap + 8 * AT_VROW));
                            va[ml][sub * 2 + ks] = __builtin_shufflevector(__builtin_bit_cast(h4, lo), __builtin_bit_cast(h4, hi), 0, 1, 2, 3, 4, 5, 6, 7);
                        }
                SB(); PRIO(1);
#pragma unroll
                for (int kk = 0; kk < 4; ++kk) { O[2 * mp] = MFMA32(va[0][kk], pu[kk >> 1][kk & 1], O[2 * mp]); O[2 * mp + 1] = MFMA32(va[1][kk], pu[kk >> 1][kk & 1], O[2 * mp + 1]); }
                PRIO(0); SB();
            }
            }
            if (!grpB && more) AT_STORE((j + 1) & 1);
            asm volatile("s_waitcnt lgkmcnt(0)" ::: "memory"); __builtin_amdgcn_s_barrier(); asm volatile("" ::: "memory");
        }
        if (!grpB) {
            asm volatile("s_waitcnt lgkmcnt(0)" ::: "memory"); __builtin_amdgcn_s_barrier(); asm volatile("" ::: "memory");
        }
#undef AT_LOAD
#undef AT_STORE
        const float ltot = lsum + shx32(lsum, lane), inv = 1.0f / ltot;
        const size_t orow = (size_t)(rs0 + r32);
#pragma unroll
        for (int mt = 0; mt < 4; ++mt)
#pragma unroll
            for (int g = 0; g < 4; ++g) {
                const int d = hq * 128 + 32 * mt + 8 * g + 4 * h2;
                const h4 zb = *(GLB const h4*)(PROJ + orow * PS + C_ZB + d);
                h4 ov;
#pragma unroll
                for (int jj = 0; jj < 4; ++jj) ov[jj] = (f16)(O[mt][4 * g + jj] * inv * (float)zb[jj]);
                *(GLB h4*)(F.OB() + orow * 2048 + d) = ov;
            }
    }
    __syncthreads();
}

DI void phase_mix(const Frame F0, int l, int slab, int rep = 0) {
    const Frame F = F0.fresh();
    LAS int* ubox = (LAS int*)(F.lds + LDS_MISC + 64);
    const int xcc = (int)(xb_xcc_id() & 7u);
    const int nsc = 8 + (slab == 0 ? 32 : 0), nsb = slab == 0 ? 8 : 0, total = nsc + nsb + 64;
#pragma unroll 1
    for (int qq = 0; qq < 8; ++qq) {
        const int q = (xcc + qq) & 7;
        unsigned* ctr = F.ctl() + CW_Q + ((rep * 8 + l * NSLAB + slab) * 8 + q) * 64;
        for (;;) {
            if (F.tid == 0) ubox[0] = (int)__hip_atomic_fetch_add(ctr, 1u, __ATOMIC_RELAXED, __HIP_MEMORY_SCOPE_AGENT);
            __syncthreads();
            const int u = ubox[0];
            __syncthreads();
            if (u >= total) break;
            if (u < 8) { const int cu = u * 8 + q; gdn_scan_unit(F, l, slab, slab * 4 + (cu >> 4), cu & 15);
                if (PROBE_REP & 256) gdn_scan_unit(F, l, slab, slab * 4 + (cu >> 4), cu & 15); }
            else if (u < nsc) { const int v = (u - 8) * 8 + q; gdn_scan_unit(F, l, slab, 16 + (v >> 4), v & 15); }
            else if (u < nsc + nsb) { const int w = u - nsc; attn_pv_unit(F, l, slab, 8192 + 32 * ((w >> 1) * 8 + q), w & 1); }
            else { const int k = u - nsc - nsb; attn_pv_unit(F, l, slab, (q & 3) * 2048 + (63 - (2 * (k >> 1) + (q >> 2))) * 32, k & 1); }
        }
    }
}
DI void phase_pre(const Frame F0, int l, int slab, int rep = 0) {
    const Frame F = F0.fresh();
    LAS int* ubox = (LAS int*)(F.lds + LDS_MISC + 64);
    unsigned* ctr = F.ctl() + CW_Q + (128 + rep * 8 + l * NSLAB + slab) * 64;
    const int nsel = ts_of(slab) / 32, nc = slab == 0 ? 144 : 128, total = nsel + nc * 16;
    for (;;) {
        if (F.tid == 0) ubox[0] = (int)__hip_atomic_fetch_add(ctr, 1u, __ATOMIC_RELAXED, __HIP_MEMORY_SCOPE_AGENT);
        __syncthreads();
        const int u = ubox[0];
        __syncthreads();
        if (u >= total) break;
        if (u < nsel) {
            int q = u, rs0;
            if (slab == 0 && q < 32) rs0 = 8192 + 32 * q;
            else { if (slab == 0) q -= 32; rs0 = (q & 3) * 2048 + (63 - (q >> 2)) * 32; }
            attn_sel_unit(F, l, slab, rs0);
        } else { const int v = u - nsel; gdn_pre_unit(F, l, slab, v >> 4, v & 15); }
    }
}
DI void phase_final(const Frame F0) {
    const Frame F = F0.fresh();
    GLB const float* nw = F.in(I_FNW);
    for (int R = F.bid * NWAVES + F.wave; R < NTOK; R += F.G * NWAVES) {
        GLB float* x = F.out() + (size_t)R * D;
        f32x4 v[8]; float ss = 0.f;
#pragma unroll
        for (int i = 0; i < 8; ++i) { v[i] = *(GLB const f32x4*)(x + (i * 64 + F.lane) * 4); ss += v[i][0] * v[i][0] + v[i][1] * v[i][1] + v[i][2] * v[i][2] + v[i][3] * v[i][3]; }
        ss = wave_sum(ss, F.lane);
        const float r = rsqrtf(ss * (1.0f / 2048.0f) + EPS);
#pragma unroll
        for (int i = 0; i < 8; ++i) { const int c = (i * 64 + F.lane) * 4; *(GLB f32x4*)(x + c) = v[i] * r * *(GLB const f32x4*)(nw + c); }
    }
}

DI void phase_inproj(const Frame F, int l, int s) {
    const int Ts = ts_of(s);
    pg8::Gemm g{F.H(), F.WIN() + (size_t)l * NP * 2048, F.H(), F.WIN() + (size_t)l * NP * 2048, Ts, NP, 2048};
    pg8::StaticOrder S; S.init(Ts, NP, F.G, F.bid);
    EpiProj E{F.PROJ(), F.out(), F.KU(), F.VU(), F.KIU(), F.WI(), F.BETA(), F.GG(), F.in(I_ALOG) + l * 16, F.in(I_DTB) + l * 16, l, s};
    pg8::gemm_phase<EpiProj, pg8::StaticOrder>(F.lds, g, S, E, F.wave);
}
DI void phase_ab(const Frame F, int l, int s) {
    const int Ts = ts_of(s);
    pg8::Gemm g{F.OA(), F.WA() + (size_t)l * 2048 * 2048, F.OB(), F.WB() + (size_t)l * 2048 * 2048, Ts, 2048, 2048};
    pg8::DualOrder S; S.init(Ts, 2048, F.G, F.bid);
    EpiAB E{F.PROJ(), F.H()};
    pg8::gemm_phase<EpiAB, pg8::DualOrder>(F.lds, g, S, E, F.wave);
}
DI void phase_outp(const Frame F, int l, int s) {
    const int Ts = ts_of(s);
    pg8::Gemm g{F.H(), F.WO() + (size_t)l * 2048 * 2048, F.H(), F.WO() + (size_t)l * 2048 * 2048, Ts, 2048, 2048};
    pg8::StaticOrder S; S.init(Ts, 2048, F.G, F.bid);
    EpiOut E{F.in(I_XP), F.in(I_XS), F.out(), F.ADA() + (size_t)l * 32 * 6144, l, s};
    pg8::gemm_phase<EpiOut, pg8::StaticOrder>(F.lds, g, S, E, F.wave);
}
constexpr int NPH = 6;
constexpr int N_PHASES = 1 + 2 * NSLAB * NPH + 1;
__global__ void __launch_bounds__(NTHR, 2) fwd_kernel(Args args) {
    extern __shared__ __attribute__((aligned(16))) unsigned char lds[];
    Frame F;
    F.lds = (LAS unsigned char*)lds;
    F.tid = threadIdx.x; F.lane = F.tid & 63; F.wave = __builtin_amdgcn_readfirstlane(F.tid >> 6); F.G = gridDim.x; F.bid = blockIdx.x;
    if (F.tid < 22) *(LAS unsigned long long*)(F.lds + LDS_TAB + 8 * F.tid) = (unsigned long long)args.in[F.tid];
    if (F.tid == 22) *(LAS unsigned long long*)(F.lds + LDS_TAB + 8 * 22) = (unsigned long long)args.out;
    if (F.tid == 23) *(LAS unsigned long long*)(F.lds + LDS_TAB + 8 * 23) = (unsigned long long)args.ws;
    volatile LAS unsigned* MISC = (volatile LAS unsigned*)(F.lds + LDS_MISC);
    if (F.tid < 64) MISC[F.tid] = 0u;
    __syncthreads();
    const int lo = args.ph_lo, hi = args.ph_hi;
    const bool multi = (hi - lo) > 1;
    if (multi) (void)xcd_barrier_post(F.ctl() + CW_BAR, MISC);
#define IN(k) (lo <= (k) && (k) < hi)
#define GBAR() do { XcdBarrier bar_; bar_.bar = F.ctl() + CW_BAR; bar_.x = xb_xcc_id(); bar_.st = MISC; xcd_barrier(bar_, (int)(lane_id_fresh() == 0 && F.wave == 0)); } while (0)
#define SEAM(k) do { if (IN(k) && IN((k) + 1)) { XcdBarrier bar_; bar_.bar = F.ctl() + CW_BAR; bar_.x = xb_xcc_id(); bar_.st = MISC; xcd_barrier(bar_, (int)(lane_id_fresh() == 0 && F.wave == 0)); } } while (0)
    if (IN(0)) { p0_prologue(F); if (PROBE_REP & 64) { GBAR(); p0_prologue(F); } }
    SEAM(0);
    for (int l = 0; l < 2; ++l)
        for (int s = 0; s < NSLAB; ++s) {
            const int pb = 1 + (l * NSLAB + s) * NPH;
            if (IN(pb)) { phase_norm(F, l, s); if (PROBE_REP & 1) { GBAR(); phase_norm(F, l, s); } }
            SEAM(pb);
            if (IN(pb + 1)) { phase_inproj(F, l, s); if (PROBE_REP & 2) { GBAR(); phase_inproj(F, l, s); } }
            SEAM(pb + 1);
            if (IN(pb + 2)) { phase_pre(F, l, s); if (PROBE_REP & 4) { GBAR(); phase_pre(F, l, s, 1); } }
            SEAM(pb + 2);
            if (IN(pb + 3)) { phase_mix(F, l, s); if (PROBE_REP & 8) { GBAR(); phase_mix(F, l, s, 1); } }
            SEAM(pb + 3);
            if (IN(pb + 4)) { phase_ab(F, l, s); if (PROBE_REP & 16) { GBAR(); phase_ab(F, l, s); } }
            SEAM(pb + 4);
            if (IN(pb + 5)) { phase_outp(F, l, s); if (PROBE_REP & 32) { GBAR(); phase_outp(F, l, s); } }
            SEAM(pb + 5);
        }
    if (IN(N_PHASES - 1)) phase_final(F);
#undef IN
#undef SEAM
}

extern "C" void kernel_launch(void* const* d_in, const int* in_sizes, int n_in, void* d_out, int out_size, void* d_ws, size_t ws_size, hipStream_t stream) {
    static int grid = 0;
    if (grid == 0) {
        if (n_in != 22 || (size_t)out_size != O_END || ws_size < WS_END) { fprintf(stderr, "kernel_launch: unexpected shapes (n_in %d out %d ws %zu, need %zu)\n", n_in, out_size, ws_size, (size_t)WS_END); grid = -1; return; }
        int dev = 0, cus = 0, per_cu = 0;
        if (hipGetDevice(&dev) != hipSuccess || hipDeviceGetAttribute(&cus, hipDeviceAttributeMultiprocessorCount, dev) != hipSuccess) { grid = -1; return; }
        if (hipFuncSetAttribute((const void*)fwd_kernel, hipFuncAttributeMaxDynamicSharedMemorySize, LDS_BYTES) != hipSuccess) { fprintf(stderr, "kernel_launch: hipFuncSetAttribute failed\n"); grid = -1; return; }
        if (hipOccupancyMaxActiveBlocksPerMultiprocessor(&per_cu, (const void*)fwd_kernel, NTHR, LDS_BYTES) != hipSuccess || per_cu < 1) { fprintf(stderr, "kernel_launch: occupancy query says %d\n", per_cu); }
        (void)hipGetLastError();
        grid = cus;
    }
    if (grid < 0) return;
    (void)hipMemsetAsync((char*)d_ws + WS_CTL, 0, CTL_BYTES, stream);
    Args a{};
    for (int i = 0; i < 22; ++i) a.in[i] = (const float*)d_in[i];
    a.out = (float*)d_out; a.ws = (unsigned char*)d_ws;
#if MK_ONE_LAUNCH
    a.ph_lo = 0; a.ph_hi = N_PHASES;
    hipLaunchKernelGGL(fwd_kernel, dim3(grid), dim3(NTHR), LDS_BYTES, stream, a);
#else
    for (int p = 0; p < N_PHASES; ++p) { a.ph_lo = p; a.ph_hi = p + 1; hipLaunchKernelGGL(fwd_kernel, dim3(grid), dim3(NTHR), LDS_BYTES, stream, a); }
#endif
}
```

```cpp
#include <hip/hip_runtime.h>
#include <cstdio>
#include <cstdint>

#ifndef PROBE_REP
#define PROBE_REP 0
#endif
#ifndef PROBE_T
#define PROBE_T 0
#endif
#ifndef SELCHK
#define SELCHK 0
#endif
#ifndef MK_ONE_LAUNCH
#define MK_ONE_LAUNCH 1
#endif

#define LAS __attribute__((address_space(3)))
#define GLB __attribute__((address_space(1)))
typedef _Float16 f16;
typedef _Float16 h8 __attribute__((ext_vector_type(8)));
typedef _Float16 h4 __attribute__((ext_vector_type(4)));
typedef _Float16 h2 __attribute__((ext_vector_type(2)));
typedef float f32x4 __attribute__((ext_vector_type(4)));
typedef float f32x2 __attribute__((ext_vector_type(2)));
typedef unsigned u32x4 __attribute__((ext_vector_type(4)));
typedef unsigned u32x2 __attribute__((ext_vector_type(2)));
#define DI __device__ __forceinline__

constexpr int D = 2048, NTOKP = 32768, NTOKS = 1024, NTOK = NTOKP + NTOKS;
constexpr int IN_DIM = 18032, NP = 18176, PS = 17408;
constexpr int LSMP = 4160, PAST = 4096;
constexpr int NSLAB = 4, NWAVES = 8, NTHR = 512;
constexpr int C_QKV = 0, C_ZA = 6144, C_QB = 8192, C_ZB = 10240, C_QI = 12288, C_GA = 13312, C_GB = 15360;
constexpr float EPS = 1e-6f;
constexpr int NPOS = 16 * 2048 + 16 * LSMP;

constexpr size_t O_YP = 0, O_YS = O_YP + (size_t)NTOKP * D, O_NKP = O_YS + (size_t)NTOKS * D, O_NVP = O_NKP + (size_t)2 * 16 * 2048 * 256,
    O_NIP = O_NVP + (size_t)2 * 16 * 2048 * 256, O_NGP = O_NIP + (size_t)2 * 16 * 2048 * 64, O_NCP = O_NGP + (size_t)2 * 16 * 16 * 16384,
    O_NKS = O_NCP + (size_t)2 * 16 * 3 * 6144, O_NVS = O_NKS + (size_t)2 * 16 * 64 * 256, O_NIS = O_NVS + (size_t)2 * 16 * 64 * 256,
    O_NGS = O_NIS + (size_t)2 * 16 * 64 * 64, O_NCS = O_NGS + (size_t)2 * 16 * 16 * 16384, O_END = O_NCS + (size_t)2 * 16 * 3 * 6144;
static_assert(O_END == 126091264ull, "output size");

constexpr size_t al256(size_t x) { return (x + 255) & ~(size_t)255; }
constexpr size_t WS_CTL = 0, CTL_BYTES = 1u << 20;
constexpr size_t WS_ADA = WS_CTL + CTL_BYTES;
constexpr size_t WS_WIN = al256(WS_ADA + (size_t)2 * 32 * 6144 * 4);
constexpr size_t WS_WA = al256(WS_WIN + (size_t)2 * NP * 2048 * 2);
constexpr size_t WS_WB = al256(WS_WA + (size_t)2 * 2048 * 2048 * 2);
constexpr size_t WS_WO = al256(WS_WB + (size_t)2 * 2048 * 2048 * 2);
constexpr size_t WS_H = al256(WS_WO + (size_t)2 * 2048 * 2048 * 2);
constexpr size_t WS_PROJ = al256(WS_H + (size_t)9216 * 2048 * 2);
constexpr size_t WS_OA = al256(WS_PROJ + (size_t)9216 * PS * 2);
constexpr size_t WS_OB = al256(WS_OA + (size_t)9216 * 2048 * 2);
constexpr size_t WS_KU = al256(WS_OB + (size_t)9216 * 2048 * 2);
constexpr size_t WS_VU = al256(WS_KU + (size_t)NPOS * 256 * 2);
constexpr size_t WS_KIU = al256(WS_VU + (size_t)NPOS * 256 * 2);
constexpr size_t WS_WI = al256(WS_KIU + (size_t)NPOS * 64 * 2);
constexpr size_t WS_BETA = al256(WS_WI + (size_t)NTOK * 16 * 4);
constexpr size_t WS_G = al256(WS_BETA + (size_t)NTOK * 16 * 4);
constexpr int LDR = 4160;
constexpr size_t WS_SCR = al256(WS_G + (size_t)NTOK * 16 * 4);
constexpr int GP_W = 0, GP_QD = 16384, GP_KD = 32768, GP_U = 49152, GP_QK = 65536, GP_STRIDE = 73728;
constexpr size_t WS_GP = al256(WS_SCR + (size_t)256 * 32 * LDR * 4);
constexpr size_t WS_GL = al256(WS_GP + (size_t)144 * 16 * GP_STRIDE);
constexpr size_t WS_MASK = al256(WS_GL + (size_t)144 * 16 * 4);
constexpr size_t WS_MG = al256(WS_MASK + (size_t)288 * 32 * 65 * 8);
constexpr size_t WS_H2 = al256(WS_MG + (size_t)9216 * 2048 * 2);
constexpr size_t WS_END = al256(WS_H2 + (size_t)9216 * 2048 * 2);

constexpr int LDS_BYTES = 147456, LDS_MISC = 131072;

#define XB_TMO      128
#define XB_XCNT(j)  (256  + 64 * (j))
#define XB_XSUB(j)  (1280 + 64 * (j))
#define XB_XGEN(j)  (2304 + 64 * (j))
#define XB_TOP      3328
#define XB_TOPGEN   3392
#define XCD_BAR_WORDS 3456
#define XB_SPIN_CAP (1u << 18)
__device__ __forceinline__ unsigned xb_ld(unsigned* p)              { return __hip_atomic_load(p, __ATOMIC_RELAXED, __HIP_MEMORY_SCOPE_AGENT); }
__device__ __forceinline__ unsigned xb_add(unsigned* p, unsigned v) { return __hip_atomic_fetch_add(p, v, __ATOMIC_RELAXED, __HIP_MEMORY_SCOPE_AGENT); }
__device__ __forceinline__ unsigned xb_xcc_id() { return (unsigned)__builtin_amdgcn_s_getreg((3 << 11) | 20) & 0xFu; }
#define XB_SPIN(cond, bar) do { unsigned _sp = 0; while (cond) { __builtin_amdgcn_s_sleep(1); \
    if ((++_sp & 255u) == 0u) { if (xb_ld(&(bar)[XB_TMO])) break; if (_sp > XB_SPIN_CAP) { atomicAdd(&(bar)[XB_TMO], 1u); break; } } } } while (0)
struct XcdBarrier { unsigned* bar; unsigned x; volatile LAS unsigned* st; };
__device__ __forceinline__ XcdBarrier xcd_barrier_post(unsigned* bar, volatile LAS unsigned* st) {
    XcdBarrier b; b.bar = bar; b.x = xb_xcc_id(); b.st = st;
    if (threadIdx.x == 0) (void)xb_add(&bar[XB_XCNT(b.x)], 1u);
    return b;
}
__device__ __forceinline__ void xcd_barrier_complete(unsigned* bar, unsigned x, unsigned& nloc, unsigned& nx) {
    const unsigned G = gridDim.x * gridDim.y * gridDim.z;
    unsigned sum, cnt, mine, sp = 0u;
    for (;;) {
        sum = 0u; cnt = 0u; mine = 0u;
#pragma unroll
        for (unsigned j = 0; j < 16; ++j) { const unsigned c = xb_ld(&bar[XB_XCNT(j)]); sum += c; cnt += (c > 0u) ? 1u : 0u; mine = (j == x) ? c : mine; }
        if (sum == G) break;
        __builtin_amdgcn_s_sleep(1);
        if ((++sp & 255u) == 0u) { if (xb_ld(&bar[XB_TMO])) break; if (sp > XB_SPIN_CAP) { atomicAdd(&bar[XB_TMO], 1u); break; } }
    }
    nloc = mine > 0u ? mine : 1u; nx = cnt > 0u ? cnt : 1u;
}
__device__ __forceinline__ void xcd_barrier(const XcdBarrier b, const int leader) {
    asm volatile("s_waitcnt vmcnt(0)" ::: "memory");
    __syncthreads();
    if (leader) {
        unsigned* bar = b.bar;
        __builtin_amdgcn_s_waitcnt(0);
        unsigned nloc = b.st[0], nx = b.st[1];
        if (nloc == 0u) { xcd_barrier_complete(bar, b.x, nloc, nx); b.st[0] = nloc; b.st[1] = nx; }
        const unsigned old = xb_add(&bar[XB_XSUB(b.x)], 1u);
        const unsigned gen = old / nloc;
        if (old + 1u == (gen + 1u) * nloc) {
            __builtin_amdgcn_fence(__ATOMIC_RELEASE, "agent");
            asm volatile("s_waitcnt vmcnt(0)" ::: "memory");
            const unsigned og = xb_add(&bar[XB_TOP], 1u);
            const unsigned tg = og / nx;
            if (og + 1u == (tg + 1u) * nx) xb_add(&bar[XB_TOPGEN], 1u);
            else XB_SPIN(xb_ld(&bar[XB_TOPGEN]) == tg, bar);
            __builtin_amdgcn_fence(__ATOMIC_ACQUIRE, "agent");
            xb_add(&bar[XB_XGEN(b.x)], 1u);
            asm volatile("s_waitcnt vmcnt(0)" ::: "memory");
        } else {
            XB_SPIN(xb_ld(&bar[XB_XGEN(b.x)]) == gen, bar);
            __builtin_amdgcn_fence(__ATOMIC_ACQUIRE, "agent");
            asm volatile("s_waitcnt vmcnt(0)" ::: "memory");
        }
    }
    __syncthreads();
}

DI int lane_id_fresh() { unsigned z = 0u; asm volatile("" : "+v"(z)); return (int)__builtin_amdgcn_mbcnt_hi(~0u, __builtin_amdgcn_mbcnt_lo(~0u, z)); }
template <int O> DI float swz_xor(float v) { return __builtin_bit_cast(float, __builtin_amdgcn_ds_swizzle(__builtin_bit_cast(int, v), (O << 10) | 0x1F)); }
DI float shx32(float v, int lane) { return __builtin_bit_cast(float, __builtin_amdgcn_ds_bpermute((lane ^ 32) << 2, __builtin_bit_cast(int, v))); }
DI float wave_sum(float v, int lane) {
    v += swz_xor<1>(v); v += swz_xor<2>(v); v += swz_xor<4>(v); v += swz_xor<8>(v); v += swz_xor<16>(v);
    return v + shx32(v, lane);
}
DI float sigmoidf_(float x) { return __builtin_amdgcn_rcpf(1.0f + __expf(-x)); }
DI float siluf_(float x) { return x * __builtin_amdgcn_rcpf(1.0f + __expf(-x)); }
DI unsigned pk_f16(float lo, float hi) { h2 v = {(f16)lo, (f16)hi}; return __builtin_bit_cast(unsigned, v); }
DI void rowinfo(int slab, int rs, int& R, int& sq, int& t) {
    if (rs < 8192) { R = slab * 8192 + rs; sq = R >> 11; t = R & 2047; }
    else { const int q = rs - 8192; R = NTOKP + q; sq = 16 + (q >> 6); t = q & 63; }
}
DI int posbase(int sq) { return sq < 16 ? sq * 2048 : 32768 + (sq - 16) * LSMP; }
__host__ __device__ inline int ts_of(int slab) { return slab == 0 ? 9216 : 8192; }
DI int proj_src_col(int n) {
    if (n < 8192) return n;
    if (n < 10240) return 8224 + (n - 8192);
    if (n < 12288) return 10784 + (n - 10240);
    if (n < 13312) return 12832 + (n - 12288);
    if (n < 15360) return 13936 + (n - 13312);
    if (n < 17408) return 15984 + (n - 15360);
    if (n < 17664) return 10272 + (n - 17408);
    if (n < 17920) return 10528 + (n - 17664);
    const int j = n - 17920;
    if (j < 64) return 13856 + j;
    if (j < 80) return 13920 + (j - 64);
    if (j < 96) return 8192 + (j - 80);
    if (j < 112) return 8208 + (j - 96);
    return -1;
}
DI int rel_bucket(int rel) {
    const int n = rel < 0 ? -rel : rel;
    const int v = n < 8 ? n : (n < 12 ? 8 : n < 16 ? 9 : n < 23 ? 10 : n < 32 ? 11 : n < 46 ? 12 : n < 64 ? 13 : n < 91 ? 14 : 15);
    return (rel > 0 ? 16 : 0) + v;
}

namespace pg8 {
constexpr int BM = 256, BK = 64, HALF = 128, HTB = HALF * BK * 2, STAGE_BYTES = 8 * HTB, NXCD = 8, WGM = 8;
DI int lds_byte(int r, int c) { const int st = (r >> 4) * 2 + (c >> 5), rr = r & 15, cc = c & 31, ob = rr * 64 + cc * 2; return st * 1024 + (ob ^ (((ob >> 9) & 1) << 5)); }
DI void stage_rc(int b, int& R, int& C) { const int st = b / 1024, sb = b % 1024, swz = sb ^ (((sb >> 9) & 1) << 5); R = (st >> 1) * 16 + swz / 64; C = (st & 1) * 32 + (swz % 64) / 2; }
DI int perm32(int rho) { const int n = rho >> 4, i = rho & 15; return 8 * (i >> 2) + 4 * n + (i & 3); }

struct Unit { int pm, pn, which; };
struct Gemm { GLB const f16* A0; GLB const f16* B0; GLB const f16* A1; GLB const f16* B1; int M, N, K; };

struct StaticOrder {
    int nM, nN, nwg, G, c;
    DI void init(int M, int N, int G_, int c_) { nM = M / BM; nN = N / BM; nwg = nM * nN; G = G_; c = c_; }
    DI bool tile(long L, Unit& u) const {
        if (L >= nwg) return false;
        int wgid = (int)L; { const int q = nwg / NXCD, r = nwg % NXCD, xcd = wgid % NXCD, off = wgid / NXCD; wgid = (xcd < r ? xcd * (q + 1) : r * (q + 1) + (xcd - r) * q) + off; }
        const int nig = WGM * nN, gid = wgid / nig, fm = gid * WGM, gsz = (nM - fm) < WGM ? (nM - fm) : WGM;
        u.pm = fm + ((wgid % nig) % gsz); u.pn = (wgid % nig) / gsz; return true;
    }
    DI bool next(int i, Unit& u) const { u.which = 0; return tile((long)i * G + c, u); }
};
struct OneTile { int pm, pn, nu;
    DI bool next(int i, Unit& u) const { if (i >= nu) return false; u.pm = pm; u.pn = pn; u.which = i; return true; } };
struct SubOrder : StaticOrder {
    int part;
    DI void init2(int M, int part_, int G_, int c_) { part = part_; init(M, (part_ == 1 ? 31 : 40) * BM, G_, c_); }
    DI bool next(int i, Unit& u) const { u.which = 0; if (!tile((long)i * G + c, u)) return false; const int p = u.pn;
        u.pn = part == 1 ? (p < 24 ? p : (p < 28 ? 48 + (p - 24) : 68 + (p - 28))) : (p < 24 ? 24 + p : 52 + (p - 24)); return true; }
};
struct DualOrder : StaticOrder {
    DI bool next(int i, Unit& u) const { u.which = i & 1; return tile((long)(i >> 1) * G + c, u); }
};

template <class Epi, class Sched, bool ALIGN_EPI = true>
DI void gemm_phase(LAS unsigned char* lds, const Gemm g, const Sched& S, const Epi& E, int wave_s) {
    int tid_ = lane_id_fresh() + wave_s * 64; asm volatile("" : "+v"(tid_));
    const int tid = tid_, wid = __builtin_amdgcn_readfirstlane(tid >> 6), lane = tid & 63, wr = wid >> 2, wc = wid & 3, fr = lane & 15, fq = lane >> 4;
    const int K = g.K, nt = K / BK;
    unsigned voffA[2], voffB[2];
#pragma unroll
    for (int i = 0; i < 2; ++i) { int R, C; stage_rc(tid * 16 + i * 8192, R, C); const int Rb = (R & ~31) + perm32(R & 31);
        voffA[i] = (unsigned)(R * K + C) * 2u; voffB[i] = (unsigned)(Rb * K + C) * 2u; }
    const size_t kstep = (size_t)(BK * 2);
    const size_t hstep = (size_t)HALF * K * 2;
    const size_t tstep = 2 * hstep;
    const unsigned ldsw = (unsigned)wid * 1024u;
    const int aoff = lds_byte(wr * 64 + fr, fq * 8), boff = lds_byte(wc * 32 + fr, fq * 8);
#define PG8_SA(b, h) (((b) * 2 + (h)) * HTB)
#define PG8_SB(b, h) ((4 + (b) * 2 + (h)) * HTB)
#define PG8_STAGE(bufoff, gbase, voff) do { _Pragma("unroll") for (int _i = 0; _i < 2; ++_i) \
        __builtin_amdgcn_global_load_lds((GLB const unsigned*)((GLB const char*)(gbase) + (voff)[_i]), (LAS unsigned*)(lds + (bufoff) + ldsw + _i * 8192), 16, 0, 0); } while (0)
#define PG8_LDA(dst, b, h) do { _Pragma("unroll") for (int m = 0; m < 4; ++m) _Pragma("unroll") for (int k = 0; k < 2; ++k) dst[m][k] = *(const LAS h8*)(lds + PG8_SA(b, h) + aoff + m * 2048 + k * 1024); } while (0)
#define PG8_LDB(dst, b, h) do { _Pragma("unroll") for (int n = 0; n < 2; ++n) _Pragma("unroll") for (int k = 0; k < 2; ++k) dst[n][k] = *(const LAS h8*)(lds + PG8_SB(b, h) + boff + n * 2048 + k * 1024); } while (0)
#define PG8_MMA(ai, bj, At, Bt) do { __builtin_amdgcn_s_setprio(1); _Pragma("unroll") for (int m = 0; m < 4; ++m) _Pragma("unroll") for (int n = 0; n < 2; ++n) _Pragma("unroll") for (int k = 0; k < 2; ++k) \
        acc[ai][bj][m][n] = __builtin_amdgcn_mfma_f32_16x16x32_f16(Bt[n][k], At[m][k], acc[ai][bj][m][n], 0, 0, 0); __builtin_amdgcn_s_setprio(0); } while (0)
#define PG8_WAIT_V(n) asm volatile("s_waitcnt vmcnt(" #n ")" ::: "memory")
#define PG8_WAIT_L(n) asm volatile("s_waitcnt lgkmcnt(" #n ")" ::: "memory")
#define PG8_BAR __builtin_amdgcn_s_barrier()
#define PG8_SCHED __builtin_amdgcn_sched_barrier(0)
    Unit cur, nxt; int ui = 0;
    if (!S.next(0, cur)) return;
    f32x4 acc[2][2][4][2];
#pragma unroll
    for (int a = 0; a < 2; ++a)
#pragma unroll
        for (int b = 0; b < 2; ++b)
#pragma unroll
            for (int m = 0; m < 4; ++m)
#pragma unroll
                for (int n = 0; n < 2; ++n) acc[a][b][m][n] = (f32x4){0.f, 0.f, 0.f, 0.f};
    h8 At[4][2], B0[2][2], B1[2][2];
    GLB const char* cA = (GLB const char*)(cur.which ? g.A1 : g.A0) + (size_t)cur.pm * tstep; GLB const char* cB = (GLB const char*)(cur.which ? g.B1 : g.B0) + (size_t)cur.pn * tstep;
    PG8_STAGE(PG8_SB(0, 0), cB, voffB); PG8_STAGE(PG8_SB(0, 1), cB + hstep, voffB); PG8_STAGE(PG8_SA(0, 0), cA, voffA); PG8_STAGE(PG8_SA(0, 1), cA + hstep, voffA);
    if (wr == 1) PG8_BAR;
    PG8_WAIT_V(2); PG8_BAR;
    PG8_STAGE(PG8_SB(1, 0), cB + kstep, voffB); PG8_STAGE(PG8_SA(1, 0), cA + kstep, voffA); PG8_STAGE(PG8_SB(1, 1), cB + hstep + kstep, voffB);
    PG8_WAIT_V(6); PG8_BAR;
    for (;;) {
        const bool has_next = S.next(ui + 1, nxt);
        GLB const char* nA = has_next ? (GLB const char*)(nxt.which ? g.A1 : g.A0) + (size_t)nxt.pm * tstep : cA; GLB const char* nB = has_next ? (GLB const char*)(nxt.which ? g.B1 : g.B0) + (size_t)nxt.pn * tstep : cB;
        for (int t = 0; t < nt; t += 2) {
            const bool last = (t == nt - 2);
            GLB const char* a1 = cA + (size_t)(t + 1) * kstep;
            GLB const char* a2 = last ? nA : cA + (size_t)(t + 2) * kstep; GLB const char* b2 = last ? nB : cB + (size_t)(t + 2) * kstep;
            GLB const char* a3 = a2 + kstep; GLB const char* b3 = b2 + kstep;
            PG8_LDB(B0, 0, 0); PG8_LDB(B1, 0, 1); PG8_SCHED; PG8_LDA(At, 0, 0); PG8_STAGE(PG8_SA(1, 1), a1 + hstep, voffA);
            PG8_WAIT_V(8); PG8_WAIT_L(0); PG8_BAR; PG8_MMA(0, 0, At, B0); PG8_MMA(0, 1, At, B1); PG8_BAR; PG8_SCHED;
            PG8_LDA(At, 0, 1); PG8_STAGE(PG8_SB(0, 0), b2, voffB); PG8_STAGE(PG8_SB(0, 1), b2 + hstep, voffB); PG8_STAGE(PG8_SA(0, 0), a2, voffA);
            PG8_WAIT_V(8); PG8_WAIT_L(0); PG8_BAR; PG8_MMA(1, 0, At, B0); PG8_MMA(1, 1, At, B1); PG8_BAR; PG8_SCHED;
            PG8_LDB(B0, 1, 0); PG8_LDB(B1, 1, 1); PG8_SCHED; PG8_LDA(At, 1, 0); PG8_STAGE(PG8_SA(0, 1), a2 + hstep, voffA);
            PG8_WAIT_V(8); PG8_WAIT_L(0); PG8_BAR; PG8_MMA(0, 0, At, B0); PG8_MMA(0, 1, At, B1); PG8_BAR; PG8_SCHED;
            PG8_LDA(At, 1, 1); PG8_STAGE(PG8_SB(1, 0), b3, voffB); PG8_STAGE(PG8_SB(1, 1), b3 + hstep, voffB); PG8_STAGE(PG8_SA(1, 0), a3, voffA);
            PG8_WAIT_V(8); PG8_WAIT_L(0); PG8_BAR; PG8_MMA(1, 0, At, B0); PG8_MMA(1, 1, At, B1); PG8_BAR; PG8_SCHED;
        }
        if constexpr (ALIGN_EPI) { if (wr == 0) PG8_BAR; }
        E(acc, cur, wr, wc, fr, fq);
        if (!has_next) break;
#pragma unroll
        for (int a = 0; a < 2; ++a)
#pragma unroll
            for (int b = 0; b < 2; ++b)
#pragma unroll
                for (int m = 0; m < 4; ++m)
#pragma unroll
                    for (int n = 0; n < 2; ++n) acc[a][b][m][n] = (f32x4){0.f, 0.f, 0.f, 0.f};
        cur = nxt; cA = nA; cB = nB; ++ui;
        if constexpr (ALIGN_EPI) { if (wr == 1) PG8_BAR; }
    }
    PG8_WAIT_V(0);
    if constexpr (!ALIGN_EPI) { if (wr == 0) PG8_BAR; }
    PG8_BAR;
#undef PG8_SA
#undef PG8_SB
#undef PG8_STAGE
#undef PG8_LDA
#undef PG8_LDB
#undef PG8_MMA
#undef PG8_WAIT_V
#undef PG8_WAIT_L
#undef PG8_BAR
#undef PG8_SCHED
}
}

struct Args { const float* in[22]; float* out; unsigned char* ws; int ph_lo, ph_hi; };
constexpr int LDS_TAB = LDS_MISC + 256;
DI unsigned long long ldtab(LAS unsigned char* lds, int i) {
    const unsigned vx = *(const volatile LAS unsigned*)(lds + LDS_TAB + 8 * i), vy = *(const volatile LAS unsigned*)(lds + LDS_TAB + 8 * i + 4); u32x2 v; v.x = vx; v.y = vy;
    return ((unsigned long long)(unsigned)__builtin_amdgcn_readfirstlane((int)v.y) << 32) | (unsigned)__builtin_amdgcn_readfirstlane((int)v.x);
}
struct Frame {
    LAS unsigned char* lds; int tid, lane, wave, G, bid;
    DI Frame fresh() const { Frame f = *this; int t = lane_id_fresh() + wave * 64; asm volatile("" : "+v"(t)); f.tid = t; f.lane = t & 63; f.wave = wave; return f; }
    DI GLB const float* in(int i) const { return (GLB const float*)ldtab(lds, i); }
    DI GLB float* out() const { return (GLB float*)ldtab(lds, 22); }
    DI GLB unsigned char* ws() const { return (GLB unsigned char*)ldtab(lds, 23); }
    DI unsigned* ctl() const { return (unsigned*)ldtab(lds, 23); }
    DI GLB float* ADA() const { return (GLB float*)(ws() + WS_ADA); }
    DI GLB f16* WIN() const { return (GLB f16*)(ws() + WS_WIN); }
    DI GLB f16* WA() const { return (GLB f16*)(ws() + WS_WA); }
    DI GLB f16* WB() const { return (GLB f16*)(ws() + WS_WB); }
    DI GLB f16* WO() const { return (GLB f16*)(ws() + WS_WO); }
    DI GLB f16* H(int par) const { return (GLB f16*)(ws() + (par ? WS_H2 : WS_H)); }
    DI GLB f16* MG() const { return (GLB f16*)(ws() + WS_MG); }
    DI GLB f16* PROJ() const { return (GLB f16*)(ws() + WS_PROJ); }
    DI GLB f16* OA() const { return (GLB f16*)(ws() + WS_OA); }
    DI GLB f16* OB() const { return (GLB f16*)(ws() + WS_OB); }
    DI GLB f16* KU() const { return (GLB f16*)(ws() + WS_KU); }
    DI GLB f16* VU() const { return (GLB f16*)(ws() + WS_VU); }
    DI GLB f16* KIU() const { return (GLB f16*)(ws() + WS_KIU); }
    DI GLB float* WI() const { return (GLB float*)(ws() + WS_WI); }
    DI GLB float* BETA() const { return (GLB float*)(ws() + WS_BETA); }
    DI GLB float* GG() const { return (GLB float*)(ws() + WS_G); }
};
enum { I_XP = 0, I_XS, I_CP, I_CS, I_CK, I_CV, I_CIK, I_SG, I_SC, I_NW, I_WADA, I_BADA, I_WIN, I_WCONV, I_ALOG, I_DTB, I_GNW, I_WBA, I_WBB, I_WOUT, I_RELB, I_FNW };
constexpr int CW_BAR = 0, CW_Q = 4096, CW_T = 16384;

struct EpiProj {
    static constexpr bool PERM = true;
    GLB f16* proj; GLB float* out; GLB f16 *KU, *VU, *KIU; GLB float *WI, *BETA, *GG; GLB const float *a_log, *dt_bias; int layer, slab;
    DI void operator()(const f32x4 (&acc)[2][2][4][2], const pg8::Unit& u, int wr, int wc, int fr_, int fq_) const {
        int fr = fr_, fq = fq_; asm volatile("" : "+v"(fr), "+v"(fq));
        const int pn = u.pn;
        const int rsb = u.pm * 256 + wr * 64 + fr;
        if (pn < 68) {
            const int act = ((pn >= 24 && pn < 32) || (pn >= 40 && pn < 48)) ? 1 : (pn >= 52 ? 2 : 0);
            const int col0 = pn * 256 + wc * 32 + 8 * fq;
#pragma unroll
            for (int ai = 0; ai < 2; ++ai)
#pragma unroll
                for (int m = 0; m < 4; ++m) {
                    GLB f16* rowp = proj + (size_t)(rsb + ai * 128 + m * 16) * PS + col0;
#pragma unroll
                    for (int bj = 0; bj < 2; ++bj) {
                        f32x4 v0 = acc[ai][bj][m][0], v1 = acc[ai][bj][m][1];
                        if (act == 1) {
#pragma unroll
                            for (int j = 0; j < 4; ++j) { v0[j] = siluf_(v0[j]); v1[j] = siluf_(v1[j]); }
                        } else if (act == 2) {
#pragma unroll
                            for (int j = 0; j < 4; ++j) { v0[j] = sigmoidf_(v0[j]); v1[j] = sigmoidf_(v1[j]); }
                        }
                        u32x4 w; w.x = pk_f16(v0[0], v0[1]); w.y = pk_f16(v0[2], v0[3]); w.z = pk_f16(v1[0], v1[1]); w.w = pk_f16(v1[2], v1[3]);
                        *(GLB u32x4*)(rowp + bj * 128) = w;
                    }
                }
            if (pn < 24 && fr >= 13) {
                const bool smp = u.pm >= 32;
                if (smp || (u.pm & 7) == 7) {
#pragma unroll
                    for (int ai = 0; ai < 2; ++ai) {
                        if (!smp && !(ai == 1 && wr == 1)) continue;
                        int R, sq, t; rowinfo(slab, rsb + ai * 128 + 48, R, sq, t);
                        const int T = smp ? 64 : 2048;
                        GLB float* base = out + (smp ? O_NCS : O_NCP) + ((size_t)(layer * 16 + (sq & 15)) * 3 + (t - (T - 3))) * 6144 + col0;
#pragma unroll
                        for (int bj = 0; bj < 2; ++bj) { *(GLB f32x4*)(base + bj * 128) = acc[ai][bj][3][0]; *(GLB f32x4*)(base + bj * 128 + 4) = acc[ai][bj][3][1]; }
                    }
                }
            }
        } else {
            float dtb[8], ea[8];
            { const int hb = (wc == 3 && fq < 2) ? 8 * fq : 0;
#pragma unroll
              for (int j = 0; j < 8; ++j) { dtb[j] = dt_bias[hb + j]; ea[j] = a_log[hb + j]; }
              asm volatile("" ::: "memory");
#pragma unroll
              for (int j = 0; j < 8; ++j) ea[j] = -__expf(ea[j]); }
#pragma unroll
            for (int ai = 0; ai < 2; ++ai)
#pragma unroll
                for (int m = 0; m < 4; ++m) {
                    int R, sq, t; rowinfo(slab, rsb + ai * 128 + m * 16, R, sq, t);
                    const bool smp = sq >= 16; const int b = sq & 15;
                    const size_t pos = (size_t)posbase(sq) + (smp ? PAST : 0) + t;
#pragma unroll
                    for (int bj = 0; bj < 2; ++bj) {
                        const int c = bj * 128 + wc * 32 + 8 * fq;
                        const f32x4 v0 = acc[ai][bj][m][0], v1 = acc[ai][bj][m][1];
                        if (pn < 70) {
                            GLB float* o = out + (pn == 68 ? (smp ? O_NKS : O_NKP) : (smp ? O_NVS : O_NVP)) + ((size_t)(layer * 16 + b) * (smp ? 64 : 2048) + t) * 256 + c;
                            *(GLB f32x4*)o = v0; *(GLB f32x4*)(o + 4) = v1;
                            u32x4 w; w.x = pk_f16(v0[0], v0[1]); w.y = pk_f16(v0[2], v0[3]); w.z = pk_f16(v1[0], v1[1]); w.w = pk_f16(v1[2], v1[3]);
                            *(GLB u32x4*)((pn == 68 ? KU : VU) + pos * 256 + c) = w;
                        } else if (c < 64) {
                            GLB float* o = out + (smp ? O_NIS : O_NIP) + ((size_t)(layer * 16 + b) * (smp ? 64 : 2048) + t) * 64 + c;
                            *(GLB f32x4*)o = v0; *(GLB f32x4*)(o + 4) = v1;
                            u32x4 w; w.x = pk_f16(v0[0], v0[1]); w.y = pk_f16(v0[2], v0[3]); w.z = pk_f16(v1[0], v1[1]); w.w = pk_f16(v1[2], v1[3]);
                            *(GLB u32x4*)(KIU + pos * 64 + c) = w;
                        } else if (c < 80) {
                            GLB float* o = WI + (size_t)R * 16 + (c - 64);
                            *(GLB f32x4*)o = v0 * 0.03125f; *(GLB f32x4*)(o + 4) = v1 * 0.03125f;
                        } else if (c < 96) {
                            GLB float* o = BETA + (size_t)R * 16 + (c - 80);
                            f32x4 a, bb;
#pragma unroll
                            for (int j = 0; j < 4; ++j) { a[j] = sigmoidf_(v0[j]); bb[j] = sigmoidf_(v1[j]); }
                            *(GLB f32x4*)o = a; *(GLB f32x4*)(o + 4) = bb;
                        } else if (c < 112) {
                            GLB float* o = GG + (size_t)R * 16 + (c - 96);
                            f32x4 a, bb;
#pragma unroll
                            for (int j = 0; j < 4; ++j) {
                                const float x0 = v0[j] + dtb[j], x1 = v1[j] + dtb[4 + j];
                                const float s0 = x0 > 20.f ? x0 : __logf(1.0f + __expf(x0)), s1 = x1 > 20.f ? x1 : __logf(1.0f + __expf(x1));
                                a[j] = ea[j] * s0; bb[j] = ea[4 + j] * s1;
                            }
                            *(GLB f32x4*)o = a; *(GLB f32x4*)(o + 4) = bb;
                        }
                    }
                }
        }
    }
};
struct EpiAB {
    static constexpr bool PERM = true;
    GLB const f16* proj; GLB f16* mg;
    DI void operator()(const f32x4 (&acc)[2][2][4][2], const pg8::Unit& u, int wr, int wc, int fr_, int fq_) const {
        int fr = fr_, fq = fq_; asm volatile("" : "+v"(fr), "+v"(fq));
        const int rsb = u.pm * 256 + wr * 64 + fr, col0 = u.pn * 256 + wc * 32 + 8 * fq;
        const int gc = (u.which ? C_GB : C_GA) + col0;
#pragma unroll
        for (int ai = 0; ai < 2; ++ai) {
            h8 gt[4][2], pv[4][2];
#pragma unroll
            for (int m = 0; m < 4; ++m)
#pragma unroll
                for (int bj = 0; bj < 2; ++bj) {
                    const size_t rs = (size_t)(rsb + ai * 128 + m * 16);
                    gt[m][bj] = *(GLB const h8*)(proj + rs * PS + gc + bj * 128);
                    if (u.which) pv[m][bj] = *(GLB const h8*)(mg + rs * 2048 + col0 + bj * 128);
                }
#pragma unroll
            for (int m = 0; m < 4; ++m)
#pragma unroll
                for (int bj = 0; bj < 2; ++bj) {
                    const size_t rs = (size_t)(rsb + ai * 128 + m * 16);
                    float r[8];
#pragma unroll
                    for (int j = 0; j < 4; ++j) { r[j] = (float)gt[m][bj][j] * acc[ai][bj][m][0][j]; r[4 + j] = (float)gt[m][bj][4 + j] * acc[ai][bj][m][1][j]; }
                    if (u.which) {
#pragma unroll
                        for (int j = 0; j < 8; ++j) r[j] += (float)pv[m][bj][j]; }
                    u32x4 w; w.x = pk_f16(r[0], r[1]); w.y = pk_f16(r[2], r[3]); w.z = pk_f16(r[4], r[5]); w.w = pk_f16(r[6], r[7]);
                    *(GLB u32x4*)(mg + rs * 2048 + col0 + bj * 128) = w;
                }
        }
    }
};
struct EpiOut {
    static constexpr bool PERM = true;
    GLB const float* xp; GLB const float* xs; GLB float* out; GLB const float* ada; int layer, slab;
    DI void operator()(const f32x4 (&acc)[2][2][4][2], const pg8::Unit& u, int wr, int wc, int fr_, int fq_) const {
        int fr = fr_, fq = fq_; asm volatile("" : "+v"(fr), "+v"(fq));
        const int rsb = u.pm * 256 + wr * 64 + fr, col0 = u.pn * 256 + wc * 32 + 8 * fq;
#pragma unroll
        for (int ai = 0; ai < 2; ++ai) {
#pragma unroll
            for (int bj = 0; bj < 2; ++bj) {
                const int c = col0 + bj * 128;
                f32x4 xv[4][2], gv[2];
                { int R, sq, t; rowinfo(slab, rsb + ai * 128, R, sq, t);
                  GLB const float* gp = ada + (size_t)sq * 6144 + 4096;
                  gv[0] = *(GLB const f32x4*)(gp + c); gv[1] = *(GLB const f32x4*)(gp + c + 4); }
#pragma unroll
                for (int m = 0; m < 4; ++m) {
                    int R, sq, t; rowinfo(slab, rsb + ai * 128 + m * 16, R, sq, t);
                    GLB const float* xo = layer == 0 ? (R < NTOKP ? xp + (size_t)R * D : xs + (size_t)(R - NTOKP) * D) : out + (size_t)R * D;
                    xv[m][0] = *(GLB const f32x4*)(xo + c); xv[m][1] = *(GLB const f32x4*)(xo + c + 4);
                }
                asm volatile("" ::: "memory");
#pragma unroll
                for (int m = 0; m < 4; ++m) {
                    int R, sq, t; rowinfo(slab, rsb + ai * 128 + m * 16, R, sq, t);
                    GLB float* yo = out + (size_t)R * D;
                    *(GLB f32x4*)(yo + c) = xv[m][0] + gv[0] * acc[ai][bj][m][0]; *(GLB f32x4*)(yo + c + 4) = xv[m][1] + gv[1] * acc[ai][bj][m][1];
                }
            }
        }
    }
};

DI void p0_prologue(const Frame F0) {
    const Frame F = F0.fresh();
    LAS float* tile = (LAS float*)F.lds;
    const int tid = F.tid;
    for (int u = F.bid; u < 2 * 6080; u += F.G) {
        const int l = u / 6080; int v = u % 6080;
        GLB const float* src; GLB f16* dst; int ldn, nb, kb; bool isin;
        if (v < 4544) { isin = true; nb = v >> 4; kb = v & 15; src = F.in(I_WIN) + (size_t)l * 2048 * IN_DIM; ldn = IN_DIM; dst = F.WIN() + (size_t)l * NP * 2048; }
        else { v -= 4544; const int mat = v >> 9, w = v & 511; isin = false; nb = w >> 4; kb = w & 15; src = F.in(I_WBA + mat) + (size_t)l * 2048 * 2048; ldn = 2048;
               dst = (mat == 0 ? F.WA() : mat == 1 ? F.WB() : F.WO()) + (size_t)l * 2048 * 2048; }
        {
            const int nn = tid & 63, np = nb * 64 + nn; const int o = isin ? proj_src_col(np) : np, oc = o >= 0 ? o : 0;
            float val[16];
#pragma unroll
            for (int i = 0; i < 16; ++i) { const int kk = (tid >> 6) + 8 * i; val[i] = src[(size_t)(kb * 128 + kk) * ldn + oc]; }
            asm volatile("" ::: "memory");
#pragma unroll
            for (int i = 0; i < 16; ++i) { const int kk = (tid >> 6) + 8 * i; tile[kk * 65 + nn] = o >= 0 ? val[i] : 0.f; }
        }
        __syncthreads();
#pragma unroll
        for (int j2 = 0; j2 < 2; ++j2) {
            const int item = tid + NTHR * j2, nn = item >> 4, kg = item & 15; h8 hv;
#pragma unroll
            for (int j = 0; j < 8; ++j) hv[j] = (f16)tile[(kg * 8 + j) * 65 + nn];
            *(GLB h8*)(dst + (size_t)(nb * 64 + nn) * 2048 + kb * 128 + kg * 8) = hv;
        }
        __syncthreads();
    }
    for (int u = F.bid; u < 2 * 96; u += F.G) {
        const int l = u / 96, cb = u % 96, kg = tid >> 6, n = tid & 63;
        float acc[32];
#pragma unroll
        for (int s = 0; s < 32; ++s) acc[s] = 0.f;
        GLB const float* W = F.in(I_WADA) + (size_t)l * 2048 * 6144 + cb * 64 + n;
        for (int kc = 0; kc < 4; ++kc) {
            for (int i = tid; i < 32 * 512; i += NTHR) { const int s = i >> 9, k = i & 511; const float c = (s < 16 ? F.in(I_CP) + s * 2048 : F.in(I_CS) + (s - 16) * 2048)[kc * 512 + k]; tile[i] = siluf_(c); }
            __syncthreads();
            for (int kk = 0; kk < 64; ++kk) { const int k = kg * 64 + kk; const float w = W[(size_t)(kc * 512 + k) * 6144];
#pragma unroll
                for (int s = 0; s < 32; ++s) acc[s] += tile[s * 512 + k] * w; }
            __syncthreads();
        }
#pragma unroll
        for (int s = 0; s < 32; ++s) tile[(kg * 32 + s) * 64 + n] = acc[s];
        __syncthreads();
        for (int o = tid; o < 2048; o += NTHR) { const int s = o >> 6, nn = o & 63; float r = F.in(I_BADA)[l * 6144 + cb * 64 + nn];
#pragma unroll
            for (int g = 0; g < 8; ++g) r += tile[(g * 32 + s) * 64 + nn];
            F.ADA()[(size_t)(l * 32 + s) * 6144 + cb * 64 + nn] = r; }
        __syncthreads();
    }
}

DI void phase_norm(const Frame F0, int l, int slab) {
    const Frame F = F0.fresh();
    const int Ts = ts_of(slab);
    GLB const float* nw = F.in(I_NW) + l * 2048;
    f32x4 nwv[8];
#pragma unroll
    for (int i = 0; i < 8; ++i) nwv[i] = *(GLB const f32x4*)(nw + (i * 64 + F.lane) * 4);
    for (int rs = F.bid * NWAVES + F.wave; rs < Ts; rs += F.G * NWAVES) {
        int R, sq, t; rowinfo(slab, rs, R, sq, t);
        GLB const float* x = l == 0 ? (R < NTOKP ? F.in(I_XP) + (size_t)R * D : F.in(I_XS) + (size_t)(R - NTOKP) * D) : F.out() + (size_t)R * D;
        GLB const float* ad = F.ADA() + (size_t)(l * 32 + sq) * 6144;
        f32x4 v[8], shv[8], scv[8]; float ss = 0.f;
#pragma unroll
        for (int i = 0; i < 8; ++i) v[i] = *(GLB const f32x4*)(x + (i * 64 + F.lane) * 4);
#pragma unroll
        for (int i = 0; i < 8; ++i) { const int c = (i * 64 + F.lane) * 4; shv[i] = *(GLB const f32x4*)(ad + c); scv[i] = *(GLB const f32x4*)(ad + 2048 + c); }
        asm volatile("" ::: "memory");
#pragma unroll
        for (int i = 0; i < 8; ++i) ss += v[i][0] * v[i][0] + v[i][1] * v[i][1] + v[i][2] * v[i][2] + v[i][3] * v[i][3];
        ss = wave_sum(ss, F.lane);
        const float r = rsqrtf(ss * (1.0f / 2048.0f) + EPS);
#pragma unroll
        for (int i = 0; i < 8; ++i) { const int c = (i * 64 + F.lane) * 4;
            const f32x4 w = nwv[i], sh = shv[i], sc = scv[i];
            const f32x4 hv = v[i] * r * w * (sc + 1.0f) + sh;
            u32x2 p; p.x = pk_f16(hv[0], hv[1]); p.y = pk_f16(hv[2], hv[3]);
            *(GLB u32x2*)(F.H(slab & 1) + (size_t)rs * 2048 + c) = p; }
    }
    if (slab == 0) {
        const size_t gid = (size_t)F.bid * NTHR + F.tid, gsz = (size_t)F.G * NTHR;
        const size_t nk = (size_t)16 * PAST * 32;
        for (size_t g0 = gid; g0 < nk; g0 += 2 * gsz) {
            f32x4 ka[2][2], va[2][2]; size_t dofs[2]; bool ok[2];
#pragma unroll
            for (int e = 0; e < 2; ++e) {
                const size_t g1 = g0 + e * gsz; ok[e] = g1 < nk; const size_t g = ok[e] ? g1 : g0;
                const size_t b = g / (PAST * 32), rem = g % (PAST * 32), p = rem >> 5, c8 = (rem & 31) * 8;
                const size_t so = (size_t)l * 16 * PAST * 256 + g * 8; dofs[e] = ((size_t)32768 + b * LSMP + p) * 256 + c8;
                ka[e][0] = *(GLB const f32x4*)(F.in(I_CK) + so); ka[e][1] = *(GLB const f32x4*)(F.in(I_CK) + so + 4);
                va[e][0] = *(GLB const f32x4*)(F.in(I_CV) + so); va[e][1] = *(GLB const f32x4*)(F.in(I_CV) + so + 4);
            }
            asm volatile("" ::: "memory");
#pragma unroll
            for (int e = 0; e < 2; ++e) if (ok[e]) {
                { const f32x4 a = ka[e][0], bb = ka[e][1];
                  u32x4 w; w.x = pk_f16(a[0], a[1]); w.y = pk_f16(a[2], a[3]); w.z = pk_f16(bb[0], bb[1]); w.w = pk_f16(bb[2], bb[3]); *(GLB u32x4*)(F.KU() + dofs[e]) = w; }
                { const f32x4 a = va[e][0], bb = va[e][1];
                  u32x4 w; w.x = pk_f16(a[0], a[1]); w.y = pk_f16(a[2], a[3]); w.z = pk_f16(bb[0], bb[1]); w.w = pk_f16(bb[2], bb[3]); *(GLB u32x4*)(F.VU() + dofs[e]) = w; }
            }
        }
        const size_t ni = (size_t)16 * PAST * 8;
        for (size_t g0 = gid; g0 < ni; g0 += 4 * gsz) {
            f32x4 ia[4][2]; size_t dofs[4]; bool ok[4];
#pragma unroll
            for (int e = 0; e < 4; ++e) {
                const size_t g1 = g0 + e * gsz; ok[e] = g1 < ni; const size_t g = ok[e] ? g1 : g0;
                const size_t b = g / (PAST * 8), rem = g % (PAST * 8), p = rem >> 3, c8 = (rem & 7) * 8;
                const size_t so = (size_t)l * 16 * PAST * 64 + g * 8; dofs[e] = ((size_t)32768 + b * LSMP + p) * 64 + c8;
                ia[e][0] = *(GLB const f32x4*)(F.in(I_CIK) + so); ia[e][1] = *(GLB const f32x4*)(F.in(I_CIK) + so + 4);
            }
            asm volatile("" ::: "memory");
#pragma unroll
            for (int e = 0; e < 4; ++e) if (ok[e]) {
                const f32x4 a = ia[e][0], bb = ia[e][1];
                u32x4 w; w.x = pk_f16(a[0], a[1]); w.y = pk_f16(a[2], a[3]); w.z = pk_f16(bb[0], bb[1]); w.w = pk_f16(bb[2], bb[3]); *(GLB u32x4*)(F.KIU() + dofs[e]) = w;
            }
        }
    }
}

DI unsigned sortable(float f) { const unsigned u = __float_as_uint(f); return (u & 0x80000000u) ? ~u : (u | 0x80000000u); }


typedef float f32x16 __attribute__((ext_vector_type(16)));
typedef __fp16 fp16x4_t __attribute__((__vector_size__(4 * sizeof(__fp16))));
#define MFMA32(a, b, c) __builtin_amdgcn_mfma_f32_32x32x16_f16((a), (b), (c), 0, 0, 0)
#define SB() __builtin_amdgcn_sched_barrier(0)
#define PRIO(n) __builtin_amdgcn_s_setprio(n)
constexpr int AT_KV = 0, AT_BUF = 35840, AT_V = 17408, AT_ROW = 272, AT_VROW = 288;
constexpr int AT_QI = 0, AT_QIS = 1032;
constexpr int AT_MASK = 71680, AT_BT = AT_MASK + 32 * 65 * 8, AT_WI = AT_BT + 16 * 192 * 4, AT_END = AT_WI + 32 * 16 * 4;
static_assert(AT_END <= LDS_MISC && 32 * AT_QIS * 2 <= AT_MASK, "attention LDS map");
constexpr float LOG2E = 1.4426950408889634f, SCL2 = 0.08838834764831845f * LOG2E;


constexpr int GX = 0, GX_S = 400, GTF = 51200, GPT = GTF + 17408, GTAB = GPT + 4096, GAT = GTAB + 1536, GAT_S = 68, GTM = GAT + 17408, GT_S = 72, GTM2 = GTM + 9216, GPRE_END = GTM2 + 9216;
static_assert(GPRE_END <= LDS_MISC, "gdn pre LDS map");
DI void gdn_pre_unit(const Frame& F0, int l, int slab, int c, int hd) {
    const unsigned tst_10 = PROBE_T ? (unsigned)clock64() : 0u;
    const Frame F = F0.fresh();
    const int tid = F.tid, lane = F.lane, wave = F.wave, r32 = lane & 31, h2 = lane >> 5;
    LAS unsigned char* lds = F.lds;
    LAS f16* X = (LAS f16*)(lds + GX);
    LAS float* TF = (LAS float*)(lds + GTF);
    LAS float* PT = (LAS float*)(lds + GPT);
    LAS float* TAB = (LAS float*)(lds + GTAB);
    LAS float* AT = (LAS float*)(lds + GAT);
    LAS f16* TM = (LAS f16*)(lds + GTM);
    LAS f16* TM2 = (LAS f16*)(lds + GTM2);
    const bool smp = c >= 128;
    const int sq = smp ? 16 + (c - 128) : slab * 4 + (c >> 5), n = smp ? 0 : (c & 31), b = sq & 15;
    const int rsb = smp ? 8192 + (sq - 16) * 64 : (sq - slab * 4) * 2048 + n * 64;
    const int Rb = smp ? NTOKP + (sq - 16) * 64 : sq * 2048 + n * 64;
    GLB const f16* PROJ = F.PROJ();
    GLB unsigned char* gp = F.ws() + WS_GP + (size_t)(c * 16 + hd) * GP_STRIDE;
    {
        GLB const float* wcv = F.in(I_WCONV) + (size_t)l * 4 * 6144;
        GLB const float* scv = F.in(I_SC) + (size_t)(l * 16 + b) * 3 * 6144;
        if (tid < 384) {
            const int run = tid / 48, cg = tid % 48, part = cg >> 4, c8 = (cg & 15) * 8, gch = part * 2048 + hd * 128 + c8, tok0 = run * 8;
            h8 xr[11];
#pragma unroll
            for (int r = 0; r < 11; ++r) {
                const int tt = tok0 - 3 + r;
                if (tt >= 0 || n > 0) xr[r] = *(GLB const h8*)(PROJ + (size_t)(rsb + tt) * PS + gch);
                else if (smp) { const f32x4 a = *(GLB const f32x4*)(scv + (size_t)(3 + tt) * 6144 + gch), bq = *(GLB const f32x4*)(scv + (size_t)(3 + tt) * 6144 + gch + 4);
                    h8 t; t[0] = (f16)a[0]; t[1] = (f16)a[1]; t[2] = (f16)a[2]; t[3] = (f16)a[3]; t[4] = (f16)bq[0]; t[5] = (f16)bq[1]; t[6] = (f16)bq[2]; t[7] = (f16)bq[3]; xr[r] = t; }
                else {
#pragma unroll
                    for (int j = 0; j < 8; ++j) xr[r][j] = (f16)0.f; }
            }
            float w[4][8];
#pragma unroll
            for (int tap = 0; tap < 4; ++tap) { const f32x4 w0 = *(GLB const f32x4*)(wcv + tap * 6144 + gch), w1 = *(GLB const f32x4*)(wcv + tap * 6144 + gch + 4);
#pragma unroll
                for (int j = 0; j < 4; ++j) { w[tap][j] = w0[j]; w[tap][4 + j] = w1[j]; } }
            h8 y[8];
#pragma unroll
            for (int tq = 0; tq < 8; ++tq)
#pragma unroll
                for (int j = 0; j < 8; ++j) {
                    const float acc = w[0][j] * (float)xr[tq][j] + w[1][j] * (float)xr[tq + 1][j] + w[2][j] * (float)xr[tq + 2][j] + w[3][j] * (float)xr[tq + 3][j];
                    y[tq][j] = (f16)siluf_(acc);
                }
#pragma unroll
            for (int tq = 0; tq < 8; ++tq) *(LAS h8*)(X + (tok0 + tq) * GX_S + cg * 8) = y[tq];
        }
        if (wave == 7) {
            const float be = F.BETA()[(size_t)(Rb + lane) * 16 + hd];
            float gcv = F.GG()[(size_t)(Rb + lane) * 16 + hd];
#pragma unroll
            for (int o = 1; o < 64; o <<= 1) { const float tv = __builtin_bit_cast(float, __builtin_amdgcn_ds_bpermute(((lane - o) & 63) << 2, __builtin_bit_cast(int, gcv))); if (lane >= o) gcv += tv; }
            const float gl = __builtin_bit_cast(float, __builtin_amdgcn_readlane(__builtin_bit_cast(int, gcv), 63));
            TAB[128 + lane] = be; TAB[192 + lane] = gcv; TAB[256 + lane] = __expf(gcv); TAB[320 + lane] = __expf(gl - gcv);
            if (lane == 63) ((GLB float*)(F.ws() + WS_GL))[c * 16 + hd] = __expf(gl);
        }
    }
    __syncthreads();
    {
        const int tok = tid >> 3, part = tid & 7;
        float sq_ = 0.f, sk_ = 0.f;
#pragma unroll
        for (int u = 0; u < 2; ++u) { const h8 a = *(const LAS h8*)(X + tok * GX_S + part * 16 + u * 8), k = *(const LAS h8*)(X + tok * GX_S + 128 + part * 16 + u * 8);
#pragma unroll
            for (int j = 0; j < 8; ++j) { sq_ += (float)a[j] * (float)a[j]; sk_ += (float)k[j] * (float)k[j]; } }
        { sq_ += swz_xor<4>(sq_); sk_ += swz_xor<4>(sk_); sq_ += swz_xor<2>(sq_); sk_ += swz_xor<2>(sk_); sq_ += swz_xor<1>(sq_); sk_ += swz_xor<1>(sk_); }
        if (part == 0) { TAB[tok] = rsqrtf(sq_ + EPS) * 0.08838834764831845f; TAB[64 + tok] = rsqrtf(sk_ + EPS); }
    }
    __syncthreads();
    if (wave < 6) {
        const bool isqk = wave >= 3; const int ti = isqk ? wave - 3 : wave;
        const int rt = isqk ? (ti == 2 ? 1 : 0) : (wave == 2 ? 1 : 0), ct = isqk ? (ti == 0 ? 0 : 1) : (wave == 0 ? 0 : 1);
        f32x16 acc;
#pragma unroll
        for (int i = 0; i < 16; ++i) acc[i] = 0.f;
        {
            h8 fa[8], fb[8];
#pragma unroll
            for (int s = 0; s < 8; ++s) { fa[s] = *(const LAS h8*)(X + (32 * rt + r32) * GX_S + 128 + 16 * s + 8 * h2);
                fb[s] = *(const LAS h8*)(X + (32 * ct + r32) * GX_S + (isqk ? 0 : 128) + 16 * s + 8 * h2); }
            SB();
#pragma unroll
            for (int s = 0; s < 8; ++s) acc = MFMA32(fa[s], fb[s], acc);
            SB();
        }
        const int col = 32 * ct + r32;
        if (!isqk) {
            const float bk = TAB[128 + col] * TAB[64 + col], gck = TAB[192 + col];
#pragma unroll
            for (int g = 0; g < 4; ++g) { const int j0 = 32 * rt + 8 * g + 4 * h2;
                const f32x4 rk = *(const LAS f32x4*)(TAB + 64 + j0), gj = *(const LAS f32x4*)(TAB + 192 + j0);
                f32x4 v;
#pragma unroll
                for (int jj = 0; jj < 4; ++jj) v[jj] = (col > j0 + jj) ? bk * rk[jj] * acc[4 * g + jj] * __expf(fminf(gck - gj[jj], 0.f)) : 0.f;
                *(LAS f32x4*)(AT + col * GAT_S + j0) = v; }
        } else {
            const float rqi = TAB[col], gci = TAB[192 + col];
#pragma unroll
            for (int g = 0; g < 4; ++g) { const int j0 = 32 * rt + 8 * g + 4 * h2;
                const f32x4 rk = *(const LAS f32x4*)(TAB + 64 + j0), gj = *(const LAS f32x4*)(TAB + 192 + j0);
                h4 v;
#pragma unroll
                for (int jj = 0; jj < 4; ++jj) v[jj] = (f16)((col >= j0 + jj) ? rqi * rk[jj] * acc[4 * g + jj] * __expf(fminf(gci - gj[jj], 0.f)) : 0.f);
                *(GLB h4*)(gp + GP_QK + (col * 64 + j0) * 2) = v; }
        }
    } else if (wave == 6) {
#pragma unroll
        for (int u = 0; u < 4; ++u) { const int p = lane + 64 * u, i = p >> 3, j0 = 32 + (p & 7) * 4; *(GLB h4*)(gp + GP_QK + (i * 64 + j0) * 2) = (h4){(f16)0.f, (f16)0.f, (f16)0.f, (f16)0.f}; }
    }
    if (wave == 0 || wave == 2) {
        const int bs = wave == 0 ? 0 : 32;
        asm volatile("s_waitcnt lgkmcnt(0)" ::: "memory");
        {
            const int o = bs + 16 * ((lane >> 4) & 1), cc = lane & 15;
            float T[16];
            f32x4 Ar[16][4];
#pragma unroll
            for (int i = 1; i < 16; ++i)
#pragma unroll
                for (int jg = 0; jg < (i + 3) / 4; ++jg) Ar[i][jg] = *(const LAS f32x4*)(AT + (o + i) * GAT_S + o + 4 * jg);
            asm volatile("" ::: "memory");
#pragma unroll
            for (int i = 0; i < 16; ++i) {
                float sacc = (i == cc) ? 1.f : 0.f;
#pragma unroll
                for (int jg = 0; jg < (i + 3) / 4; ++jg) { const f32x4 a4 = Ar[i][jg];
#pragma unroll
                    for (int jj = 0; jj < 4; ++jj) if (4 * jg + jj < i) sacc -= a4[jj] * T[4 * jg + jj]; }
                T[i] = sacc;
            }
            if (lane < 32) {
#pragma unroll
                for (int i = 0; i < 16; ++i) TF[(o + i) * GAT_S + o + cc] = T[i];
            }
        }
        asm volatile("s_waitcnt lgkmcnt(0)" ::: "memory");
        {
            const int r16 = lane & 15, k4 = lane >> 4, i = lane >> 2, c4 = (lane & 3) * 4;
            float a[4], b[4];
#pragma unroll
            for (int kk = 0; kk < 4; ++kk) { a[kk] = AT[(bs + 16 + r16) * GAT_S + bs + 4 * kk + k4]; b[kk] = TF[(bs + 4 * kk + k4) * GAT_S + bs + r16]; }
            f32x4 p = {0.f, 0.f, 0.f, 0.f};
#pragma unroll
            for (int kk = 0; kk < 4; ++kk) p = __builtin_amdgcn_mfma_f32_16x16x4f32(a[kk], b[kk], p, 0, 0, 0);
#pragma unroll
            for (int q = 0; q < 4; ++q) PT[(bs >> 5) * 256 + (4 * k4 + q) * 16 + r16] = p[q];
            { float zz = 0.f; asm volatile("" : "+v"(zz)); *(LAS f32x4*)(TF + (bs + i) * GAT_S + bs + 16 + c4) = (f32x4){zz, zz, zz, zz}; }
            asm volatile("s_waitcnt lgkmcnt(0)" ::: "memory");
#pragma unroll
            for (int kk = 0; kk < 4; ++kk) { a[kk] = TF[(bs + 16 + r16) * GAT_S + bs + 16 + 4 * kk + k4]; b[kk] = PT[(bs >> 5) * 256 + (4 * kk + k4) * 16 + r16]; }
            f32x4 v = {0.f, 0.f, 0.f, 0.f};
#pragma unroll
            for (int kk = 0; kk < 4; ++kk) v = __builtin_amdgcn_mfma_f32_16x16x4f32(a[kk], b[kk], v, 0, 0, 0);
#pragma unroll
            for (int q = 0; q < 4; ++q) TF[(bs + 16 + 4 * k4 + q) * GAT_S + bs + r16] = -v[q];
        }
    } else {
        const int e = (wave == 1 ? 0 : wave - 2) * 64 + lane;
#pragma unroll 1
        for (int item = e; item < 2048; item += 384) {
            const int which = item >> 10, rem = item & 1023, tok = rem >> 4, c8 = (rem & 15) * 8;
            const h8 xv = *(const LAS h8*)(X + tok * GX_S + (which ? 128 : 0) + c8);
            const float sc = which ? TAB[64 + tok] * TAB[320 + tok] : TAB[tok] * TAB[256 + tok];
            h8 o;
#pragma unroll
            for (int j = 0; j < 8; ++j) o[j] = (f16)((float)xv[j] * sc);
            *(GLB h8*)(gp + (which ? GP_KD : GP_QD) + (tok * 128 + c8) * 2) = o;
        }
    }
    __syncthreads();
    {
        const int ti = (wave >> 1) & 1, tj = wave & 1, r16 = lane & 15, k4 = lane >> 4;
        if (wave < 4) {
            float a[8], b[8];
#pragma unroll
            for (int kk = 0; kk < 8; ++kk) { a[kk] = AT[(32 + 16 * ti + r16) * GAT_S + 4 * kk + k4]; b[kk] = TF[(4 * kk + k4) * GAT_S + 16 * tj + r16]; }
            f32x4 pacc = {0.f, 0.f, 0.f, 0.f};
#pragma unroll
            for (int kk = 0; kk < 8; ++kk) pacc = __builtin_amdgcn_mfma_f32_16x16x4f32(a[kk], b[kk], pacc, 0, 0, 0);
#pragma unroll
            for (int i = 0; i < 4; ++i) PT[(16 * ti + 4 * k4 + i) * 32 + 16 * tj + r16] = pacc[i];
        }
        __syncthreads();
        if (wave < 4) {
            float a[8], b[8];
#pragma unroll
            for (int kk = 0; kk < 8; ++kk) { a[kk] = TF[(32 + 16 * ti + r16) * GAT_S + 32 + 4 * kk + k4]; b[kk] = PT[(4 * kk + k4) * 32 + 16 * tj + r16]; }
            f32x4 vacc = {0.f, 0.f, 0.f, 0.f};
#pragma unroll
            for (int kk = 0; kk < 8; ++kk) vacc = __builtin_amdgcn_mfma_f32_16x16x4f32(a[kk], b[kk], vacc, 0, 0, 0);
#pragma unroll
            for (int i = 0; i < 4; ++i) TF[(32 + 16 * ti + 4 * k4 + i) * GAT_S + 16 * tj + r16] = -vacc[i];
        }
    }
    __syncthreads();
    {
        const int i = tid >> 3, jg = tid & 7; h8 o, o2;
#pragma unroll
        for (int jj = 0; jj < 8; ++jj) { const int j = 8 * jg + jj; const float tv = (i < 32 && jg >= 4) ? 0.f : TF[i * GAT_S + j]; const float bj = TAB[128 + j];
            o[jj] = (f16)(tv * bj * TAB[64 + j] * TAB[256 + j]); o2[jj] = (f16)(tv * bj); }
        *(LAS h8*)(TM + i * GT_S + 8 * jg) = o; *(LAS h8*)(TM2 + i * GT_S + 8 * jg) = o2;
    }
    __syncthreads();
    {
        const int mt = wave & 3, nt = wave >> 2;
        const int i16 = lane & 15, q4 = i16 >> 2, p4 = i16 & 3, blk = (lane >> 4) & 1;
        f32x16 aw, au;
#pragma unroll
        for (int i = 0; i < 16; ++i) { aw[i] = 0.f; au[i] = 0.f; }
        {
            h8 tb[4], tb2[4], ka[4], vb[4];
#pragma unroll
            for (int s = 0; s < 4; ++s) {
                tb[s] = *(const LAS h8*)(TM + (32 * nt + r32) * GT_S + 16 * s + 8 * h2);
                tb2[s] = *(const LAS h8*)(TM2 + (32 * nt + r32) * GT_S + 16 * s + 8 * h2);
                LAS unsigned char* kp = (LAS unsigned char*)X + (16 * s + 8 * h2 + q4) * (GX_S * 2) + 2 * (128 + 32 * mt) + 8 * (4 * blk + p4);
                LAS unsigned char* vp = (LAS unsigned char*)X + (16 * s + 8 * h2 + q4) * (GX_S * 2) + 2 * (256 + 32 * mt) + 8 * (4 * blk + p4);
                const fp16x4_t klo = __builtin_amdgcn_ds_read_tr16_b64_v4f16((LAS fp16x4_t*)kp), khi = __builtin_amdgcn_ds_read_tr16_b64_v4f16((LAS fp16x4_t*)(kp + 4 * GX_S * 2));
                const fp16x4_t vlo = __builtin_amdgcn_ds_read_tr16_b64_v4f16((LAS fp16x4_t*)vp), vhi = __builtin_amdgcn_ds_read_tr16_b64_v4f16((LAS fp16x4_t*)(vp + 4 * GX_S * 2));
                ka[s] = __builtin_shufflevector(__builtin_bit_cast(h4, klo), __builtin_bit_cast(h4, khi), 0, 1, 2, 3, 4, 5, 6, 7);
                vb[s] = __builtin_shufflevector(__builtin_bit_cast(h4, vlo), __builtin_bit_cast(h4, vhi), 0, 1, 2, 3, 4, 5, 6, 7);
            }
            SB();
#pragma unroll
            for (int s = 0; s < 4; ++s) { aw = MFMA32(ka[s], tb[s], aw); au = MFMA32(tb2[s], vb[s], au); }
            SB();
        }
#pragma unroll
        for (int g = 0; g < 4; ++g) {
            h4 w4, u4;
#pragma unroll
            for (int jj = 0; jj < 4; ++jj) { w4[jj] = (f16)aw[4 * g + jj]; u4[jj] = (f16)au[4 * g + jj]; }
            *(GLB h4*)(gp + GP_W + ((32 * nt + r32) * 128 + 32 * mt + 8 * g + 4 * h2) * 2) = w4;
            *(GLB h4*)(gp + GP_U + (((mt * 2 + nt) * 4 + g) * 64 + lane) * 8) = u4;
        }
    }
    __syncthreads();
    if (PROBE_T && (lane_id_fresh() + F0.wave * 64) == 0) __hip_atomic_fetch_add((unsigned long long*)(F0.ctl() + CW_T) + 10, (unsigned long long)((unsigned)clock64() - tst_10), __ATOMIC_RELAXED, __HIP_MEMORY_SCOPE_AGENT);
}

constexpr int SC_W = 0, SC_QD = 17408, SC_KD = 34816, SC_QK = 53248, SC_BUF = 62464, SC_KROW = 288, SC_SSQ = 2 * SC_BUF, SC_END = SC_SSQ + 1024;
static_assert(SC_END <= LDS_MISC, "gdn scan LDS map");
DI void gdn_scan_unit(const Frame& F0, int l, int slab, int sq, int hd) {
    const unsigned tst_9 = PROBE_T ? (unsigned)clock64() : 0u;
    const Frame F = F0.fresh();
    const int tid = F.tid, lane = F.lane, wave = F.wave, r32 = lane & 31, h2 = lane >> 5;
    const int i16 = lane & 15, q4 = i16 >> 2, p4 = i16 & 3, blk = (lane >> 4) & 1;
    LAS unsigned char* lds = F.lds;
    LAS float* ssq = (LAS float*)(lds + SC_SSQ);
    const bool smp = sq >= 16; const int b = sq & 15, nch = smp ? 1 : 32;
    const int c0 = smp ? 128 + (sq - 16) : (sq - slab * 4) * 32;
    const int rs0 = smp ? 8192 + (sq - 16) * 64 : (sq - slab * 4) * 2048;
    GLB const unsigned char* gpb = F.ws() + WS_GP + (size_t)hd * GP_STRIDE;
    GLB const float* GLp = (GLB const float*)(F.ws() + WS_GL);
    const int w = wave;
    f32x16 S[4];
    if (wave < 4) {
        GLB const float* s0 = F.in(I_SG) + ((size_t)(l * 16 + b) * 16 + hd) * 16384;
#pragma unroll
        for (int mt = 0; mt < 4; ++mt)
#pragma unroll
            for (int i = 0; i < 16; ++i) S[mt][i] = smp ? s0[(32 * mt + (i & 3) + 8 * (i >> 2) + 4 * h2) * 128 + 32 * w + r32] : 0.f;
    }
    const int lt = tid - 256;
    h4 uf[2][4];
    if (wave < 4) { GLB const unsigned char* up = gpb + (size_t)c0 * 16 * GP_STRIDE + GP_U;
#pragma unroll
        for (int tm = 0; tm < 2; ++tm)
#pragma unroll
            for (int g = 0; g < 4; ++g) uf[tm][g] = *(GLB const h4*)(up + (((w * 2 + tm) * 4 + g) * 64 + lane) * 8); }
#define SC_LOAD(cc) do { GLB const unsigned char* src = gpb + (size_t)(cc) * 16 * GP_STRIDE; \
        _Pragma("unroll") for (int it = 0; it < 4; ++it) { const int i = lt + 256 * it, row = i >> 4, c8 = (i & 15) * 8; const int go = (row * 128 + c8) * 2; \
            t0[it] = *(GLB const u32x4*)(src + GP_W + go); t1[it] = *(GLB const u32x4*)(src + GP_QD + go); t2[it] = *(GLB const u32x4*)(src + GP_KD + go); } \
        _Pragma("unroll") for (int it = 0; it < 2; ++it) { const int i = lt + 256 * it, row = i >> 3, c8 = (i & 7) * 8; t3[it] = *(GLB const u32x4*)(src + GP_QK + (row * 64 + c8) * 2); } } while (0)
#define SC_STORE(bufi) do { LAS unsigned char* dst = lds + (bufi) * SC_BUF; \
        _Pragma("unroll") for (int it = 0; it < 4; ++it) { const int i = lt + 256 * it, row = i >> 4, c8 = (i & 15) * 8; const int lo = row * 272 + c8 * 2; \
            *(LAS u32x4*)(dst + SC_W + lo) = t0[it]; *(LAS u32x4*)(dst + SC_QD + lo) = t1[it]; *(LAS u32x4*)(dst + SC_KD + row * SC_KROW + c8 * 2) = t2[it]; } \
        _Pragma("unroll") for (int it = 0; it < 2; ++it) { const int i = lt + 256 * it, row = i >> 3, c8 = (i & 7) * 8; *(LAS u32x4*)(dst + SC_QK + row * 144 + c8 * 2) = t3[it]; } } while (0)
    u32x4 t0[4], t1[4], t2[4], t3[2];
    if (wave >= 4) { SC_LOAD(c0); SC_STORE(0); }
    __syncthreads();
    const float gnw0 = 0.f; (void)gnw0;
    if (wave >= 4) {
        if (nch > 1) SC_LOAD(c0 + 1);
#pragma unroll 1
        for (int n = 0; n < nch; ++n) {
            int tl_ = lane_id_fresh() + wave * 64; asm volatile("" : "+v"(tl_));
            const int lt = tl_ - 256; const bool more = (n + 1) < nch;
        asm volatile("s_waitcnt lgkmcnt(0)" ::: "memory"); __builtin_amdgcn_s_barrier(); asm volatile("" ::: "memory");
            if (more) { SC_STORE((n + 1) & 1); if (n + 2 < nch) SC_LOAD(c0 + n + 2); }
        asm volatile("s_waitcnt lgkmcnt(0)" ::: "memory"); __builtin_amdgcn_s_barrier(); asm volatile("" ::: "memory");
        }
    } else {
    f32x4 gwv[4];
    { GLB const float* gnw = F.in(I_GNW) + l * 128;
#pragma unroll
      for (int g = 0; g < 4; ++g) gwv[g] = *(GLB const f32x4*)(gnw + 32 * w + 8 * g + 4 * h2); }
#pragma unroll 1
    for (int n = 0; n < nch; ++n) {
        const int c = c0 + n;
        int tl_ = lane_id_fresh() + wave * 64; asm volatile("" : "+v"(tl_));
        const int lt = tl_ - 256, lane = tl_ & 63, r32 = lane & 31, h2 = lane >> 5, i16 = lane & 15, q4 = i16 >> 2, p4 = i16 & 3, blk = (lane >> 4) & 1;
        LAS unsigned char* bufp = lds + (n & 1) * SC_BUF;
        f32x16 oT[2];
        h8 VNp[2][2];
        const bool more = (n + 1) < nch;
        float gl = 0.f; h4 zaf[2][4];
            gl = GLp[c * 16 + hd];
            h8 Sp[4][2];
#pragma unroll
            for (int mt = 0; mt < 4; ++mt)
#pragma unroll
                for (int ks = 0; ks < 2; ++ks) { h8 t;
#pragma unroll
                    for (int jj = 0; jj < 8; ++jj) t[jj] = (f16)S[mt][8 * ks + jj];
                    Sp[mt][ks] = t; }
#pragma unroll
            for (int tm = 0; tm < 2; ++tm) {
                h8 wf[8];
#pragma unroll
                for (int kq = 0; kq < 8; ++kq) {
                    LAS unsigned char* ap = bufp + SC_W + (32 * tm + r32) * 272 + 2 * (16 * kq + 4 * h2);
                    const h4 lo = *(const LAS h4*)ap, hi = *(const LAS h4*)(ap + 16);
                    wf[kq] = __builtin_shufflevector(lo, hi, 0, 1, 2, 3, 4, 5, 6, 7);
                }
                f32x16 ws;
#pragma unroll
                for (int i = 0; i < 16; ++i) ws[i] = 0.f;
                SB();
#pragma unroll
                for (int kq = 0; kq < 8; ++kq) ws = MFMA32(wf[kq], Sp[kq >> 1][kq & 1], ws);
                SB();
#pragma unroll
                for (int g = 0; g < 4; ++g)
#pragma unroll
                    for (int jj = 0; jj < 4; ++jj) ws[4 * g + jj] = (float)uf[tm][g][jj] - ws[4 * g + jj];
#pragma unroll
                for (int ks = 0; ks < 2; ++ks) { h8 t;
#pragma unroll
                    for (int jj = 0; jj < 8; ++jj) t[jj] = (f16)ws[8 * ks + jj];
                    VNp[tm][ks] = t; }
            }
            {
                GLB const f16* PROJ = F.PROJ();
#pragma unroll
                for (int tn = 0; tn < 2; ++tn)
#pragma unroll
                    for (int g = 0; g < 4; ++g) zaf[tn][g] = *(GLB const h4*)(PROJ + (size_t)(rs0 + 64 * n + 32 * tn + r32) * PS + C_ZA + hd * 128 + 32 * w + 8 * g + 4 * h2);
            }
#pragma unroll
            for (int tn = 0; tn < 2; ++tn) {
                f32x16 o;
#pragma unroll
                for (int i = 0; i < 16; ++i) o[i] = 0.f;
#pragma unroll
                for (int hb = 0; hb < 2; ++hb) {
                    h8 bf[4];
#pragma unroll
                    for (int kq = 0; kq < 4; ++kq) {
                        LAS unsigned char* bp = bufp + SC_QD + (32 * tn + r32) * 272 + 2 * (16 * (4 * hb + kq) + 4 * h2);
                        const h4 lo = *(const LAS h4*)bp, hi = *(const LAS h4*)(bp + 16);
                        bf[kq] = __builtin_shufflevector(lo, hi, 0, 1, 2, 3, 4, 5, 6, 7);
                    }
                    SB();
#pragma unroll
                    for (int kq = 0; kq < 4; ++kq) o = MFMA32(Sp[(4 * hb + kq) >> 1][kq & 1], bf[kq], o);
                    SB();
                }
                {
                    h8 bf[4];
#pragma unroll
                    for (int kq = 0; kq < 4; ++kq) {
                        LAS unsigned char* bp = bufp + SC_QK + (32 * tn + r32) * 144 + 2 * (16 * kq + 4 * h2);
                        const h4 lo = *(const LAS h4*)bp, hi = *(const LAS h4*)(bp + 16);
                        bf[kq] = __builtin_shufflevector(lo, hi, 0, 1, 2, 3, 4, 5, 6, 7);
                    }
                    SB();
#pragma unroll
                    for (int kq = 0; kq < 4; ++kq) o = MFMA32(VNp[kq >> 1][kq & 1], bf[kq], o);
                    SB();
                }
                oT[tn] = o;
                float sacc = 0.f;
#pragma unroll
                for (int i = 0; i < 16; ++i) sacc += o[i] * o[i];
                sacc += shx32(sacc, lane);
                if (h2 == 0) ssq[w * 64 + 32 * tn + r32] = sacc;
            }
            if (n + 1 < nch) {
                GLB const unsigned char* up = gpb + (size_t)(c + 1) * 16 * GP_STRIDE + GP_U;
#pragma unroll
                for (int tm = 0; tm < 2; ++tm)
#pragma unroll
                    for (int g = 0; g < 4; ++g) uf[tm][g] = *(GLB const h4*)(up + (((w * 2 + tm) * 4 + g) * 64 + lane) * 8);
            }
        asm volatile("s_waitcnt lgkmcnt(0)" ::: "memory"); __builtin_amdgcn_s_barrier(); asm volatile("" ::: "memory");
        {
#pragma unroll
            for (int tn = 0; tn < 2; ++tn) {
                const int tok = 32 * tn + r32;
                const float tot = ssq[tok] + ssq[64 + tok] + ssq[128 + tok] + ssq[192 + tok];
                const float rstd = rsqrtf(tot * (1.0f / 128.0f) + EPS);
                const size_t rs = (size_t)(rs0 + 64 * n + tok);
#pragma unroll
                for (int g = 0; g < 4; ++g) {
                    const int dv0 = 32 * w + 8 * g + 4 * h2;
                    const f32x4 gw = gwv[g];
                    const h4 za = zaf[tn][g];
                    h4 ov;
#pragma unroll
                    for (int jj = 0; jj < 4; ++jj) ov[jj] = (f16)(oT[tn][4 * g + jj] * rstd * gw[jj] * (float)za[jj]);
                    *(GLB h4*)(F.OA() + rs * 2048 + hd * 128 + dv0) = ov;
                }
            }
#pragma unroll
            for (int mp = 0; mp < 2; ++mp) {
                h8 kf[2][4];
#pragma unroll
                for (int ml = 0; ml < 2; ++ml)
#pragma unroll
                    for (int kq = 0; kq < 4; ++kq) {
                        LAS unsigned char* ap = bufp + SC_KD + (16 * kq + 4 * h2 + q4) * SC_KROW + 64 * (2 * mp + ml) + 8 * (4 * blk + p4);
                        const fp16x4_t lo = __builtin_amdgcn_ds_read_tr16_b64_v4f16((LAS fp16x4_t*)ap);
                        const fp16x4_t hi = __builtin_amdgcn_ds_read_tr16_b64_v4f16((LAS fp16x4_t*)(ap + 8 * SC_KROW));
                        kf[ml][kq] = __builtin_shufflevector(__builtin_bit_cast(h4, lo), __builtin_bit_cast(h4, hi), 0, 1, 2, 3, 4, 5, 6, 7);
                    }
#pragma unroll
                for (int i = 0; i < 16; ++i) { S[2 * mp][i] *= gl; S[2 * mp + 1][i] *= gl; }
                SB();
#pragma unroll
                for (int kq = 0; kq < 4; ++kq) { S[2 * mp] = MFMA32(kf[0][kq], VNp[kq >> 1][kq & 1], S[2 * mp]); S[2 * mp + 1] = MFMA32(kf[1][kq], VNp[kq >> 1][kq & 1], S[2 * mp + 1]); }
                SB();
            }
        }
        asm volatile("s_waitcnt lgkmcnt(0)" ::: "memory"); __builtin_amdgcn_s_barrier(); asm volatile("" ::: "memory");
    }
    }
#undef SC_LOAD
#undef SC_STORE
    if (wave < 4) {
        GLB float* so = F.out() + (smp ? O_NGS : O_NGP) + ((size_t)(l * 16 + b) * 16 + hd) * 16384;
#pragma unroll
        for (int mt = 0; mt < 4; ++mt)
#pragma unroll
            for (int i = 0; i < 16; ++i) so[(32 * mt + (i & 3) + 8 * (i >> 2) + 4 * h2) * 128 + 32 * w + r32] = S[mt][i];
    }
    __syncthreads();
    if (PROBE_T && (lane_id_fresh() + F0.wave * 64) == 0) __hip_atomic_fetch_add((unsigned long long*)(F0.ctl() + CW_T) + 9, (unsigned long long)((unsigned)clock64() - tst_9), __ATOMIC_RELAXED, __HIP_MEMORY_SCOPE_AGENT);
}

template <int NKMAX>
DI void select_rows(GLB const float* scr, GLB unsigned long long* mask, int wave, int lane, int nk, int nvis) {
#pragma unroll 1
    for (int r = 0; r < 4; ++r) {
        const int q = wave * 4 + r;
        unsigned u[NKMAX];
#pragma unroll
        for (int k = 0; k < NKMAX; ++k) u[k] = __float_as_uint(scr[(size_t)q * LDR + 64 * k + lane]);
        asm volatile("" ::: "memory");
#pragma unroll
        for (int k = 0; k < NKMAX; ++k) u[k] = (k < nk) ? sortable(__uint_as_float(u[k])) : 0u;
        unsigned thr = 0u;
        if (nvis > 256) {
#pragma unroll 1
            for (int bit = 31; bit >= 0; --bit) {
                const unsigned cand = thr | (1u << bit);
                int c = 0;
#pragma unroll
                for (int k = 0; k < NKMAX; ++k) c += (int)__popcll(__ballot(u[k] >= cand));
                if (c >= 256) thr = cand;
                if (c == 256) break;
            }
        }
#pragma unroll
        for (int k = 0; k < NKMAX; ++k) { const unsigned long long bal = __ballot(u[k] >= thr); if (k < nk && lane == 0) mask[q * 65 + k] = bal; }
    }
}

DI unsigned wave_prefix_incl(unsigned v) {
    v += (unsigned)__builtin_amdgcn_update_dpp(0, (int)v, 0x111, 0xf, 0xf, true);
    v += (unsigned)__builtin_amdgcn_update_dpp(0, (int)v, 0x112, 0xf, 0xf, true);
    v += (unsigned)__builtin_amdgcn_update_dpp(0, (int)v, 0x114, 0xf, 0xf, true);
    v += (unsigned)__builtin_amdgcn_update_dpp(0, (int)v, 0x118, 0xf, 0xf, true);
    v += (unsigned)__builtin_amdgcn_update_dpp(0, (int)v, 0x142, 0xa, 0xf, false);
    v += (unsigned)__builtin_amdgcn_update_dpp(0, (int)v, 0x143, 0xc, 0xf, false);
    return v;
}
template <int NKMAX>
DI void select_rows_hist(GLB const float* scr, GLB unsigned long long* mask, LAS unsigned* hist, int wave, int lane, int nk, unsigned* chk) {
#pragma unroll 1
    for (int r = 0; r < 4; ++r) {
        const int q = wave * 4 + r;
        unsigned u[NKMAX];
#pragma unroll
        for (int k = 0; k < NKMAX; ++k) u[k] = __float_as_uint(scr[(size_t)q * LDR + 64 * k + lane]);
        asm volatile("" ::: "memory");
#pragma unroll
        for (int k = 0; k < NKMAX; ++k) u[k] = (k < nk) ? sortable(__uint_as_float(u[k])) : 0u;
        unsigned prefix = 0u, pmask = 0u, need = 256u;
#pragma unroll 1
        for (int pass = 0; pass < 3; ++pass) {
            const int shift = pass == 0 ? 21 : (pass == 1 ? 10 : 0);
            const unsigned bm = pass == 2 ? 1023u : 2047u;
#pragma unroll
            for (int i = 0; i < 8; ++i) *(LAS u32x4*)(hist + (i * 64 + lane) * 4) = (u32x4){0u, 0u, 0u, 0u};
#pragma unroll
            for (int k = 0; k < NKMAX; ++k)
                if (k < nk && (u[k] & pmask) == prefix) __hip_atomic_fetch_add(hist + ((u[k] >> shift) & bm), 1u, __ATOMIC_RELAXED, __HIP_MEMORY_SCOPE_WORKGROUP);
            unsigned s = 0u;
#pragma unroll
            for (int i = 0; i < 8; ++i) { const u32x4 v = *(const LAS u32x4*)(hist + (63 - lane) * 32 + 4 * i); s += v[0] + v[1] + v[2] + v[3]; }
            const unsigned P = wave_prefix_incl(s);
            const int Ls = (int)__builtin_ctzll(__ballot(P >= need));
            const unsigned above = (unsigned)__builtin_amdgcn_readlane((int)(P - s), Ls);
            const int grp = 63 - Ls;
            const unsigned hb = hist[grp * 32 + 31 - (lane & 31)];
            const unsigned Pb = wave_prefix_incl(hb);
            const int js = (int)__builtin_ctzll(__ballot(above + Pb >= need));
            need -= (unsigned)__builtin_amdgcn_readlane((int)(above + Pb - hb), js);
            prefix |= (unsigned)(grp * 32 + 31 - js) << shift; pmask |= bm << shift;
        }
        const unsigned thr = prefix;
        if (SELCHK) {
            unsigned t2 = 0u;
#pragma unroll 1
            for (int bit = 31; bit >= 0; --bit) { const unsigned cand = t2 | (1u << bit); int c = 0;
#pragma unroll
                for (int k = 0; k < NKMAX; ++k) c += (int)__popcll(__ballot(u[k] >= cand));
                if (c >= 256) t2 = cand; }
            bool bad = false;
#pragma unroll
            for (int k = 0; k < NKMAX; ++k) bad |= (k < nk) && (__ballot(u[k] >= thr) != __ballot(u[k] >= t2));
            if (bad && lane == 0) __hip_atomic_fetch_add(chk, 1u, __ATOMIC_RELAXED, __HIP_MEMORY_SCOPE_AGENT);
        }
#pragma unroll
        for (int k = 0; k < NKMAX; ++k) { const unsigned long long bal = __ballot(u[k] >= thr); if (k < nk && lane == 0) mask[q * 65 + k] = bal; }
    }
}

DI void attn_sel_unit(const Frame& F0, int l, int slab, int rs0) {
    const unsigned tst_11 = PROBE_T ? (unsigned)clock64() : 0u;
    const Frame F = F0.fresh();
    const int tid = F.tid, lane = F.lane, wave = F.wave, r32 = lane & 31, h2 = lane >> 5;
    LAS unsigned char* lds = F.lds;
    GLB unsigned long long* mask = (GLB unsigned long long*)(F.ws() + WS_MASK) + (size_t)(rs0 >> 5) * 32 * 65;
    LAS float* wil = (LAS float*)(lds + AT_WI);
    int R0, sq, t0; rowinfo(slab, rs0, R0, sq, t0);
    const bool smp = sq >= 16;
    const int qpos0 = (smp ? PAST : 0) + t0, nvis = 64 * (qpos0 / 64 + 1), nk = nvis >> 6, pb = posbase(sq);
    GLB float* scr = (GLB float*)(F.ws() + WS_SCR) + (size_t)F.bid * 32 * LDR;
    GLB const f16* PROJ = F.PROJ();
#pragma unroll
    for (int it = 0; it < 8; ++it) { const int i = tid + NTHR * it, row = i >> 7, c8 = (i & 127) * 8;
        *(LAS h8*)(lds + AT_QI + (row * AT_QIS + c8) * 2) = *(GLB const h8*)(PROJ + (size_t)(rs0 + row) * PS + C_QI + c8); }
    wil[tid] = F.WI()[(size_t)(R0 + (tid >> 4)) * 16 + (tid & 15)];
    __syncthreads();
    {
    {
        GLB const f16* KI = F.KIU();
        h8 an[2][4];
        { const int p0 = wave < nk ? wave : 0;
#pragma unroll
          for (int tl = 0; tl < 2; ++tl)
#pragma unroll
            for (int s = 0; s < 4; ++s) an[tl][s] = *(GLB const h8*)(KI + (size_t)(pb + 64 * p0 + 32 * tl + r32) * 64 + 16 * s + 8 * h2); }
#pragma unroll 1
        for (int pp = wave; pp < ((PROBE_REP & 512) ? 2 * nk : nk); pp += 8) { const int p = pp >= nk ? pp - nk : pp;
            h8 a[2][4];
#pragma unroll
            for (int tl = 0; tl < 2; ++tl)
#pragma unroll
                for (int s = 0; s < 4; ++s) a[tl][s] = an[tl][s];
            { const int pn = (pp + 8 >= nk && !(PROBE_REP & 512)) ? p : ((pp + 8) >= nk ? pp + 8 - nk : pp + 8), pq = pn < nk ? pn : p;
#pragma unroll
              for (int tl = 0; tl < 2; ++tl)
#pragma unroll
                for (int s = 0; s < 4; ++s) an[tl][s] = *(GLB const h8*)(KI + (size_t)(pb + 64 * pq + 32 * tl + r32) * 64 + 16 * s + 8 * h2); }
            f32x16 sc0, sc1;
#pragma unroll
            for (int i = 0; i < 16; ++i) { sc0[i] = 0.f; sc1[i] = 0.f; }
#pragma unroll 2
            for (int h = 0; h < 16; ++h) {
                h8 b[4];
#pragma unroll
                for (int s = 0; s < 4; ++s) b[s] = *(const LAS h8*)(lds + AT_QI + (r32 * AT_QIS + h * 64 + 16 * s + 8 * h2) * 2);
                f32x16 c0, c1;
#pragma unroll
                for (int i = 0; i < 16; ++i) { c0[i] = 0.f; c1[i] = 0.f; }
#pragma unroll
                for (int s = 0; s < 4; ++s) { c0 = MFMA32(a[0][s], b[s], c0); c1 = MFMA32(a[1][s], b[s], c1); }
                const float w = wil[r32 * 16 + h];
#pragma unroll
                for (int i = 0; i < 16; ++i) { sc0[i] += w * fmaxf(c0[i], 0.f); sc1[i] += w * fmaxf(c1[i], 0.f); }
            }
            GLB float* o = scr + (size_t)r32 * LDR + 64 * p + 4 * h2;
#pragma unroll
            for (int g = 0; g < 4; ++g) { *(GLB f32x4*)(o + 8 * g) = (f32x4){sc0[4 * g], sc0[4 * g + 1], sc0[4 * g + 2], sc0[4 * g + 3]};
                                          *(GLB f32x4*)(o + 32 + 8 * g) = (f32x4){sc1[4 * g], sc1[4 * g + 1], sc1[4 * g + 2], sc1[4 * g + 3]}; }
        }
    }
    asm volatile("s_waitcnt vmcnt(0)" ::: "memory");
    __syncthreads();
    __builtin_amdgcn_fence(__ATOMIC_ACQUIRE, "agent");
    { int lane2 = lane; asm volatile("" : "+v"(lane2));
      LAS unsigned* hist = (LAS unsigned*)(lds + wave * 8192);
      unsigned* chk = F.ctl() + CW_T + 1024;
      if (nk > 32) select_rows_hist<65>(scr, mask, hist, wave, lane2, nk, chk); else if (nk > 16) select_rows_hist<32>(scr, mask, hist, wave, lane2, nk, chk);
      else if (nk > 8) select_rows<16>(scr, mask, wave, lane2, nk, nvis); else select_rows<8>(scr, mask, wave, lane2, nk, nvis); }
    __syncthreads();
    }
    if (PROBE_T && (lane_id_fresh() + F0.wave * 64) == 0) __hip_atomic_fetch_add((unsigned long long*)(F0.ctl() + CW_T) + 11, (unsigned long long)((unsigned)clock64() - tst_11), __ATOMIC_RELAXED, __HIP_MEMORY_SCOPE_AGENT);
}
DI void attn_pv_unit(const Frame& F0, int l, int slab, int rs0, int n) {
    const Frame F = F0.fresh();
    unsigned tacc[9] = {0, 0, 0, 0, 0, 0, 0, 0, 0}; unsigned tlast = PROBE_T ? (unsigned)clock64() : 0u; const unsigned tstart = tlast;
#define TICK(k) do { if (PROBE_T) { const unsigned now_ = (unsigned)clock64(); tacc[k] += now_ - tlast; tlast = now_; } } while (0)
    const int tid = F.tid, lane = F.lane, wave = F.wave, r32 = lane & 31, h2 = lane >> 5;
    LAS unsigned char* lds = F.lds;
    LAS unsigned long long* mask = (LAS unsigned long long*)(lds + AT_MASK);
    LAS float* bt = (LAS float*)(lds + AT_BT);
    int R0, sq, t0; rowinfo(slab, rs0, R0, sq, t0);
    const bool smp = sq >= 16;
    const int qpos0 = (smp ? PAST : 0) + t0, nk = qpos0 / 64 + 1, pb = posbase(sq);
    GLB const f16* PROJ = F.PROJ();
    {
        GLB const unsigned long long* mg = (GLB const unsigned long long*)(F.ws() + WS_MASK) + (size_t)(rs0 >> 5) * 32 * 65;
        for (int i = tid; i < 32 * nk; i += NTHR) { const int q = i / nk, k = i - q * nk; mask[q * 65 + k] = mg[q * 65 + k]; }
        GLB const float* rb = F.in(I_RELB);
        for (int i = tid; i < 8 * 192; i += NTHR) { const int h = i / 192, rel = (i % 192) - 128; bt[(8 * n + h) * 192 + (i % 192)] = rb[rel_bucket(rel) * 16 + 8 * n + h] * LOG2E; }
    }
    __syncthreads();
    GLB const f16* KU = F.KU(); GLB const f16* VU = F.VU();
    const int i16 = lane & 15, q4 = i16 >> 2, p4 = i16 & 3, blk = (lane >> 4) & 1;
    {
        const int hq = 8 * n + wave;
        h8 qf[8];
#pragma unroll
        for (int s = 0; s < 8; ++s) qf[s] = *(GLB const h8*)(PROJ + (size_t)(rs0 + r32) * PS + C_QB + hq * 128 + 16 * s + 8 * h2);
        const float b15 = bt[hq * 192];
        f32x16 O[4];
#pragma unroll
        for (int mt = 0; mt < 4; ++mt)
#pragma unroll
            for (int i = 0; i < 16; ++i) O[mt][i] = 0.f;
        float m = -1e30f, lsum = 0.f;
        u32x4 kreg[2], vreg[2];
        const int srow = tid >> 4, sc8 = (tid & 15) * 8;
#define AT_LOAD(j) do { _Pragma("unroll") for (int it = 0; it < 2; ++it) { const size_t go = (size_t)(pb + 64 * (j) + srow + 32 * it) * 256 + n * 128 + sc8; \
            kreg[it] = *(GLB const u32x4*)(KU + go); vreg[it] = *(GLB const u32x4*)(VU + go); } } while (0)
#define AT_STORE(b) do { _Pragma("unroll") for (int it = 0; it < 2; ++it) { const int lo = AT_KV + (b) * AT_BUF + (srow + 32 * it) * AT_ROW + sc8 * 2; \
            *(LAS u32x4*)(lds + lo) = kreg[it]; *(LAS u32x4*)(lds + AT_KV + (b) * AT_BUF + AT_V + (srow + 32 * it) * AT_VROW + sc8 * 2) = vreg[it]; } } while (0)
        const bool grpB = wave >= 4;
        TICK(8);
        AT_LOAD(0); AT_STORE(0);
        if (grpB && nk > 1) AT_LOAD(1);
            asm volatile("s_waitcnt lgkmcnt(0)" ::: "memory"); __builtin_amdgcn_s_barrier(); asm volatile("" ::: "memory");
        if (grpB) {
            asm volatile("s_waitcnt lgkmcnt(0)" ::: "memory"); __builtin_amdgcn_s_barrier(); asm volatile("" ::: "memory");
        }
#pragma unroll 1
        for (int j = 0; j < nk; ++j) {
            const bool more = (j + 1) < nk;
            TICK(0);
            if (!grpB && more) AT_LOAD(j + 1);
            LAS unsigned char* kb = lds + AT_KV + (j & 1) * AT_BUF;
            LAS unsigned char* vb = kb + AT_V;
            f32x16 st[2];
#pragma unroll 1
            for (int prb_ = 0; prb_ < ((PROBE_REP & 2048) ? 2 : 1); ++prb_)
#pragma unroll
            for (int sub = 0; sub < 2; ++sub) {
                h8 ka[8];
#pragma unroll
                for (int s = 0; s < 8; ++s) ka[s] = *(const LAS h8*)(kb + (32 * sub + r32) * AT_ROW + 32 * s + 16 * h2);
                f32x16 c0;
#pragma unroll
                for (int i = 0; i < 16; ++i) c0[i] = 0.f;
                SB(); PRIO(1);
#pragma unroll
                for (int s = 0; s < 8; ++s) c0 = MFMA32(ka[s], qf[s], c0);
                PRIO(0); SB();
                st[sub] = c0;
            }
            TICK(1);
            const bool far = (64 * j + 63 - qpos0) <= -128;
            float mx = -1e30f;
            if (far) {
#pragma unroll
                for (int sub = 0; sub < 2; ++sub)
#pragma unroll
                    for (int i = 0; i < 16; ++i) mx = fmaxf(mx, st[sub][i]);
                mx = mx * SCL2 + b15;
            } else {
                const int relb = 64 * j + 4 * h2 - (qpos0 + r32) + 128;
#pragma unroll
                for (int sub = 0; sub < 2; ++sub)
#pragma unroll
                    for (int i = 0; i < 16; ++i) { int ri = relb + 32 * sub + (i & 3) + 8 * (i >> 2); ri = ri < 0 ? 0 : ri;
                        st[sub][i] = st[sub][i] * SCL2 + bt[hq * 192 + ri]; mx = fmaxf(mx, st[sub][i]); }
            }
            mx = fmaxf(mx, shx32(mx, lane));
            if (__any(mx > m + 8.0f)) {
                const float mup = fmaxf(m, mx), alpha = __builtin_amdgcn_exp2f(m - mup);
                m = mup;
                lsum *= alpha;
#pragma unroll
                for (int mt = 0; mt < 4; ++mt)
#pragma unroll
                    for (int i = 0; i < 16; ++i) O[mt][i] *= alpha;
            }
            const float mnew = m;
            TICK(2);
            if (grpB && more) AT_STORE((j + 1) & 1);
            asm volatile("s_waitcnt lgkmcnt(0)" ::: "memory"); __builtin_amdgcn_s_barrier(); asm volatile("" ::: "memory");
            TICK(3);
            if (grpB && (j + 2) < nk) AT_LOAD(j + 2);
            const unsigned long long mw = mask[r32 * 65 + j];
            float ps = 0.f;
            h8 pf[2][2];
            const float esc = far ? SCL2 : 1.0f, ecst = (far ? b15 : 0.f) - mnew;
            const ::h2 ones2 = {(f16)1.f, (f16)1.f};
#pragma unroll
            for (int sub = 0; sub < 2; ++sub) {
                const unsigned wsh = ((unsigned)(mw >> (32 * sub))) >> (4 * h2);
                u32x4 pw[2];
#pragma unroll
                for (int pr = 0; pr < 8; ++pr) {
                    const int i0 = 2 * pr, cb = (i0 & 3) + 8 * (i0 >> 2);
                    const float e0 = __builtin_amdgcn_exp2f(st[sub][i0] * esc + ecst), e1 = __builtin_amdgcn_exp2f(st[sub][i0 + 1] * esc + ecst);
                    const unsigned b0 = (unsigned)__builtin_amdgcn_sbfe((int)wsh, cb, 1), b1 = (unsigned)__builtin_amdgcn_sbfe((int)wsh, cb + 1, 1);
                    const unsigned mk = (b0 & 0xFFFFu) | (b1 & 0xFFFF0000u);
                    const unsigned pk = pk_f16(e0, e1) & mk;
                    ps = __builtin_amdgcn_fdot2(__builtin_bit_cast(::h2, pk), ones2, ps, false);
                    pw[pr >> 2][pr & 3] = pk;
                }
                pf[sub][0] = __builtin_bit_cast(h8, pw[0]); pf[sub][1] = __builtin_bit_cast(h8, pw[1]);
            }
            lsum += ps;
            TICK(4);
#pragma unroll 1
            for (int prb_ = (PROBE_REP & 4096) ? 0 : 1; prb_ < 2; ++prb_) {
            h8 pu[2][2];
            { float zr = prb_ ? 1.0f : 0.0f; asm volatile("" : "+v"(zr));
#pragma unroll
              for (int a_ = 0; a_ < 2; ++a_)
#pragma unroll
                for (int b_ = 0; b_ < 2; ++b_) { h8 t = pf[a_][b_];
                    if (PROBE_REP & 4096) {
#pragma unroll
                        for (int jj = 0; jj < 8; ++jj) t[jj] = (f16)((float)t[jj] * zr); }
                    pu[a_][b_] = t; } }
#pragma unroll
            for (int mp = 0; mp < 2; ++mp) {
                h8 va[2][4];
#pragma unroll
                for (int ml = 0; ml < 2; ++ml)
#pragma unroll
                    for (int sub = 0; sub < 2; ++sub)
#pragma unroll
                        for (int ks = 0; ks < 2; ++ks) {
                            LAS unsigned char* ap = vb + (32 * sub + 16 * ks + 4 * h2 + q4) * AT_VROW + 64 * (2 * mp + ml) + 8 * (4 * blk + p4);
                            const fp16x4_t lo = __builtin_amdgcn_ds_read_tr16_b64_v4f16((LAS fp16x4_t*)ap);
                            const fp16x4_t hi = __builtin_amdgcn_ds_read_tr16_b64_v4f16((LAS fp16x4_t*)(ap + 8 * AT_VROW));
                            va[ml][sub * 2 + ks] = __builtin_shufflevector(__builtin_bit_cast(h4, lo), __builtin_bit_cast(h4, hi), 0, 1, 2, 3, 4, 5, 6, 7);
                        }
                SB(); PRIO(1);
#pragma unroll
                for (int kk = 0; kk < 4; ++kk) { O[2 * mp] = MFMA32(va[0][kk], pu[kk >> 1][kk & 1], O[2 * mp]); O[2 * mp + 1] = MFMA32(va[1][kk], pu[kk >> 1][kk & 1], O[2 * mp + 1]); }
                PRIO(0); SB();
            }
            }
            TICK(5);
            if (!grpB && more) AT_STORE((j + 1) & 1);
            asm volatile("s_waitcnt lgkmcnt(0)" ::: "memory"); __builtin_amdgcn_s_barrier(); asm volatile("" ::: "memory");
        }
        if (!grpB) {
            asm volatile("s_waitcnt lgkmcnt(0)" ::: "memory"); __builtin_amdgcn_s_barrier(); asm volatile("" ::: "memory");
        }
#undef AT_LOAD
#undef AT_STORE
        TICK(6);
        const float ltot = lsum + shx32(lsum, lane), inv = 1.0f / ltot;
        const size_t orow = (size_t)(rs0 + r32);
        GLB const f16* zp = PROJ + orow * PS + C_ZB + hq * 128 + 4 * h2;
        GLB f16* ob = F.OB() + orow * 2048 + hq * 128 + 4 * h2;
        h4 zbv[4][4];
#pragma unroll
        for (int mt = 0; mt < 4; ++mt)
#pragma unroll
            for (int g = 0; g < 4; ++g) zbv[mt][g] = *(GLB const h4*)(zp + 32 * mt + 8 * g);
        asm volatile("" ::: "memory");
#pragma unroll
        for (int mt = 0; mt < 4; ++mt)
#pragma unroll
            for (int g = 0; g < 4; ++g) {
                h4 ov;
#pragma unroll
                for (int jj = 0; jj < 4; ++jj) ov[jj] = (f16)(O[mt][4 * g + jj] * inv * (float)zbv[mt][g][jj]);
                *(GLB h4*)(ob + 32 * mt + 8 * g) = ov;
            }
    }
    if (PROBE_T && tid == 0) { TICK(7); tacc[7] = tlast - tstart;
        unsigned long long* tc = (unsigned long long*)(F.ctl() + CW_T);
#pragma unroll
        for (int k_ = 0; k_ < 9; ++k_) __hip_atomic_fetch_add(tc + k_, (unsigned long long)tacc[k_], __ATOMIC_RELAXED, __HIP_MEMORY_SCOPE_AGENT); }
#undef TICK
    __syncthreads();
}

DI void ab_tile_unit(const Frame& F, int l, int t);
DI void out_tile_unit(const Frame& F, int l, int t);
DI void phase_mix(const Frame F0, int l, int slab, int rep = 0) {
    const Frame F = F0.fresh();
    LAS int* ubox = (LAS int*)(F.lds + LDS_MISC + 64);
    const int xcc = (int)(xb_xcc_id() & 7u);
    const int nex = slab == 1 ? 4 : 0;
    const int nsc = 8 + (slab == 0 ? 32 : 0), nsb = slab == 0 ? 8 : 0, total = nex + nsc + nsb + 64;
#pragma unroll 1
    for (int qq = 0; qq < 8; ++qq) {
        const int q = (xcc + qq) & 7;
        unsigned* ctr = F.ctl() + CW_Q + ((rep * 8 + l * NSLAB + slab) * 8 + q) * 64;
        for (;;) {
            if (F.tid == 0) ubox[0] = (int)__hip_atomic_fetch_add(ctr, 1u, __ATOMIC_RELAXED, __HIP_MEMORY_SCOPE_AGENT);
            __syncthreads();
            const int u0 = ubox[0];
            __syncthreads();
            if (u0 >= total) break;
            if (u0 < nex) { out_tile_unit(F, l, u0 * 8 + q); continue; }
            const int u = u0 - nex;
            if (u < 8) { const int cu = u * 8 + q; gdn_scan_unit(F, l, slab, slab * 4 + (cu >> 4), cu & 15);
                if (PROBE_REP & 256) gdn_scan_unit(F, l, slab, slab * 4 + (cu >> 4), cu & 15); }
            else if (u < nsc) { const int v = (u - 8) * 8 + q; gdn_scan_unit(F, l, slab, 16 + (v >> 4), v & 15); }
            else if (u < nsc + nsb) { const int w = u - nsc; attn_pv_unit(F, l, slab, 8192 + 32 * ((w >> 1) * 8 + q), w & 1); }
            else { const int k = u - nsc - nsb; attn_pv_unit(F, l, slab, (q & 3) * 2048 + (63 - (2 * (k >> 1) + (q >> 2))) * 32, k & 1); }
        }
    }
}
DI void phase_pre(const Frame F0, int l, int slab, int rep = 0) {
    const Frame F = F0.fresh();
    LAS int* ubox = (LAS int*)(F.lds + LDS_MISC + 64);
    unsigned* ctr = F.ctl() + CW_Q + (128 + rep * 8 + l * NSLAB + slab) * 64;
    const int nex = slab == 1 ? 32 : 0;
    const int nsel = ts_of(slab) / 32, nc = slab == 0 ? 144 : 128, total = nex + nsel + nc * 16;
    int nxt = 0;
    if (F.tid == 0) nxt = (int)__hip_atomic_fetch_add(ctr, 1u, __ATOMIC_RELAXED, __HIP_MEMORY_SCOPE_AGENT);
    for (;;) {
        if (F.tid == 0) ubox[0] = nxt;
        __syncthreads();
        const int u0 = ubox[0];
        __syncthreads();
        if (u0 >= total) break;
        if (F.tid == 0) nxt = (int)__hip_atomic_fetch_add(ctr, 1u, __ATOMIC_RELAXED, __HIP_MEMORY_SCOPE_AGENT);
        if (u0 < nex) { ab_tile_unit(F, l, u0); continue; }
        const int u = u0 - nex;
        if (u < nsel) {
            int q = u, rs0;
            if (slab == 0 && q < 32) rs0 = 8192 + 32 * q;
            else { if (slab == 0) q -= 32; rs0 = (q & 3) * 2048 + (63 - (q >> 2)) * 32; }
            attn_sel_unit(F, l, slab, rs0);
        } else { const int v = u - nsel; gdn_pre_unit(F, l, slab, v >> 4, v & 15); }
    }
}
DI void phase_final(const Frame F0) {
    const Frame F = F0.fresh();
    if (PROBE_T) { const unsigned long long tot = __hip_atomic_load((unsigned long long*)(F.ctl() + CW_T) + (PROBE_T - 1), __ATOMIC_RELAXED, __HIP_MEMORY_SCOPE_AGENT);
        const long long target = (long long)(tot / (unsigned long long)F.G); const long long t0 = clock64(); while (clock64() - t0 < target) __builtin_amdgcn_s_sleep(1); }
    const bool selbad = SELCHK && __hip_atomic_load(F.ctl() + CW_T + 1024, __ATOMIC_RELAXED, __HIP_MEMORY_SCOPE_AGENT) != 0u;
    GLB const float* nw = F.in(I_FNW);
    f32x4 nwv[8];
#pragma unroll
    for (int i = 0; i < 8; ++i) nwv[i] = *(GLB const f32x4*)(nw + (i * 64 + F.lane) * 4);
    for (int R = F.bid * NWAVES + F.wave; R < NTOK; R += F.G * NWAVES) {
        GLB float* x = F.out() + (size_t)R * D;
        f32x4 v[8]; float ss = 0.f;
#pragma unroll
        for (int i = 0; i < 8; ++i) { v[i] = *(GLB const f32x4*)(x + (i * 64 + F.lane) * 4); ss += v[i][0] * v[i][0] + v[i][1] * v[i][1] + v[i][2] * v[i][2] + v[i][3] * v[i][3]; }
        ss = wave_sum(ss, F.lane);
        const float r = rsqrtf(ss * (1.0f / 2048.0f) + EPS);
#pragma unroll
        for (int i = 0; i < 8; ++i) { const int c = (i * 64 + F.lane) * 4; *(GLB f32x4*)(x + c) = v[i] * (selbad ? __builtin_nanf("") : r) * nwv[i]; }
    }
}

DI void phase_inproj(const Frame F, int l, int s, int part, int Gg, int gidx) {
    const int Ts = ts_of(s);
    pg8::Gemm g{F.H(s & 1), F.WIN() + (size_t)l * NP * 2048, F.H(s & 1), F.WIN() + (size_t)l * NP * 2048, Ts, NP, 2048};
    pg8::SubOrder S; S.init2(Ts, part, Gg, gidx);
    EpiProj E{F.PROJ(), F.out(), F.KU(), F.VU(), F.KIU(), F.WI(), F.BETA(), F.GG(), F.in(I_ALOG) + l * 16, F.in(I_DTB) + l * 16, l, s};
    pg8::gemm_phase<EpiProj, pg8::SubOrder>(F.lds, g, S, E, F.wave);
}
DI void ab_tile_unit(const Frame& F, int l, int t) {
    pg8::Gemm g{F.OA(), F.WA() + (size_t)l * 2048 * 2048, F.OB(), F.WB() + (size_t)l * 2048 * 2048, 9216, 2048, 2048};
    pg8::OneTile S{32 + (t >> 3), t & 7, 2};
    EpiAB E{F.PROJ(), F.MG()};
    pg8::gemm_phase<EpiAB, pg8::OneTile>(F.lds, g, S, E, F.wave);
}
DI void out_tile_unit(const Frame& F, int l, int t) {
    pg8::Gemm g{F.MG(), F.WO() + (size_t)l * 2048 * 2048, F.MG(), F.WO() + (size_t)l * 2048 * 2048, 9216, 2048, 2048};
    pg8::OneTile S{32 + (t >> 3), t & 7, 1};
    EpiOut E{F.in(I_XP), F.in(I_XS), F.out(), F.ADA() + (size_t)l * 32 * 6144, l, 0};
    pg8::gemm_phase<EpiOut, pg8::OneTile>(F.lds, g, S, E, F.wave);
}
DI void phase_ab(const Frame F, int l, int s) {
    const int Ts = 8192;
    pg8::Gemm g{F.OA(), F.WA() + (size_t)l * 2048 * 2048, F.OB(), F.WB() + (size_t)l * 2048 * 2048, Ts, 2048, 2048};
    pg8::DualOrder S; S.init(Ts, 2048, F.G, F.bid);
    EpiAB E{F.PROJ(), F.MG()};
    pg8::gemm_phase<EpiAB, pg8::DualOrder>(F.lds, g, S, E, F.wave);
}
DI void phase_outp(const Frame F, int l, int s) {
    const int Ts = 8192;
    pg8::Gemm g{F.MG(), F.WO() + (size_t)l * 2048 * 2048, F.MG(), F.WO() + (size_t)l * 2048 * 2048, Ts, 2048, 2048};
    pg8::StaticOrder S; S.init(Ts, 2048, F.G, F.bid);
    EpiOut E{F.in(I_XP), F.in(I_XS), F.out(), F.ADA() + (size_t)l * 32 * 6144, l, s};
    pg8::gemm_phase<EpiOut, pg8::StaticOrder>(F.lds, g, S, E, F.wave);
}
constexpr int NPH = 4;
constexpr int N_PHASES = 3 + 2 * NSLAB * NPH + 1;
constexpr int JG = 20;
__global__ void __launch_bounds__(NTHR, 2) fwd_kernel(Args args) {
    extern __shared__ __attribute__((aligned(16))) unsigned char lds[];
    Frame F;
    F.lds = (LAS unsigned char*)lds;
    F.tid = threadIdx.x; F.lane = F.tid & 63; F.wave = __builtin_amdgcn_readfirstlane(F.tid >> 6); F.G = gridDim.x; F.bid = blockIdx.x;
    if (F.tid < 22) *(LAS unsigned long long*)(F.lds + LDS_TAB + 8 * F.tid) = (unsigned long long)args.in[F.tid];
    if (F.tid == 22) *(LAS unsigned long long*)(F.lds + LDS_TAB + 8 * 22) = (unsigned long long)args.out;
    if (F.tid == 23) *(LAS unsigned long long*)(F.lds + LDS_TAB + 8 * 23) = (unsigned long long)args.ws;
    volatile LAS unsigned* MISC = (volatile LAS unsigned*)(F.lds + LDS_MISC);
    if (F.tid < 64) MISC[F.tid] = 0u;
    __syncthreads();
    const int lo = args.ph_lo, hi = args.ph_hi;
    const bool multi = (hi - lo) > 1;
    if (multi) (void)xcd_barrier_post(F.ctl() + CW_BAR, MISC);
    const int jcls = F.bid >> 3, JGe = (F.G >> 3) * JG / 32, Gg = JGe * 8;
    const bool isG = jcls < JGe; const int gidx = jcls * 8 + (F.bid & 7);
#define IN(k) (lo <= (k) && (k) < hi)
#define GBAR() do { XcdBarrier bar_; bar_.bar = F.ctl() + CW_BAR; bar_.x = xb_xcc_id(); bar_.st = MISC; xcd_barrier(bar_, (int)(lane_id_fresh() == 0 && F.wave == 0)); } while (0)
#define SEAM(k) do { if (IN(k) && IN((k) + 1)) { XcdBarrier bar_; bar_.bar = F.ctl() + CW_BAR; bar_.x = xb_xcc_id(); bar_.st = MISC; xcd_barrier(bar_, (int)(lane_id_fresh() == 0 && F.wave == 0)); } } while (0)
    if (IN(0)) p0_prologue(F);
    SEAM(0);
    if (IN(1)) phase_norm(F, 0, 0);
    SEAM(1);
    if (IN(2)) { phase_inproj(F, 0, 0, 1, F.G, F.bid); phase_norm(F, 0, 1); }
    SEAM(2);
    for (int l = 0; l < 2; ++l)
        for (int s = 0; s < NSLAB; ++s) {
            const int pb = 3 + (l * NSLAB + s) * NPH;
            const int nl = s + 1 < NSLAB ? l : l + 1, ns = s + 1 < NSLAB ? s + 1 : 0;
#pragma unroll 1
            for (int st = 0; st < 2; ++st) {
                if (IN(pb + st)) {
                    const int gl_ = st ? nl : l, gs_ = st ? ns : s;
                    if (isG && gl_ < 2) phase_inproj(F, gl_, gs_, st ? 1 : 2, Gg, gidx);
                    if (st == 0) phase_pre(F, l, s); else phase_mix(F, l, s);
                }
                SEAM(pb + st);
            }
            if (IN(pb + 2)) phase_ab(F, l, s);
            SEAM(pb + 2);
            if (IN(pb + 3)) {
                phase_outp(F, l, s);
                const int s2 = s + 2, l2 = s2 < NSLAB ? l : l + 1;
                if (l2 < 2) phase_norm(F, l2, s2 & 3);
            }
            SEAM(pb + 3);
        }
    if (IN(N_PHASES - 1)) phase_final(F);
#undef IN
#undef SEAM
#undef GBAR
}

extern "C" void kernel_launch(void* const* d_in, const int* in_sizes, int n_in, void* d_out, int out_size, void* d_ws, size_t ws_size, hipStream_t stream) {
    static int grid = 0;
    if (grid == 0) {
        if (n_in != 22 || (size_t)out_size != O_END || ws_size < WS_END) { fprintf(stderr, "kernel_launch: unexpected shapes (n_in %d out %d ws %zu, need %zu)\n", n_in, out_size, ws_size, (size_t)WS_END); grid = -1; return; }
        int dev = 0, cus = 0, per_cu = 0;
        if (hipGetDevice(&dev) != hipSuccess || hipDeviceGetAttribute(&cus, hipDeviceAttributeMultiprocessorCount, dev) != hipSuccess) { grid = -1; return; }
        if (hipFuncSetAttribute((const void*)fwd_kernel, hipFuncAttributeMaxDynamicSharedMemorySize, LDS_BYTES) != hipSuccess) { fprintf(stderr, "kernel_launch: hipFuncSetAttribute failed\n"); grid = -1; return; }
        if (hipOccupancyMaxActiveBlocksPerMultiprocessor(&per_cu, (const void*)fwd_kernel, NTHR, LDS_BYTES) != hipSuccess || per_cu < 1) { fprintf(stderr, "kernel_launch: occupancy query says %d\n", per_cu); }
        (void)hipGetLastError();
        grid = cus < 256 ? cus : 256;
    }
    if (grid < 0) return;
    (void)hipMemsetAsync((char*)d_ws + WS_CTL, 0, CTL_BYTES, stream);
    Args a{};
    for (int i = 0; i < 22; ++i) a.in[i] = (const float*)d_in[i];
    a.out = (float*)d_out; a.ws = (unsigned char*)d_ws;
#if MK_ONE_LAUNCH
    a.ph_lo = 0; a.ph_hi = N_PHASES;
    hipLaunchKernelGGL(fwd_kernel, dim3(grid), dim3(NTHR), LDS_BYTES, stream, a);
#else
    for (int p = 0; p < N_PHASES; ++p) { a.ph_lo = p; a.ph_hi = p + 1; hipLaunchKernelGGL(fwd_kernel, dim3(grid), dim3(NTHR), LDS_BYTES, stream, a); }
#endif
}
```

```cpp
#include <hip/hip_runtime.h>
#include <cstdio>
#include <cstdint>

#ifndef PROBE_REP
#define PROBE_REP 0
#endif
#ifndef PROBE_T
#define PROBE_T 0
#endif
#ifndef SELCHK
#define SELCHK 0
#endif
#ifndef MK_ONE_LAUNCH
#define MK_ONE_LAUNCH 1
#endif

#define LAS __attribute__((address_space(3)))
#define GLB __attribute__((address_space(1)))
typedef _Float16 f16;
typedef _Float16 h8 __attribute__((ext_vector_type(8)));
typedef _Float16 h4 __attribute__((ext_vector_type(4)));
typedef _Float16 h2 __attribute__((ext_vector_type(2)));
typedef float f32x4 __attribute__((ext_vector_type(4)));
typedef float f32x2 __attribute__((ext_vector_type(2)));
typedef unsigned u32x4 __attribute__((ext_vector_type(4)));
typedef unsigned u32x2 __attribute__((ext_vector_type(2)));
#define DI __device__ __forceinline__

constexpr int D = 2048, NTOKP = 32768, NTOKS = 1024, NTOK = NTOKP + NTOKS;
constexpr int IN_DIM = 18032, NP = 18176, PS = 17408;
constexpr int LSMP = 4160, PAST = 4096;
constexpr int NSLAB = 4, NWAVES = 8, NTHR = 512;
constexpr int C_QKV = 0, C_ZA = 6144, C_QB = 8192, C_ZB = 10240, C_QI = 12288, C_GA = 13312, C_GB = 15360;
constexpr float EPS = 1e-6f;
constexpr int NPOS = 16 * 2048 + 16 * LSMP;

constexpr size_t O_YP = 0, O_YS = O_YP + (size_t)NTOKP * D, O_NKP = O_YS + (size_t)NTOKS * D, O_NVP = O_NKP + (size_t)2 * 16 * 2048 * 256,
    O_NIP = O_NVP + (size_t)2 * 16 * 2048 * 256, O_NGP = O_NIP + (size_t)2 * 16 * 2048 * 64, O_NCP = O_NGP + (size_t)2 * 16 * 16 * 16384,
    O_NKS = O_NCP + (size_t)2 * 16 * 3 * 6144, O_NVS = O_NKS + (size_t)2 * 16 * 64 * 256, O_NIS = O_NVS + (size_t)2 * 16 * 64 * 256,
    O_NGS = O_NIS + (size_t)2 * 16 * 64 * 64, O_NCS = O_NGS + (size_t)2 * 16 * 16 * 16384, O_END = O_NCS + (size_t)2 * 16 * 3 * 6144;
static_assert(O_END == 126091264ull, "output size");

constexpr size_t al256(size_t x) { return (x + 255) & ~(size_t)255; }
constexpr size_t WS_CTL = 0, CTL_BYTES = 1u << 20;
constexpr size_t WS_ADA = WS_CTL + CTL_BYTES;
constexpr size_t WS_WIN = al256(WS_ADA + (size_t)2 * 32 * 6144 * 4);
constexpr size_t WS_WA = al256(WS_WIN + (size_t)2 * NP * 2048 * 2);
constexpr size_t WS_WB = al256(WS_WA + (size_t)2 * 2048 * 2048 * 2);
constexpr size_t WS_WO = al256(WS_WB + (size_t)2 * 2048 * 2048 * 2);
constexpr size_t WS_H = al256(WS_WO + (size_t)2 * 2048 * 2048 * 2);
constexpr size_t WS_PROJ = al256(WS_H + (size_t)9216 * 2048 * 2);
constexpr size_t WS_OA = al256(WS_PROJ + (size_t)9216 * PS * 2);
constexpr size_t WS_OB = al256(WS_OA + (size_t)9216 * 2048 * 2);
constexpr size_t WS_KU = al256(WS_OB + (size_t)9216 * 2048 * 2);
constexpr size_t WS_VU = al256(WS_KU + (size_t)NPOS * 256 * 2);
constexpr size_t WS_KIU = al256(WS_VU + (size_t)NPOS * 256 * 2);
constexpr size_t WS_WI = al256(WS_KIU + (size_t)NPOS * 64 * 2);
constexpr size_t WS_BETA = al256(WS_WI + (size_t)NTOK * 16 * 4);
constexpr size_t WS_G = al256(WS_BETA + (size_t)NTOK * 16 * 4);
constexpr int LDR = 4160;
constexpr size_t WS_SCR = al256(WS_G + (size_t)NTOK * 16 * 4);
constexpr int GP_W = 0, GP_QD = 16384, GP_KD = 32768, GP_U = 49152, GP_QK = 65536, GP_STRIDE = 73728;
constexpr size_t WS_GP = al256(WS_SCR + (size_t)256 * 32 * LDR * 4);
constexpr size_t WS_GL = al256(WS_GP + (size_t)144 * 16 * GP_STRIDE);
constexpr size_t WS_MASK = al256(WS_GL + (size_t)144 * 16 * 4);
constexpr size_t WS_MG = al256(WS_MASK + (size_t)288 * 32 * 65 * 8);
constexpr size_t WS_H2 = al256(WS_MG + (size_t)9216 * 2048 * 2);
constexpr size_t WS_END = al256(WS_H2 + (size_t)9216 * 2048 * 2);

constexpr int LDS_BYTES = 147456, LDS_MISC = 131072;

#define XB_TMO      128
#define XB_XCNT(j)  (256  + 64 * (j))
#define XB_XSUB(j)  (1280 + 64 * (j))
#define XB_XGEN(j)  (2304 + 64 * (j))
#define XB_TOP      3328
#define XB_TOPGEN   3392
#define XCD_BAR_WORDS 3456
#define XB_SPIN_CAP (1u << 18)
__device__ __forceinline__ unsigned xb_ld(unsigned* p)              { return __hip_atomic_load(p, __ATOMIC_RELAXED, __HIP_MEMORY_SCOPE_AGENT); }
__device__ __forceinline__ unsigned xb_add(unsigned* p, unsigned v) { return __hip_atomic_fetch_add(p, v, __ATOMIC_RELAXED, __HIP_MEMORY_SCOPE_AGENT); }
__device__ __forceinline__ unsigned xb_xcc_id() { return (unsigned)__builtin_amdgcn_s_getreg((3 << 11) | 20) & 0xFu; }
#define XB_SPIN(cond, bar) do { unsigned _sp = 0; while (cond) { __builtin_amdgcn_s_sleep(1); \
    if ((++_sp & 255u) == 0u) { if (xb_ld(&(bar)[XB_TMO])) break; if (_sp > XB_SPIN_CAP) { atomicAdd(&(bar)[XB_TMO], 1u); break; } } } } while (0)
struct XcdBarrier { unsigned* bar; unsigned x; volatile LAS unsigned* st; };
__device__ __forceinline__ XcdBarrier xcd_barrier_post(unsigned* bar, volatile LAS unsigned* st) {
    XcdBarrier b; b.bar = bar; b.x = xb_xcc_id(); b.st = st;
    if (threadIdx.x == 0) (void)xb_add(&bar[XB_XCNT(b.x)], 1u);
    return b;
}
__device__ __forceinline__ void xcd_barrier_complete(unsigned* bar, unsigned x, unsigned& nloc, unsigned& nx) {
    const unsigned G = gridDim.x * gridDim.y * gridDim.z;
    unsigned sum, cnt, mine, sp = 0u;
    for (;;) {
        sum = 0u; cnt = 0u; mine = 0u;
#pragma unroll
        for (unsigned j = 0; j < 16; ++j) { const unsigned c = xb_ld(&bar[XB_XCNT(j)]); sum += c; cnt += (c > 0u) ? 1u : 0u; mine = (j == x) ? c : mine; }
        if (sum == G) break;
        __builtin_amdgcn_s_sleep(1);
        if ((++sp & 255u) == 0u) { if (xb_ld(&bar[XB_TMO])) break; if (sp > XB_SPIN_CAP) { atomicAdd(&bar[XB_TMO], 1u); break; } }
    }
    nloc = mine > 0u ? mine : 1u; nx = cnt > 0u ? cnt : 1u;
}
__device__ __forceinline__ void xcd_barrier(const XcdBarrier b, const int leader) {
    asm volatile("s_waitcnt vmcnt(0)" ::: "memory");
    __syncthreads();
    if (leader) {
        unsigned* bar = b.bar;
        __builtin_amdgcn_s_waitcnt(0);
        unsigned nloc = b.st[0], nx = b.st[1];
        if (nloc == 0u) { xcd_barrier_complete(bar, b.x, nloc, nx); b.st[0] = nloc; b.st[1] = nx; }
        const unsigned old = xb_add(&bar[XB_XSUB(b.x)], 1u);
        const unsigned gen = old / nloc;
        if (old + 1u == (gen + 1u) * nloc) {
            __builtin_amdgcn_fence(__ATOMIC_RELEASE, "agent");
            asm volatile("s_waitcnt vmcnt(0)" ::: "memory");
            const unsigned og = xb_add(&bar[XB_TOP], 1u);
            const unsigned tg = og / nx;
            if (og + 1u == (tg + 1u) * nx) xb_add(&bar[XB_TOPGEN], 1u);
            else XB_SPIN(xb_ld(&bar[XB_TOPGEN]) == tg, bar);
            __builtin_amdgcn_fence(__ATOMIC_ACQUIRE, "agent");
            xb_add(&bar[XB_XGEN(b.x)], 1u);
            asm volatile("s_waitcnt vmcnt(0)" ::: "memory");
        } else {
            XB_SPIN(xb_ld(&bar[XB_XGEN(b.x)]) == gen, bar);
            __builtin_amdgcn_fence(__ATOMIC_ACQUIRE, "agent");
            asm volatile("s_waitcnt vmcnt(0)" ::: "memory");
        }
    }
    __syncthreads();
}

DI int lane_id_fresh() { unsigned z = 0u; asm volatile("" : "+v"(z)); return (int)__builtin_amdgcn_mbcnt_hi(~0u, __builtin_amdgcn_mbcnt_lo(~0u, z)); }
template <int O> DI float swz_xor(float v) { return __builtin_bit_cast(float, __builtin_amdgcn_ds_swizzle(__builtin_bit_cast(int, v), (O << 10) | 0x1F)); }
DI float shx32(float v, int lane) { return __builtin_bit_cast(float, __builtin_amdgcn_ds_bpermute((lane ^ 32) << 2, __builtin_bit_cast(int, v))); }
DI float wave_sum(float v, int lane) {
    v += swz_xor<1>(v); v += swz_xor<2>(v); v += swz_xor<4>(v); v += swz_xor<8>(v); v += swz_xor<16>(v);
    return v + shx32(v, lane);
}
DI float sigmoidf_(float x) { return __builtin_amdgcn_rcpf(1.0f + __expf(-x)); }
DI float siluf_(float x) { return x * __builtin_amdgcn_rcpf(1.0f + __expf(-x)); }
DI unsigned pk_f16(float lo, float hi) { h2 v = {(f16)lo, (f16)hi}; return __builtin_bit_cast(unsigned, v); }
DI void rowinfo(int slab, int rs, int& R, int& sq, int& t) {
    if (rs < 8192) { R = slab * 8192 + rs; sq = R >> 11; t = R & 2047; }
    else { const int q = rs - 8192; R = NTOKP + q; sq = 16 + (q >> 6); t = q & 63; }
}
DI int posbase(int sq) { return sq < 16 ? sq * 2048 : 32768 + (sq - 16) * LSMP; }
__host__ __device__ inline int ts_of(int slab) { return slab == 0 ? 9216 : 8192; }
DI int proj_src_col(int n) {
    if (n < 8192) return n;
    if (n < 10240) return 8224 + (n - 8192);
    if (n < 12288) return 10784 + (n - 10240);
    if (n < 13312) return 12832 + (n - 12288);
    if (n < 15360) return 13936 + (n - 13312);
    if (n < 17408) return 15984 + (n - 15360);
    if (n < 17664) return 10272 + (n - 17408);
    if (n < 17920) return 10528 + (n - 17664);
    const int j = n - 17920;
    if (j < 64) return 13856 + j;
    if (j < 80) return 13920 + (j - 64);
    if (j < 96) return 8192 + (j - 80);
    if (j < 112) return 8208 + (j - 96);
    return -1;
}
DI int rel_bucket(int rel) {
    const int n = rel < 0 ? -rel : rel;
    const int v = n < 8 ? n : (n < 12 ? 8 : n < 16 ? 9 : n < 23 ? 10 : n < 32 ? 11 : n < 46 ? 12 : n < 64 ? 13 : n < 91 ? 14 : 15);
    return (rel > 0 ? 16 : 0) + v;
}

namespace pg8 {
constexpr int BM = 256, BK = 64, HALF = 128, HTB = HALF * BK * 2, STAGE_BYTES = 8 * HTB, NXCD = 8, WGM = 8;
DI int lds_byte(int r, int c) { const int st = (r >> 4) * 2 + (c >> 5), rr = r & 15, cc = c & 31, ob = rr * 64 + cc * 2; return st * 1024 + (ob ^ (((ob >> 9) & 1) << 5)); }
DI void stage_rc(int b, int& R, int& C) { const int st = b / 1024, sb = b % 1024, swz = sb ^ (((sb >> 9) & 1) << 5); R = (st >> 1) * 16 + swz / 64; C = (st & 1) * 32 + (swz % 64) / 2; }
DI int perm32(int rho) { const int n = rho >> 4, i = rho & 15; return 8 * (i >> 2) + 4 * n + (i & 3); }

struct Unit { int pm, pn, which; };
struct Gemm { GLB const f16* A0; GLB const f16* B0; GLB const f16* A1; GLB const f16* B1; int M, N, K; };

struct StaticOrder {
    int nM, nN, nwg, G, c;
    DI void init(int M, int N, int G_, int c_) { nM = M / BM; nN = N / BM; nwg = nM * nN; G = G_; c = c_; }
    DI bool tile(long L, Unit& u) const {
        if (L >= nwg) return false;
        int wgid = (int)L; { const int q = nwg / NXCD, r = nwg % NXCD, xcd = wgid % NXCD, off = wgid / NXCD; wgid = (xcd < r ? xcd * (q + 1) : r * (q + 1) + (xcd - r) * q) + off; }
        const int nig = WGM * nN, gid = wgid / nig, fm = gid * WGM, gsz = (nM - fm) < WGM ? (nM - fm) : WGM;
        u.pm = fm + ((wgid % nig) % gsz); u.pn = (wgid % nig) / gsz; return true;
    }
    DI bool next(int i, Unit& u) const { u.which = 0; return tile((long)i * G + c, u); }
};
struct OneTile { int pm, pn, nu;
    DI bool next(int i, Unit& u) const { if (i >= nu) return false; u.pm = pm; u.pn = pn; u.which = i; return true; } };
struct SubOrder : StaticOrder {
    int part;
    DI void init2(int M, int part_, int G_, int c_) { part = part_; init(M, (part_ == 1 ? 31 : 40) * BM, G_, c_); }
    DI bool next(int i, Unit& u) const { u.which = 0; if (!tile((long)i * G + c, u)) return false; const int p = u.pn;
        u.pn = part == 1 ? (p < 24 ? p : (p < 28 ? 48 + (p - 24) : 68 + (p - 28))) : (p < 24 ? 24 + p : 52 + (p - 24)); return true; }
};
struct DualOrder : StaticOrder {
    DI bool next(int i, Unit& u) const { u.which = i & 1; return tile((long)(i >> 1) * G + c, u); }
};

template <class Epi, class Sched, bool ALIGN_EPI = true>
DI void gemm_phase(LAS unsigned char* lds, const Gemm g, const Sched& S, const Epi& E, int wave_s) {
    int tid_ = lane_id_fresh() + wave_s * 64; asm volatile("" : "+v"(tid_));
    const int tid = tid_, wid = __builtin_amdgcn_readfirstlane(tid >> 6), lane = tid & 63, wr = wid >> 2, wc = wid & 3, fr = lane & 15, fq = lane >> 4;
    const int K = g.K, nt = K / BK;
    unsigned voffA[2], voffB[2];
#pragma unroll
    for (int i = 0; i < 2; ++i) { int R, C; stage_rc(tid * 16 + i * 8192, R, C); const int Rb = (R & ~31) + perm32(R & 31);
        voffA[i] = (unsigned)(R * K + C) * 2u; voffB[i] = (unsigned)(Rb * K + C) * 2u; }
    const size_t kstep = (size_t)(BK * 2);
    const size_t hstep = (size_t)HALF * K * 2;
    const size_t tstep = 2 * hstep;
    const unsigned ldsw = (unsigned)wid * 1024u;
    const int aoff = lds_byte(wr * 64 + fr, fq * 8), boff = lds_byte(wc * 32 + fr, fq * 8);
#define PG8_SA(b, h) (((b) * 2 + (h)) * HTB)
#define PG8_SB(b, h) ((4 + (b) * 2 + (h)) * HTB)
#define PG8_STAGE(bufoff, gbase, voff) do { _Pragma("unroll") for (int _i = 0; _i < 2; ++_i) \
        __builtin_amdgcn_global_load_lds((GLB const unsigned*)((GLB const char*)(gbase) + (voff)[_i]), (LAS unsigned*)(lds + (bufoff) + ldsw + _i * 8192), 16, 0, 0); } while (0)
#define PG8_LDA(dst, b, h) do { _Pragma("unroll") for (int m = 0; m < 4; ++m) _Pragma("unroll") for (int k = 0; k < 2; ++k) dst[m][k] = *(const LAS h8*)(lds + PG8_SA(b, h) + aoff + m * 2048 + k * 1024); } while (0)
#define PG8_LDB(dst, b, h) do { _Pragma("unroll") for (int n = 0; n < 2; ++n) _Pragma("unroll") for (int k = 0; k < 2; ++k) dst[n][k] = *(const LAS h8*)(lds + PG8_SB(b, h) + boff + n * 2048 + k * 1024); } while (0)
#define PG8_MMA(ai, bj, At, Bt) do { __builtin_amdgcn_s_setprio(1); _Pragma("unroll") for (int m = 0; m < 4; ++m) _Pragma("unroll") for (int n = 0; n < 2; ++n) _Pragma("unroll") for (int k = 0; k < 2; ++k) \
        acc[ai][bj][m][n] = __builtin_amdgcn_mfma_f32_16x16x32_f16(Bt[n][k], At[m][k], acc[ai][bj][m][n], 0, 0, 0); __builtin_amdgcn_s_setprio(0); } while (0)
#define PG8_WAIT_V(n) asm volatile("s_waitcnt vmcnt(" #n ")" ::: "memory")
#define PG8_WAIT_L(n) asm volatile("s_waitcnt lgkmcnt(" #n ")" ::: "memory")
#define PG8_BAR __builtin_amdgcn_s_barrier()
#define PG8_SCHED __builtin_amdgcn_sched_barrier(0)
    Unit cur, nxt; int ui = 0;
    if (!S.next(0, cur)) return;
    f32x4 acc[2][2][4][2];
#pragma unroll
    for (int a = 0; a < 2; ++a)
#pragma unroll
        for (int b = 0; b < 2; ++b)
#pragma unroll
            for (int m = 0; m < 4; ++m)
#pragma unroll
                for (int n = 0; n < 2; ++n) acc[a][b][m][n] = (f32x4){0.f, 0.f, 0.f, 0.f};
    h8 At[4][2], B0[2][2], B1[2][2];
    GLB const char* cA = (GLB const char*)(cur.which ? g.A1 : g.A0) + (size_t)cur.pm * tstep; GLB const char* cB = (GLB const char*)(cur.which ? g.B1 : g.B0) + (size_t)cur.pn * tstep;
    PG8_STAGE(PG8_SB(0, 0), cB, voffB); PG8_STAGE(PG8_SB(0, 1), cB + hstep, voffB); PG8_STAGE(PG8_SA(0, 0), cA, voffA); PG8_STAGE(PG8_SA(0, 1), cA + hstep, voffA);
    if (wr == 1) PG8_BAR;
    PG8_WAIT_V(2); PG8_BAR;
    PG8_STAGE(PG8_SB(1, 0), cB + kstep, voffB); PG8_STAGE(PG8_SA(1, 0), cA + kstep, voffA); PG8_STAGE(PG8_SB(1, 1), cB + hstep + kstep, voffB);
    PG8_WAIT_V(6); PG8_BAR;
    for (;;) {
        const bool has_next = S.next(ui + 1, nxt);
        GLB const char* nA = has_next ? (GLB const char*)(nxt.which ? g.A1 : g.A0) + (size_t)nxt.pm * tstep : cA; GLB const char* nB = has_next ? (GLB const char*)(nxt.which ? g.B1 : g.B0) + (size_t)nxt.pn * tstep : cB;
        for (int t = 0; t < nt; t += 2) {
            const bool last = (t == nt - 2);
            GLB const char* a1 = cA + (size_t)(t + 1) * kstep;
            GLB const char* a2 = last ? nA : cA + (size_t)(t + 2) * kstep; GLB const char* b2 = last ? nB : cB + (size_t)(t + 2) * kstep;
            GLB const char* a3 = a2 + kstep; GLB const char* b3 = b2 + kstep;
            PG8_LDB(B0, 0, 0); PG8_LDB(B1, 0, 1); PG8_SCHED; PG8_LDA(At, 0, 0); PG8_STAGE(PG8_SA(1, 1), a1 + hstep, voffA);
            PG8_WAIT_V(8); PG8_WAIT_L(0); PG8_BAR; PG8_MMA(0, 0, At, B0); PG8_MMA(0, 1, At, B1); PG8_BAR; PG8_SCHED;
            PG8_LDA(At, 0, 1); PG8_STAGE(PG8_SB(0, 0), b2, voffB); PG8_STAGE(PG8_SB(0, 1), b2 + hstep, voffB); PG8_STAGE(PG8_SA(0, 0), a2, voffA);
            PG8_WAIT_V(8); PG8_WAIT_L(0); PG8_BAR; PG8_MMA(1, 0, At, B0); PG8_MMA(1, 1, At, B1); PG8_BAR; PG8_SCHED;
            PG8_LDB(B0, 1, 0); PG8_LDB(B1, 1, 1); PG8_SCHED; PG8_LDA(At, 1, 0); PG8_STAGE(PG8_SA(0, 1), a2 + hstep, voffA);
            PG8_WAIT_V(8); PG8_WAIT_L(0); PG8_BAR; PG8_MMA(0, 0, At, B0); PG8_MMA(0, 1, At, B1); PG8_BAR; PG8_SCHED;
            PG8_LDA(At, 1, 1); PG8_STAGE(PG8_SB(1, 0), b3, voffB); PG8_STAGE(PG8_SB(1, 1), b3 + hstep, voffB); PG8_STAGE(PG8_SA(1, 0), a3, voffA);
            PG8_WAIT_V(8); PG8_WAIT_L(0); PG8_BAR; PG8_MMA(1, 0, At, B0); PG8_MMA(1, 1, At, B1); PG8_BAR; PG8_SCHED;
        }
        if constexpr (ALIGN_EPI) { if (wr == 0) PG8_BAR; }
        E(acc, cur, wr, wc, fr, fq);
        if (!has_next) break;
#pragma unroll
        for (int a = 0; a < 2; ++a)
#pragma unroll
            for (int b = 0; b < 2; ++b)
#pragma unroll
                for (int m = 0; m < 4; ++m)
#pragma unroll
                    for (int n = 0; n < 2; ++n) acc[a][b][m][n] = (f32x4){0.f, 0.f, 0.f, 0.f};
        cur = nxt; cA = nA; cB = nB; ++ui;
        if constexpr (ALIGN_EPI) { if (wr == 1) PG8_BAR; }
    }
    PG8_WAIT_V(0);
    if constexpr (!ALIGN_EPI) { if (wr == 0) PG8_BAR; }
    PG8_BAR;
#undef PG8_SA
#undef PG8_SB
#undef PG8_STAGE
#undef PG8_LDA
#undef PG8_LDB
#undef PG8_MMA
#undef PG8_WAIT_V
#undef PG8_WAIT_L
#undef PG8_BAR
#undef PG8_SCHED
}
}

struct Args { const float* in[22]; float* out; unsigned char* ws; int ph_lo, ph_hi; };
constexpr int LDS_TAB = LDS_MISC + 256;
DI unsigned long long ldtab(LAS unsigned char* lds, int i) {
    const unsigned vx = *(const volatile LAS unsigned*)(lds + LDS_TAB + 8 * i), vy = *(const volatile LAS unsigned*)(lds + LDS_TAB + 8 * i + 4); u32x2 v; v.x = vx; v.y = vy;
    return ((unsigned long long)(unsigned)__builtin_amdgcn_readfirstlane((int)v.y) << 32) | (unsigned)__builtin_amdgcn_readfirstlane((int)v.x);
}
struct Frame {
    LAS unsigned char* lds; int tid, lane, wave, G, bid;
    DI Frame fresh() const { Frame f = *this; int t = lane_id_fresh() + wave * 64; asm volatile("" : "+v"(t)); f.tid = t; f.lane = t & 63; f.wave = wave; return f; }
    DI GLB const float* in(int i) const { return (GLB const float*)ldtab(lds, i); }
    DI GLB float* out() const { return (GLB float*)ldtab(lds, 22); }
    DI GLB unsigned char* ws() const { return (GLB unsigned char*)ldtab(lds, 23); }
    DI unsigned* ctl() const { return (unsigned*)ldtab(lds, 23); }
    DI GLB float* ADA() const { return (GLB float*)(ws() + WS_ADA); }
    DI GLB f16* WIN() const { return (GLB f16*)(ws() + WS_WIN); }
    DI GLB f16* WA() const { return (GLB f16*)(ws() + WS_WA); }
    DI GLB f16* WB() const { return (GLB f16*)(ws() + WS_WB); }
    DI GLB f16* WO() const { return (GLB f16*)(ws() + WS_WO); }
    DI GLB f16* H(int par) const { return (GLB f16*)(ws() + (par ? WS_H2 : WS_H)); }
    DI GLB f16* MG() const { return (GLB f16*)(ws() + WS_MG); }
    DI GLB f16* PROJ() const { return (GLB f16*)(ws() + WS_PROJ); }
    DI GLB f16* OA() const { return (GLB f16*)(ws() + WS_OA); }
    DI GLB f16* OB() const { return (GLB f16*)(ws() + WS_OB); }
    DI GLB f16* KU() const { return (GLB f16*)(ws() + WS_KU); }
    DI GLB f16* VU() const { return (GLB f16*)(ws() + WS_VU); }
    DI GLB f16* KIU() const { return (GLB f16*)(ws() + WS_KIU); }
    DI GLB float* WI() const { return (GLB float*)(ws() + WS_WI); }
    DI GLB float* BETA() const { return (GLB float*)(ws() + WS_BETA); }
    DI GLB float* GG() const { return (GLB float*)(ws() + WS_G); }
};
enum { I_XP = 0, I_XS, I_CP, I_CS, I_CK, I_CV, I_CIK, I_SG, I_SC, I_NW, I_WADA, I_BADA, I_WIN, I_WCONV, I_ALOG, I_DTB, I_GNW, I_WBA, I_WBB, I_WOUT, I_RELB, I_FNW };
constexpr int CW_BAR = 0, CW_Q = 4096, CW_T = 16384;

struct EpiProj {
    static constexpr bool PERM = true;
    GLB f16* proj; GLB float* out; GLB f16 *KU, *VU, *KIU; GLB float *WI, *BETA, *GG; GLB const float *a_log, *dt_bias; int layer, slab;
    DI void operator()(const f32x4 (&acc)[2][2][4][2], const pg8::Unit& u, int wr, int wc, int fr_, int fq_) const {
        int fr = fr_, fq = fq_; asm volatile("" : "+v"(fr), "+v"(fq));
        const int pn = u.pn;
        const int rsb = u.pm * 256 + wr * 64 + fr;
        if (pn < 68) {
            const int act = ((pn >= 24 && pn < 32) || (pn >= 40 && pn < 48)) ? 1 : (pn >= 52 ? 2 : 0);
            const int col0 = pn * 256 + wc * 32 + 8 * fq;
#pragma unroll
            for (int ai = 0; ai < 2; ++ai)
#pragma unroll
                for (int m = 0; m < 4; ++m) {
                    GLB f16* rowp = proj + (size_t)(rsb + ai * 128 + m * 16) * PS + col0;
#pragma unroll
                    for (int bj = 0; bj < 2; ++bj) {
                        f32x4 v0 = acc[ai][bj][m][0], v1 = acc[ai][bj][m][1];
                        if (act == 1) {
#pragma unroll
                            for (int j = 0; j < 4; ++j) { v0[j] = siluf_(v0[j]); v1[j] = siluf_(v1[j]); }
                        } else if (act == 2) {
#pragma unroll
                            for (int j = 0; j < 4; ++j) { v0[j] = sigmoidf_(v0[j]); v1[j] = sigmoidf_(v1[j]); }
                        }
                        u32x4 w; w.x = pk_f16(v0[0], v0[1]); w.y = pk_f16(v0[2], v0[3]); w.z = pk_f16(v1[0], v1[1]); w.w = pk_f16(v1[2], v1[3]);
                        *(GLB u32x4*)(rowp + bj * 128) = w;
                    }
                }
            if (pn < 24 && fr >= 13) {
                const bool smp = u.pm >= 32;
                if (smp || (u.pm & 7) == 7) {
#pragma unroll
                    for (int ai = 0; ai < 2; ++ai) {
                        if (!smp && !(ai == 1 && wr == 1)) continue;
                        int R, sq, t; rowinfo(slab, rsb + ai * 128 + 48, R, sq, t);
                        const int T = smp ? 64 : 2048;
                        GLB float* base = out + (smp ? O_NCS : O_NCP) + ((size_t)(layer * 16 + (sq & 15)) * 3 + (t - (T - 3))) * 6144 + col0;
#pragma unroll
                        for (int bj = 0; bj < 2; ++bj) { *(GLB f32x4*)(base + bj * 128) = acc[ai][bj][3][0]; *(GLB f32x4*)(base + bj * 128 + 4) = acc[ai][bj][3][1]; }
                    }
                }
            }
        } else {
            float dtb[8], ea[8];
            { const int hb = (wc == 3 && fq < 2) ? 8 * fq : 0;
#pragma unroll
              for (int j = 0; j < 8; ++j) { dtb[j] = dt_bias[hb + j]; ea[j] = a_log[hb + j]; }
              asm volatile("" ::: "memory");
#pragma unroll
              for (int j = 0; j < 8; ++j) ea[j] = -__expf(ea[j]); }
#pragma unroll
            for (int ai = 0; ai < 2; ++ai)
#pragma unroll
                for (int m = 0; m < 4; ++m) {
                    int R, sq, t; rowinfo(slab, rsb + ai * 128 + m * 16, R, sq, t);
                    const bool smp = sq >= 16; const int b = sq & 15;
                    const size_t pos = (size_t)posbase(sq) + (smp ? PAST : 0) + t;
#pragma unroll
                    for (int bj = 0; bj < 2; ++bj) {
                        const int c = bj * 128 + wc * 32 + 8 * fq;
                        const f32x4 v0 = acc[ai][bj][m][0], v1 = acc[ai][bj][m][1];
                        if (pn < 70) {
                            GLB float* o = out + (pn == 68 ? (smp ? O_NKS : O_NKP) : (smp ? O_NVS : O_NVP)) + ((size_t)(layer * 16 + b) * (smp ? 64 : 2048) + t) * 256 + c;
                            *(GLB f32x4*)o = v0; *(GLB f32x4*)(o + 4) = v1;
                            u32x4 w; w.x = pk_f16(v0[0], v0[1]); w.y = pk_f16(v0[2], v0[3]); w.z = pk_f16(v1[0], v1[1]); w.w = pk_f16(v1[2], v1[3]);
                            *(GLB u32x4*)((pn == 68 ? KU : VU) + pos * 256 + c) = w;
                        } else if (c < 64) {
                            GLB float* o = out + (smp ? O_NIS : O_NIP) + ((size_t)(layer * 16 + b) * (smp ? 64 : 2048) + t) * 64 + c;
                            *(GLB f32x4*)o = v0; *(GLB f32x4*)(o + 4) = v1;
                            u32x4 w; w.x = pk_f16(v0[0], v0[1]); w.y = pk_f16(v0[2], v0[3]); w.z = pk_f16(v1[0], v1[1]); w.w = pk_f16(v1[2], v1[3]);
                            *(GLB u32x4*)(KIU + pos * 64 + c) = w;
                        } else if (c < 80) {
                            GLB float* o = WI + (size_t)R * 16 + (c - 64);
                            *(GLB f32x4*)o = v0 * 0.03125f; *(GLB f32x4*)(o + 4) = v1 * 0.03125f;
                        } else if (c < 96) {
                            GLB float* o = BETA + (size_t)R * 16 + (c - 80);
                            f32x4 a, bb;
#pragma unroll
                            for (int j = 0; j < 4; ++j) { a[j] = sigmoidf_(v0[j]); bb[j] = sigmoidf_(v1[j]); }
                            *(GLB f32x4*)o = a; *(GLB f32x4*)(o + 4) = bb;
                        } else if (c < 112) {
                            GLB float* o = GG + (size_t)R * 16 + (c - 96);
                            f32x4 a, bb;
#pragma unroll
                            for (int j = 0; j < 4; ++j) {
                                const float x0 = v0[j] + dtb[j], x1 = v1[j] + dtb[4 + j];
                                const float s0 = x0 > 20.f ? x0 : __logf(1.0f + __expf(x0)), s1 = x1 > 20.f ? x1 : __logf(1.0f + __expf(x1));
                                a[j] = ea[j] * s0; bb[j] = ea[4 + j] * s1;
                            }
                            *(GLB f32x4*)o = a; *(GLB f32x4*)(o + 4) = bb;
                        }
                    }
                }
        }
    }
};
struct EpiAB {
    static constexpr bool PERM = true;
    GLB const f16* proj; GLB f16* mg;
    DI void operator()(const f32x4 (&acc)[2][2][4][2], const pg8::Unit& u, int wr, int wc, int fr_, int fq_) const {
        int fr = fr_, fq = fq_; asm volatile("" : "+v"(fr), "+v"(fq));
        const int rsb = u.pm * 256 + wr * 64 + fr, col0 = u.pn * 256 + wc * 32 + 8 * fq;
        const int gc = (u.which ? C_GB : C_GA) + col0;
#pragma unroll
        for (int ai = 0; ai < 2; ++ai) {
            h8 gt[4][2], pv[4][2];
#pragma unroll
            for (int m = 0; m < 4; ++m)
#pragma unroll
                for (int bj = 0; bj < 2; ++bj) {
                    const size_t rs = (size_t)(rsb + ai * 128 + m * 16);
                    gt[m][bj] = *(GLB const h8*)(proj + rs * PS + gc + bj * 128);
                    if (u.which) pv[m][bj] = *(GLB const h8*)(mg + rs * 2048 + col0 + bj * 128);
                }
#pragma unroll
            for (int m = 0; m < 4; ++m)
#pragma unroll
                for (int bj = 0; bj < 2; ++bj) {
                    const size_t rs = (size_t)(rsb + ai * 128 + m * 16);
                    float r[8];
#pragma unroll
                    for (int j = 0; j < 4; ++j) { r[j] = (float)gt[m][bj][j] * acc[ai][bj][m][0][j]; r[4 + j] = (float)gt[m][bj][4 + j] * acc[ai][bj][m][1][j]; }
                    if (u.which) {
#pragma unroll
                        for (int j = 0; j < 8; ++j) r[j] += (float)pv[m][bj][j]; }
                    u32x4 w; w.x = pk_f16(r[0], r[1]); w.y = pk_f16(r[2], r[3]); w.z = pk_f16(r[4], r[5]); w.w = pk_f16(r[6], r[7]);
                    *(GLB u32x4*)(mg + rs * 2048 + col0 + bj * 128) = w;
                }
        }
    }
};
struct EpiOut {
    static constexpr bool PERM = true;
    GLB const float* xp; GLB const float* xs; GLB float* out; GLB const float* ada; int layer, slab;
    DI void operator()(const f32x4 (&acc)[2][2][4][2], const pg8::Unit& u, int wr, int wc, int fr_, int fq_) const {
        int fr = fr_, fq = fq_; asm volatile("" : "+v"(fr), "+v"(fq));
        const int rsb = u.pm * 256 + wr * 64 + fr, col0 = u.pn * 256 + wc * 32 + 8 * fq;
#pragma unroll
        for (int ai = 0; ai < 2; ++ai) {
#pragma unroll
            for (int bj = 0; bj < 2; ++bj) {
                const int c = col0 + bj * 128;
                f32x4 xv[4][2], gv[2];
                { int R, sq, t; rowinfo(slab, rsb + ai * 128, R, sq, t);
                  GLB const float* gp = ada + (size_t)sq * 6144 + 4096;
                  gv[0] = *(GLB const f32x4*)(gp + c); gv[1] = *(GLB const f32x4*)(gp + c + 4); }
#pragma unroll
                for (int m = 0; m < 4; ++m) {
                    int R, sq, t; rowinfo(slab, rsb + ai * 128 + m * 16, R, sq, t);
                    GLB const float* xo = layer == 0 ? (R < NTOKP ? xp + (size_t)R * D : xs + (size_t)(R - NTOKP) * D) : out + (size_t)R * D;
                    xv[m][0] = *(GLB const f32x4*)(xo + c); xv[m][1] = *(GLB const f32x4*)(xo + c + 4);
                }
                asm volatile("" ::: "memory");
#pragma unroll
                for (int m = 0; m < 4; ++m) {
                    int R, sq, t; rowinfo(slab, rsb + ai * 128 + m * 16, R, sq, t);
                    GLB float* yo = out + (size_t)R * D;
                    *(GLB f32x4*)(yo + c) = xv[m][0] + gv[0] * acc[ai][bj][m][0]; *(GLB f32x4*)(yo + c + 4) = xv[m][1] + gv[1] * acc[ai][bj][m][1];
                }
            }
        }
    }
};

DI void p0_prologue(const Frame F0) {
    const Frame F = F0.fresh();
    LAS float* tile = (LAS float*)F.lds;
    const int tid = F.tid;
    for (int u = F.bid; u < 2 * 6080; u += F.G) {
        const int l = u / 6080; int v = u % 6080;
        GLB const float* src; GLB f16* dst; int ldn, nb, kb; bool isin;
        if (v < 4544) { isin = true; nb = v >> 4; kb = v & 15; src = F.in(I_WIN) + (size_t)l * 2048 * IN_DIM; ldn = IN_DIM; dst = F.WIN() + (size_t)l * NP * 2048; }
        else { v -= 4544; const int mat = v >> 9, w = v & 511; isin = false; nb = w >> 4; kb = w & 15; src = F.in(I_WBA + mat) + (size_t)l * 2048 * 2048; ldn = 2048;
               dst = (mat == 0 ? F.WA() : mat == 1 ? F.WB() : F.WO()) + (size_t)l * 2048 * 2048; }
        {
            const int nn = tid & 63, np = nb * 64 + nn; const int o = isin ? proj_src_col(np) : np, oc = o >= 0 ? o : 0;
            float val[16];
#pragma unroll
            for (int i = 0; i < 16; ++i) { const int kk = (tid >> 6) + 8 * i; val[i] = src[(size_t)(kb * 128 + kk) * ldn + oc]; }
            asm volatile("" ::: "memory");
#pragma unroll
            for (int i = 0; i < 16; ++i) { const int kk = (tid >> 6) + 8 * i; tile[kk * 65 + nn] = o >= 0 ? val[i] : 0.f; }
        }
        __syncthreads();
#pragma unroll
        for (int j2 = 0; j2 < 2; ++j2) {
            const int item = tid + NTHR * j2, nn = item >> 4, kg = item & 15; h8 hv;
#pragma unroll
            for (int j = 0; j < 8; ++j) hv[j] = (f16)tile[(kg * 8 + j) * 65 + nn];
            *(GLB h8*)(dst + (size_t)(nb * 64 + nn) * 2048 + kb * 128 + kg * 8) = hv;
        }
        __syncthreads();
    }
    for (int u = F.bid; u < 2 * 96; u += F.G) {
        const int l = u / 96, cb = u % 96, kg = tid >> 6, n = tid & 63;
        float acc[32];
#pragma unroll
        for (int s = 0; s < 32; ++s) acc[s] = 0.f;
        GLB const float* W = F.in(I_WADA) + (size_t)l * 2048 * 6144 + cb * 64 + n;
        for (int kc = 0; kc < 4; ++kc) {
            float wv[32];
#pragma unroll
            for (int kk = 0; kk < 32; ++kk) wv[kk] = W[(size_t)(kc * 512 + kg * 64 + kk) * 6144];
            asm volatile("" ::: "memory");
            {
                float cv[32];
                GLB const float* cp = F.in(I_CP) + kc * 512 + tid; GLB const float* cs = F.in(I_CS) + kc * 512 + tid;
#pragma unroll
                for (int s = 0; s < 32; ++s) cv[s] = s < 16 ? cp[s * 2048] : cs[(s - 16) * 2048];
                asm volatile("" ::: "memory");
#pragma unroll
                for (int s = 0; s < 32; ++s) tile[s * 512 + tid] = siluf_(cv[s]);
            }
            __syncthreads();
#pragma unroll 1
            for (int hb = 0; hb < 2; ++hb) {
                if (hb) {
#pragma unroll
                    for (int kk = 0; kk < 32; ++kk) wv[kk] = W[(size_t)(kc * 512 + kg * 64 + 32 + kk) * 6144];
                    asm volatile("" ::: "memory");
                }
#pragma unroll
                for (int kk = 0; kk < 32; ++kk) { const int k = kg * 64 + hb * 32 + kk; const float w = wv[kk];
#pragma unroll
                    for (int s = 0; s < 32; ++s) acc[s] += tile[s * 512 + k] * w; }
            }
            __syncthreads();
        }
#pragma unroll
        for (int s = 0; s < 32; ++s) tile[(kg * 32 + s) * 64 + n] = acc[s];
        __syncthreads();
        for (int o = tid; o < 2048; o += NTHR) { const int s = o >> 6, nn = o & 63; float r = F.in(I_BADA)[l * 6144 + cb * 64 + nn];
#pragma unroll
            for (int g = 0; g < 8; ++g) r += tile[(g * 32 + s) * 64 + nn];
            F.ADA()[(size_t)(l * 32 + s) * 6144 + cb * 64 + nn] = r; }
        __syncthreads();
    }
}

DI void phase_norm(const Frame F0, int l, int slab) {
    const Frame F = F0.fresh();
    const int Ts = ts_of(slab);
    GLB const float* nw = F.in(I_NW) + l * 2048;
    f32x4 nwv[8];
#pragma unroll
    for (int i = 0; i < 8; ++i) nwv[i] = *(GLB const f32x4*)(nw + (i * 64 + F.lane) * 4);
    for (int rs = F.bid * NWAVES + F.wave; rs < Ts; rs += F.G * NWAVES) {
        int R, sq, t; rowinfo(slab, rs, R, sq, t);
        GLB const float* x = l == 0 ? (R < NTOKP ? F.in(I_XP) + (size_t)R * D : F.in(I_XS) + (size_t)(R - NTOKP) * D) : F.out() + (size_t)R * D;
        GLB const float* ad = F.ADA() + (size_t)(l * 32 + sq) * 6144;
        f32x4 v[8], shv[8], scv[8]; float ss = 0.f;
#pragma unroll
        for (int i = 0; i < 8; ++i) v[i] = *(GLB const f32x4*)(x + (i * 64 + F.lane) * 4);
#pragma unroll
        for (int i = 0; i < 8; ++i) { const int c = (i * 64 + F.lane) * 4; shv[i] = *(GLB const f32x4*)(ad + c); scv[i] = *(GLB const f32x4*)(ad + 2048 + c); }
        asm volatile("" ::: "memory");
#pragma unroll
        for (int i = 0; i < 8; ++i) ss += v[i][0] * v[i][0] + v[i][1] * v[i][1] + v[i][2] * v[i][2] + v[i][3] * v[i][3];
        ss = wave_sum(ss, F.lane);
        const float r = rsqrtf(ss * (1.0f / 2048.0f) + EPS);
#pragma unroll
        for (int i = 0; i < 8; ++i) { const int c = (i * 64 + F.lane) * 4;
            const f32x4 w = nwv[i], sh = shv[i], sc = scv[i];
            const f32x4 hv = v[i] * r * w * (sc + 1.0f) + sh;
            u32x2 p; p.x = pk_f16(hv[0], hv[1]); p.y = pk_f16(hv[2], hv[3]);
            *(GLB u32x2*)(F.H(slab & 1) + (size_t)rs * 2048 + c) = p; }
    }
    if (slab == 0) {
        const size_t gid = (size_t)F.bid * NTHR + F.tid, gsz = (size_t)F.G * NTHR;
        const size_t nk = (size_t)16 * PAST * 32;
        for (size_t g0 = gid; g0 < nk; g0 += 2 * gsz) {
            f32x4 ka[2][2], va[2][2]; size_t dofs[2]; bool ok[2];
#pragma unroll
            for (int e = 0; e < 2; ++e) {
                const size_t g1 = g0 + e * gsz; ok[e] = g1 < nk; const size_t g = ok[e] ? g1 : g0;
                const size_t b = g / (PAST * 32), rem = g % (PAST * 32), p = rem >> 5, c8 = (rem & 31) * 8;
                const size_t so = (size_t)l * 16 * PAST * 256 + g * 8; dofs[e] = ((size_t)32768 + b * LSMP + p) * 256 + c8;
                ka[e][0] = *(GLB const f32x4*)(F.in(I_CK) + so); ka[e][1] = *(GLB const f32x4*)(F.in(I_CK) + so + 4);
                va[e][0] = *(GLB const f32x4*)(F.in(I_CV) + so); va[e][1] = *(GLB const f32x4*)(F.in(I_CV) + so + 4);
            }
            asm volatile("" ::: "memory");
#pragma unroll
            for (int e = 0; e < 2; ++e) if (ok[e]) {
                { const f32x4 a = ka[e][0], bb = ka[e][1];
                  u32x4 w; w.x = pk_f16(a[0], a[1]); w.y = pk_f16(a[2], a[3]); w.z = pk_f16(bb[0], bb[1]); w.w = pk_f16(bb[2], bb[3]); *(GLB u32x4*)(F.KU() + dofs[e]) = w; }
                { const f32x4 a = va[e][0], bb = va[e][1];
                  u32x4 w; w.x = pk_f16(a[0], a[1]); w.y = pk_f16(a[2], a[3]); w.z = pk_f16(bb[0], bb[1]); w.w = pk_f16(bb[2], bb[3]); *(GLB u32x4*)(F.VU() + dofs[e]) = w; }
            }
        }
        const size_t ni = (size_t)16 * PAST * 8;
        for (size_t g0 = gid; g0 < ni; g0 += 4 * gsz) {
            f32x4 ia[4][2]; size_t dofs[4]; bool ok[4];
#pragma unroll
            for (int e = 0; e < 4; ++e) {
                const size_t g1 = g0 + e * gsz; ok[e] = g1 < ni; const size_t g = ok[e] ? g1 : g0;
                const size_t b = g / (PAST * 8), rem = g % (PAST * 8), p = rem >> 3, c8 = (rem & 7) * 8;
                const size_t so = (size_t)l * 16 * PAST * 64 + g * 8; dofs[e] = ((size_t)32768 + b * LSMP + p) * 64 + c8;
                ia[e][0] = *(GLB const f32x4*)(F.in(I_CIK) + so); ia[e][1] = *(GLB const f32x4*)(F.in(I_CIK) + so + 4);
            }
            asm volatile("" ::: "memory");
#pragma unroll
            for (int e = 0; e < 4; ++e) if (ok[e]) {
                const f32x4 a = ia[e][0], bb = ia[e][1];
                u32x4 w; w.x = pk_f16(a[0], a[1]); w.y = pk_f16(a[2], a[3]); w.z = pk_f16(bb[0], bb[1]); w.w = pk_f16(bb[2], bb[3]); *(GLB u32x4*)(F.KIU() + dofs[e]) = w;
            }
        }
    }
}

DI unsigned sortable(float f) { const unsigned u = __float_as_uint(f); return (u & 0x80000000u) ? ~u : (u | 0x80000000u); }


typedef float f32x16 __attribute__((ext_vector_type(16)));
typedef __fp16 fp16x4_t __attribute__((__vector_size__(4 * sizeof(__fp16))));
#define MFMA32(a, b, c) __builtin_amdgcn_mfma_f32_32x32x16_f16((a), (b), (c), 0, 0, 0)
#define SB() __builtin_amdgcn_sched_barrier(0)
#define PRIO(n) __builtin_amdgcn_s_setprio(n)
constexpr int AT_KV = 0, AT_BUF = 35840, AT_V = 17408, AT_ROW = 272, AT_VROW = 288;
constexpr int AT_QI = 0, AT_QIS = 1032;
constexpr int AT_MASK = 71680, AT_BT = AT_MASK + 32 * 65 * 8, AT_WI = AT_BT + 16 * 192 * 4, AT_END = AT_WI + 32 * 16 * 4;
static_assert(AT_END <= LDS_MISC && 32 * AT_QIS * 2 <= AT_MASK, "attention LDS map");
constexpr float LOG2E = 1.4426950408889634f, SCL2 = 0.08838834764831845f * LOG2E;


constexpr int GX = 0, GX_S = 400, GTF = 51200, GPT = GTF + 17408, GTAB = GPT + 4096, GAT = GTAB + 1536, GAT_S = 68, GTM = GAT + 17408, GT_S = 72, GTM2 = GTM + 9216, GPRE_END = GTM2 + 9216;
static_assert(GPRE_END <= LDS_MISC, "gdn pre LDS map");
DI void gdn_pre_unit(const Frame& F0, int l, int slab, int c, int hd) {
    const unsigned tst_10 = PROBE_T ? (unsigned)clock64() : 0u;
    const Frame F = F0.fresh();
    const int tid = F.tid, lane = F.lane, wave = F.wave, r32 = lane & 31, h2 = lane >> 5;
    LAS unsigned char* lds = F.lds;
    LAS f16* X = (LAS f16*)(lds + GX);
    LAS float* TF = (LAS float*)(lds + GTF);
    LAS float* PT = (LAS float*)(lds + GPT);
    LAS float* TAB = (LAS float*)(lds + GTAB);
    LAS float* AT = (LAS float*)(lds + GAT);
    LAS f16* TM = (LAS f16*)(lds + GTM);
    LAS f16* TM2 = (LAS f16*)(lds + GTM2);
    const bool smp = c >= 128;
    const int sq = smp ? 16 + (c - 128) : slab * 4 + (c >> 5), n = smp ? 0 : (c & 31), b = sq & 15;
    const int rsb = smp ? 8192 + (sq - 16) * 64 : (sq - slab * 4) * 2048 + n * 64;
    const int Rb = smp ? NTOKP + (sq - 16) * 64 : sq * 2048 + n * 64;
    GLB const f16* PROJ = F.PROJ();
    GLB unsigned char* gp = F.ws() + WS_GP + (size_t)(c * 16 + hd) * GP_STRIDE;
    {
        GLB const float* wcv = F.in(I_WCONV) + (size_t)l * 4 * 6144;
        GLB const float* scv = F.in(I_SC) + (size_t)(l * 16 + b) * 3 * 6144;
        if (tid < 384) {
            const int run = tid / 48, cg = tid % 48, part = cg >> 4, c8 = (cg & 15) * 8, gch = part * 2048 + hd * 128 + c8, tok0 = run * 8;
            h8 xr[11];
#pragma unroll
            for (int r = 0; r < 11; ++r) {
                const int tt = tok0 - 3 + r;
                if (tt >= 0 || n > 0) xr[r] = *(GLB const h8*)(PROJ + (size_t)(rsb + tt) * PS + gch);
                else if (smp) { const f32x4 a = *(GLB const f32x4*)(scv + (size_t)(3 + tt) * 6144 + gch), bq = *(GLB const f32x4*)(scv + (size_t)(3 + tt) * 6144 + gch + 4);
                    h8 t; t[0] = (f16)a[0]; t[1] = (f16)a[1]; t[2] = (f16)a[2]; t[3] = (f16)a[3]; t[4] = (f16)bq[0]; t[5] = (f16)bq[1]; t[6] = (f16)bq[2]; t[7] = (f16)bq[3]; xr[r] = t; }
                else {
#pragma unroll
                    for (int j = 0; j < 8; ++j) xr[r][j] = (f16)0.f; }
            }
            float w[4][8];
#pragma unroll
            for (int tap = 0; tap < 4; ++tap) { const f32x4 w0 = *(GLB const f32x4*)(wcv + tap * 6144 + gch), w1 = *(GLB const f32x4*)(wcv + tap * 6144 + gch + 4);
#pragma unroll
                for (int j = 0; j < 4; ++j) { w[tap][j] = w0[j]; w[tap][4 + j] = w1[j]; } }
            h8 y[8];
#pragma unroll
            for (int tq = 0; tq < 8; ++tq)
#pragma unroll
                for (int j = 0; j < 8; ++j) {
                    const float acc = w[0][j] * (float)xr[tq][j] + w[1][j] * (float)xr[tq + 1][j] + w[2][j] * (float)xr[tq + 2][j] + w[3][j] * (float)xr[tq + 3][j];
                    y[tq][j] = (f16)siluf_(acc);
                }
#pragma unroll
            for (int tq = 0; tq < 8; ++tq) *(LAS h8*)(X + (tok0 + tq) * GX_S + cg * 8) = y[tq];
        }
        if (wave == 7) {
            const float be = F.BETA()[(size_t)(Rb + lane) * 16 + hd];
            float gcv = F.GG()[(size_t)(Rb + lane) * 16 + hd];
#pragma unroll
            for (int o = 1; o < 64; o <<= 1) { const float tv = __builtin_bit_cast(float, __builtin_amdgcn_ds_bpermute(((lane - o) & 63) << 2, __builtin_bit_cast(int, gcv))); if (lane >= o) gcv += tv; }
            const float gl = __builtin_bit_cast(float, __builtin_amdgcn_readlane(__builtin_bit_cast(int, gcv), 63));
            TAB[128 + lane] = be; TAB[192 + lane] = gcv; TAB[256 + lane] = __expf(gcv); TAB[320 + lane] = __expf(gl - gcv);
            if (lane == 63) ((GLB float*)(F.ws() + WS_GL))[c * 16 + hd] = __expf(gl);
        }
    }
    __syncthreads();
    {
        const int tok = tid >> 3, part = tid & 7;
        float sq_ = 0.f, sk_ = 0.f;
#pragma unroll
        for (int u = 0; u < 2; ++u) { const h8 a = *(const LAS h8*)(X + tok * GX_S + part * 16 + u * 8), k = *(const LAS h8*)(X + tok * GX_S + 128 + part * 16 + u * 8);
#pragma unroll
            for (int j = 0; j < 8; ++j) { sq_ += (float)a[j] * (float)a[j]; sk_ += (float)k[j] * (float)k[j]; } }
        { sq_ += swz_xor<4>(sq_); sk_ += swz_xor<4>(sk_); sq_ += swz_xor<2>(sq_); sk_ += swz_xor<2>(sk_); sq_ += swz_xor<1>(sq_); sk_ += swz_xor<1>(sk_); }
        if (part == 0) { TAB[tok] = rsqrtf(sq_ + EPS) * 0.08838834764831845f; TAB[64 + tok] = rsqrtf(sk_ + EPS); }
    }
    __syncthreads();
    if (wave < 6) {
        const bool isqk = wave >= 3; const int ti = isqk ? wave - 3 : wave;
        const int rt = isqk ? (ti == 2 ? 1 : 0) : (wave == 2 ? 1 : 0), ct = isqk ? (ti == 0 ? 0 : 1) : (wave == 0 ? 0 : 1);
        f32x16 acc;
#pragma unroll
        for (int i = 0; i < 16; ++i) acc[i] = 0.f;
        {
            h8 fa[8], fb[8];
#pragma unroll
            for (int s = 0; s < 8; ++s) { fa[s] = *(const LAS h8*)(X + (32 * rt + r32) * GX_S + 128 + 16 * s + 8 * h2);
                fb[s] = *(const LAS h8*)(X + (32 * ct + r32) * GX_S + (isqk ? 0 : 128) + 16 * s + 8 * h2); }
            SB();
#pragma unroll
            for (int s = 0; s < 8; ++s) acc = MFMA32(fa[s], fb[s], acc);
            SB();
        }
        const int col = 32 * ct + r32;
        if (!isqk) {
            const float bk = TAB[128 + col] * TAB[64 + col], gck = TAB[192 + col];
#pragma unroll
            for (int g = 0; g < 4; ++g) { const int j0 = 32 * rt + 8 * g + 4 * h2;
                const f32x4 rk = *(const LAS f32x4*)(TAB + 64 + j0), gj = *(const LAS f32x4*)(TAB + 192 + j0);
                f32x4 v;
#pragma unroll
                for (int jj = 0; jj < 4; ++jj) v[jj] = (col > j0 + jj) ? bk * rk[jj] * acc[4 * g + jj] * __expf(fminf(gck - gj[jj], 0.f)) : 0.f;
                *(LAS f32x4*)(AT + col * GAT_S + j0) = v; }
        } else {
            const float rqi = TAB[col], gci = TAB[192 + col];
#pragma unroll
            for (int g = 0; g < 4; ++g) { const int j0 = 32 * rt + 8 * g + 4 * h2;
                const f32x4 rk = *(const LAS f32x4*)(TAB + 64 + j0), gj = *(const LAS f32x4*)(TAB + 192 + j0);
                h4 v;
#pragma unroll
                for (int jj = 0; jj < 4; ++jj) v[jj] = (f16)((col >= j0 + jj) ? rqi * rk[jj] * acc[4 * g + jj] * __expf(fminf(gci - gj[jj], 0.f)) : 0.f);
                *(GLB h4*)(gp + GP_QK + (col * 64 + j0) * 2) = v; }
        }
    } else if (wave == 6) {
#pragma unroll
        for (int u = 0; u < 4; ++u) { const int p = lane + 64 * u, i = p >> 3, j0 = 32 + (p & 7) * 4; *(GLB h4*)(gp + GP_QK + (i * 64 + j0) * 2) = (h4){(f16)0.f, (f16)0.f, (f16)0.f, (f16)0.f}; }
    }
    if (wave == 0 || wave == 2) {
        const int bs = wave == 0 ? 0 : 32;
        asm volatile("s_waitcnt lgkmcnt(0)" ::: "memory");
        {
            const int o = bs + 16 * ((lane >> 4) & 1), cc = lane & 15;
            float T[16];
            f32x4 Ar[16][4];
#pragma unroll
            for (int i = 1; i < 16; ++i)
#pragma unroll
                for (int jg = 0; jg < (i + 3) / 4; ++jg) Ar[i][jg] = *(const LAS f32x4*)(AT + (o + i) * GAT_S + o + 4 * jg);
            asm volatile("" ::: "memory");
#pragma unroll
            for (int i = 0; i < 16; ++i) {
                float sacc = (i == cc) ? 1.f : 0.f;
#pragma unroll
                for (int jg = 0; jg < (i + 3) / 4; ++jg) { const f32x4 a4 = Ar[i][jg];
#pragma unroll
                    for (int jj = 0; jj < 4; ++jj) if (4 * jg + jj < i) sacc -= a4[jj] * T[4 * jg + jj]; }
                T[i] = sacc;
            }
            if (lane < 32) {
#pragma unroll
                for (int i = 0; i < 16; ++i) TF[(o + i) * GAT_S + o + cc] = T[i];
            }
        }
        asm volatile("s_waitcnt lgkmcnt(0)" ::: "memory");
        {
            const int r16 = lane & 15, k4 = lane >> 4, i = lane >> 2, c4 = (lane & 3) * 4;
            float a[4], b[4];
#pragma unroll
            for (int kk = 0; kk < 4; ++kk) { a[kk] = AT[(bs + 16 + r16) * GAT_S + bs + 4 * kk + k4]; b[kk] = TF[(bs + 4 * kk + k4) * GAT_S + bs + r16]; }
            f32x4 p = {0.f, 0.f, 0.f, 0.f};
#pragma unroll
            for (int kk = 0; kk < 4; ++kk) p = __builtin_amdgcn_mfma_f32_16x16x4f32(a[kk], b[kk], p, 0, 0, 0);
#pragma unroll
            for (int q = 0; q < 4; ++q) PT[(bs >> 5) * 256 + (4 * k4 + q) * 16 + r16] = p[q];
            { float zz = 0.f; asm volatile("" : "+v"(zz)); *(LAS f32x4*)(TF + (bs + i) * GAT_S + bs + 16 + c4) = (f32x4){zz, zz, zz, zz}; }
            asm volatile("s_waitcnt lgkmcnt(0)" ::: "memory");
#pragma unroll
            for (int kk = 0; kk < 4; ++kk) { a[kk] = TF[(bs + 16 + r16) * GAT_S + bs + 16 + 4 * kk + k4]; b[kk] = PT[(bs >> 5) * 256 + (4 * kk + k4) * 16 + r16]; }
            f32x4 v = {0.f, 0.f, 0.f, 0.f};
#pragma unroll
            for (int kk = 0; kk < 4; ++kk) v = __builtin_amdgcn_mfma_f32_16x16x4f32(a[kk], b[kk], v, 0, 0, 0);
#pragma unroll
            for (int q = 0; q < 4; ++q) TF[(bs + 16 + 4 * k4 + q) * GAT_S + bs + r16] = -v[q];
        }
    } else {
        const int e = (wave == 1 ? 0 : wave - 2) * 64 + lane;
#pragma unroll 1
        for (int item = e; item < 2048; item += 384) {
            const int which = item >> 10, rem = item & 1023, tok = rem >> 4, c8 = (rem & 15) * 8;
            const h8 xv = *(const LAS h8*)(X + tok * GX_S + (which ? 128 : 0) + c8);
            const float sc = which ? TAB[64 + tok] * TAB[320 + tok] : TAB[tok] * TAB[256 + tok];
            h8 o;
#pragma unroll
            for (int j = 0; j < 8; ++j) o[j] = (f16)((float)xv[j] * sc);
            *(GLB h8*)(gp + (which ? GP_KD : GP_QD) + (tok * 128 + c8) * 2) = o;
        }
    }
    __syncthreads();
    {
        const int ti = (wave >> 1) & 1, tj = wave & 1, r16 = lane & 15, k4 = lane >> 4;
        if (wave < 4) {
            float a[8], b[8];
#pragma unroll
            for (int kk = 0; kk < 8; ++kk) { a[kk] = AT[(32 + 16 * ti + r16) * GAT_S + 4 * kk + k4]; b[kk] = TF[(4 * kk + k4) * GAT_S + 16 * tj + r16]; }
            f32x4 pacc = {0.f, 0.f, 0.f, 0.f};
#pragma unroll
            for (int kk = 0; kk < 8; ++kk) pacc = __builtin_amdgcn_mfma_f32_16x16x4f32(a[kk], b[kk], pacc, 0, 0, 0);
#pragma unroll
            for (int i = 0; i < 4; ++i) PT[(16 * ti + 4 * k4 + i) * 32 + 16 * tj + r16] = pacc[i];
        }
        __syncthreads();
        if (wave < 4) {
            float a[8], b[8];
#pragma unroll
            for (int kk = 0; kk < 8; ++kk) { a[kk] = TF[(32 + 16 * ti + r16) * GAT_S + 32 + 4 * kk + k4]; b[kk] = PT[(4 * kk + k4) * 32 + 16 * tj + r16]; }
            f32x4 vacc = {0.f, 0.f, 0.f, 0.f};
#pragma unroll
            for (int kk = 0; kk < 8; ++kk) vacc = __builtin_amdgcn_mfma_f32_16x16x4f32(a[kk], b[kk], vacc, 0, 0, 0);
#pragma unroll
            for (int i = 0; i < 4; ++i) TF[(32 + 16 * ti + 4 * k4 + i) * GAT_S + 16 * tj + r16] = -vacc[i];
        }
    }
    __syncthreads();
    {
        const int i = tid >> 3, jg = tid & 7; h8 o, o2;
#pragma unroll
        for (int jj = 0; jj < 8; ++jj) { const int j = 8 * jg + jj; const float tv = (i < 32 && jg >= 4) ? 0.f : TF[i * GAT_S + j]; const float bj = TAB[128 + j];
            o[jj] = (f16)(tv * bj * TAB[64 + j] * TAB[256 + j]); o2[jj] = (f16)(tv * bj); }
        *(LAS h8*)(TM + i * GT_S + 8 * jg) = o; *(LAS h8*)(TM2 + i * GT_S + 8 * jg) = o2;
    }
    __syncthreads();
    {
        const int mt = wave & 3, nt = wave >> 2;
        const int i16 = lane & 15, q4 = i16 >> 2, p4 = i16 & 3, blk = (lane >> 4) & 1;
        f32x16 aw, au;
#pragma unroll
        for (int i = 0; i < 16; ++i) { aw[i] = 0.f; au[i] = 0.f; }
        {
            h8 tb[4], tb2[4], ka[4], vb[4];
#pragma unroll
            for (int s = 0; s < 4; ++s) {
                tb[s] = *(const LAS h8*)(TM + (32 * nt + r32) * GT_S + 16 * s + 8 * h2);
                tb2[s] = *(const LAS h8*)(TM2 + (32 * nt + r32) * GT_S + 16 * s + 8 * h2);
                LAS unsigned char* kp = (LAS unsigned char*)X + (16 * s + 8 * h2 + q4) * (GX_S * 2) + 2 * (128 + 32 * mt) + 8 * (4 * blk + p4);
                LAS unsigned char* vp = (LAS unsigned char*)X + (16 * s + 8 * h2 + q4) * (GX_S * 2) + 2 * (256 + 32 * mt) + 8 * (4 * blk + p4);
                const fp16x4_t klo = __builtin_amdgcn_ds_read_tr16_b64_v4f16((LAS fp16x4_t*)kp), khi = __builtin_amdgcn_ds_read_tr16_b64_v4f16((LAS fp16x4_t*)(kp + 4 * GX_S * 2));
                const fp16x4_t vlo = __builtin_amdgcn_ds_read_tr16_b64_v4f16((LAS fp16x4_t*)vp), vhi = __builtin_amdgcn_ds_read_tr16_b64_v4f16((LAS fp16x4_t*)(vp + 4 * GX_S * 2));
                ka[s] = __builtin_shufflevector(__builtin_bit_cast(h4, klo), __builtin_bit_cast(h4, khi), 0, 1, 2, 3, 4, 5, 6, 7);
                vb[s] = __builtin_shufflevector(__builtin_bit_cast(h4, vlo), __builtin_bit_cast(h4, vhi), 0, 1, 2, 3, 4, 5, 6, 7);
            }
            SB();
#pragma unroll
            for (int s = 0; s < 4; ++s) { aw = MFMA32(ka[s], tb[s], aw); au = MFMA32(tb2[s], vb[s], au); }
            SB();
        }
#pragma unroll
        for (int g = 0; g < 4; ++g) {
            h4 w4, u4;
#pragma unroll
            for (int jj = 0; jj < 4; ++jj) { w4[jj] = (f16)aw[4 * g + jj]; u4[jj] = (f16)au[4 * g + jj]; }
            *(GLB h4*)(gp + GP_W + ((32 * nt + r32) * 128 + 32 * mt + 8 * g + 4 * h2) * 2) = w4;
            *(GLB h4*)(gp + GP_U + (((mt * 2 + nt) * 4 + g) * 64 + lane) * 8) = u4;
        }
    }
    __syncthreads();
    if (PROBE_T && (lane_id_fresh() + F0.wave * 64) == 0) __hip_atomic_fetch_add((unsigned long long*)(F0.ctl() + CW_T) + 10, (unsigned long long)((unsigned)clock64() - tst_10), __ATOMIC_RELAXED, __HIP_MEMORY_SCOPE_AGENT);
}

constexpr int SC_W = 0, SC_QD = 17408, SC_KD = 34816, SC_QK = 53248, SC_BUF = 62464, SC_KROW = 288, SC_SSQ = 2 * SC_BUF, SC_END = SC_SSQ + 1024;
static_assert(SC_END <= LDS_MISC, "gdn scan LDS map");
DI void gdn_scan_unit(const Frame& F0, int l, int slab, int sq, int hd) {
    const unsigned tst_9 = PROBE_T ? (unsigned)clock64() : 0u;
    const Frame F = F0.fresh();
    const int tid = F.tid, lane = F.lane, wave = F.wave, r32 = lane & 31, h2 = lane >> 5;
    const int i16 = lane & 15, q4 = i16 >> 2, p4 = i16 & 3, blk = (lane >> 4) & 1;
    LAS unsigned char* lds = F.lds;
    LAS float* ssq = (LAS float*)(lds + SC_SSQ);
    const bool smp = sq >= 16; const int b = sq & 15, nch = smp ? 1 : 32;
    const int c0 = smp ? 128 + (sq - 16) : (sq - slab * 4) * 32;
    const int rs0 = smp ? 8192 + (sq - 16) * 64 : (sq - slab * 4) * 2048;
    GLB const unsigned char* gpb = F.ws() + WS_GP + (size_t)hd * GP_STRIDE;
    GLB const float* GLp = (GLB const float*)(F.ws() + WS_GL);
    const int w = wave;
    f32x16 S[4];
    if (wave < 4) {
        GLB const float* s0 = F.in(I_SG) + ((size_t)(l * 16 + b) * 16 + hd) * 16384;
#pragma unroll
        for (int mt = 0; mt < 4; ++mt)
#pragma unroll
            for (int i = 0; i < 16; ++i) S[mt][i] = smp ? s0[(32 * mt + (i & 3) + 8 * (i >> 2) + 4 * h2) * 128 + 32 * w + r32] : 0.f;
    }
    const int lt = tid - 256;
    h4 uf[2][4];
    if (wave < 4) { GLB const unsigned char* up = gpb + (size_t)c0 * 16 * GP_STRIDE + GP_U;
#pragma unroll
        for (int tm = 0; tm < 2; ++tm)
#pragma unroll
            for (int g = 0; g < 4; ++g) uf[tm][g] = *(GLB const h4*)(up + (((w * 2 + tm) * 4 + g) * 64 + lane) * 8); }
#define SC_LOAD(cc) do { GLB const unsigned char* src = gpb + (size_t)(cc) * 16 * GP_STRIDE; \
        _Pragma("unroll") for (int it = 0; it < 4; ++it) { const int i = lt + 256 * it, row = i >> 4, c8 = (i & 15) * 8; const int go = (row * 128 + c8) * 2; \
            t0[it] = *(GLB const u32x4*)(src + GP_W + go); t1[it] = *(GLB const u32x4*)(src + GP_QD + go); t2[it] = *(GLB const u32x4*)(src + GP_KD + go); } \
        _Pragma("unroll") for (int it = 0; it < 2; ++it) { const int i = lt + 256 * it, row = i >> 3, c8 = (i & 7) * 8; t3[it] = *(GLB const u32x4*)(src + GP_QK + (row * 64 + c8) * 2); } } while (0)
#define SC_STORE(bufi) do { LAS unsigned char* dst = lds + (bufi) * SC_BUF; \
        _Pragma("unroll") for (int it = 0; it < 4; ++it) { const int i = lt + 256 * it, row = i >> 4, c8 = (i & 15) * 8; const int lo = row * 272 + c8 * 2; \
            *(LAS u32x4*)(dst + SC_W + lo) = t0[it]; *(LAS u32x4*)(dst + SC_QD + lo) = t1[it]; *(LAS u32x4*)(dst + SC_KD + row * SC_KROW + c8 * 2) = t2[it]; } \
        _Pragma("unroll") for (int it = 0; it < 2; ++it) { const int i = lt + 256 * it, row = i >> 3, c8 = (i & 7) * 8; *(LAS u32x4*)(dst + SC_QK + row * 144 + c8 * 2) = t3[it]; } } while (0)
    u32x4 t0[4], t1[4], t2[4], t3[2];
    if (wave >= 4) { SC_LOAD(c0); SC_STORE(0); }
    __syncthreads();
    const float gnw0 = 0.f; (void)gnw0;
    if (wave >= 4) {
        if (nch > 1) SC_LOAD(c0 + 1);
#pragma unroll 1
        for (int n = 0; n < nch; ++n) {
            int tl_ = lane_id_fresh() + wave * 64; asm volatile("" : "+v"(tl_));
            const int lt = tl_ - 256; const bool more = (n + 1) < nch;
        asm volatile("s_waitcnt lgkmcnt(0)" ::: "memory"); __builtin_amdgcn_s_barrier(); asm volatile("" ::: "memory");
            if (more) { SC_STORE((n + 1) & 1); if (n + 2 < nch) SC_LOAD(c0 + n + 2); }
        asm volatile("s_waitcnt lgkmcnt(0)" ::: "memory"); __builtin_amdgcn_s_barrier(); asm volatile("" ::: "memory");
        }
    } else {
    f32x4 gwv[4];
    { GLB const float* gnw = F.in(I_GNW) + l * 128;
#pragma unroll
      for (int g = 0; g < 4; ++g) gwv[g] = *(GLB const f32x4*)(gnw + 32 * w + 8 * g + 4 * h2); }
#pragma unroll 1
    for (int n = 0; n < nch; ++n) {
        const int c = c0 + n;
        int tl_ = lane_id_fresh() + wave * 64; asm volatile("" : "+v"(tl_));
        const int lt = tl_ - 256, lane = tl_ & 63, r32 = lane & 31, h2 = lane >> 5, i16 = lane & 15, q4 = i16 >> 2, p4 = i16 & 3, blk = (lane >> 4) & 1;
        LAS unsigned char* bufp = lds + (n & 1) * SC_BUF;
        f32x16 oT[2];
        h8 VNp[2][2];
        const bool more = (n + 1) < nch;
        float gl = 0.f; h4 zaf[2][4];
            gl = GLp[c * 16 + hd];
            h8 Sp[4][2];
#pragma unroll
            for (int mt = 0; mt < 4; ++mt)
#pragma unroll
                for (int ks = 0; ks < 2; ++ks) { h8 t;
#pragma unroll
                    for (int jj = 0; jj < 8; ++jj) t[jj] = (f16)S[mt][8 * ks + jj];
                    Sp[mt][ks] = t; }
#pragma unroll
            for (int tm = 0; tm < 2; ++tm) {
                h8 wf[8];
#pragma unroll
                for (int kq = 0; kq < 8; ++kq) {
                    LAS unsigned char* ap = bufp + SC_W + (32 * tm + r32) * 272 + 2 * (16 * kq + 4 * h2);
                    const h4 lo = *(const LAS h4*)ap, hi = *(const LAS h4*)(ap + 16);
                    wf[kq] = __builtin_shufflevector(lo, hi, 0, 1, 2, 3, 4, 5, 6, 7);
                }
                f32x16 ws;
#pragma unroll
                for (int i = 0; i < 16; ++i) ws[i] = 0.f;
                SB();
#pragma unroll
                for (int kq = 0; kq < 8; ++kq) ws = MFMA32(wf[kq], Sp[kq >> 1][kq & 1], ws);
                SB();
#pragma unroll
                for (int g = 0; g < 4; ++g)
#pragma unroll
                    for (int jj = 0; jj < 4; ++jj) ws[4 * g + jj] = (float)uf[tm][g][jj] - ws[4 * g + jj];
#pragma unroll
                for (int ks = 0; ks < 2; ++ks) { h8 t;
#pragma unroll
                    for (int jj = 0; jj < 8; ++jj) t[jj] = (f16)ws[8 * ks + jj];
                    VNp[tm][ks] = t; }
            }
            {
                GLB const f16* PROJ = F.PROJ();
#pragma unroll
                for (int tn = 0; tn < 2; ++tn)
#pragma unroll
                    for (int g = 0; g < 4; ++g) zaf[tn][g] = *(GLB const h4*)(PROJ + (size_t)(rs0 + 64 * n + 32 * tn + r32) * PS + C_ZA + hd * 128 + 32 * w + 8 * g + 4 * h2);
            }
#pragma unroll
            for (int tn = 0; tn < 2; ++tn) {
                f32x16 o;
#pragma unroll
                for (int i = 0; i < 16; ++i) o[i] = 0.f;
#pragma unroll
                for (int hb = 0; hb < 2; ++hb) {
                    h8 bf[4];
#pragma unroll
                    for (int kq = 0; kq < 4; ++kq) {
                        LAS unsigned char* bp = bufp + SC_QD + (32 * tn + r32) * 272 + 2 * (16 * (4 * hb + kq) + 4 * h2);
                        const h4 lo = *(const LAS h4*)bp, hi = *(const LAS h4*)(bp + 16);
                        bf[kq] = __builtin_shufflevector(lo, hi, 0, 1, 2, 3, 4, 5, 6, 7);
                    }
                    SB();
#pragma unroll
                    for (int kq = 0; kq < 4; ++kq) o = MFMA32(Sp[(4 * hb + kq) >> 1][kq & 1], bf[kq], o);
                    SB();
                }
                {
                    h8 bf[4];
#pragma unroll
                    for (int kq = 0; kq < 4; ++kq) {
                        LAS unsigned char* bp = bufp + SC_QK + (32 * tn + r32) * 144 + 2 * (16 * kq + 4 * h2);
                        const h4 lo = *(const LAS h4*)bp, hi = *(const LAS h4*)(bp + 16);
                        bf[kq] = __builtin_shufflevector(lo, hi, 0, 1, 2, 3, 4, 5, 6, 7);
                    }
                    SB();
#pragma unroll
                    for (int kq = 0; kq < 4; ++kq) o = MFMA32(VNp[kq >> 1][kq & 1], bf[kq], o);
                    SB();
                }
                oT[tn] = o;
                float sacc = 0.f;
#pragma unroll
                for (int i = 0; i < 16; ++i) sacc += o[i] * o[i];
                sacc += shx32(sacc, lane);
                if (h2 == 0) ssq[w * 64 + 32 * tn + r32] = sacc;
            }
            if (n + 1 < nch) {
                GLB const unsigned char* up = gpb + (size_t)(c + 1) * 16 * GP_STRIDE + GP_U;
#pragma unroll
                for (int tm = 0; tm < 2; ++tm)
#pragma unroll
                    for (int g = 0; g < 4; ++g) uf[tm][g] = *(GLB const h4*)(up + (((w * 2 + tm) * 4 + g) * 64 + lane) * 8);
            }
        asm volatile("s_waitcnt lgkmcnt(0)" ::: "memory"); __builtin_amdgcn_s_barrier(); asm volatile("" ::: "memory");
        {
#pragma unroll
            for (int tn = 0; tn < 2; ++tn) {
                const int tok = 32 * tn + r32;
                const float tot = ssq[tok] + ssq[64 + tok] + ssq[128 + tok] + ssq[192 + tok];
                const float rstd = rsqrtf(tot * (1.0f / 128.0f) + EPS);
                const size_t rs = (size_t)(rs0 + 64 * n + tok);
#pragma unroll
                for (int g = 0; g < 4; ++g) {
                    const int dv0 = 32 * w + 8 * g + 4 * h2;
                    const f32x4 gw = gwv[g];
                    const h4 za = zaf[tn][g];
                    h4 ov;
#pragma unroll
                    for (int jj = 0; jj < 4; ++jj) ov[jj] = (f16)(oT[tn][4 * g + jj] * rstd * gw[jj] * (float)za[jj]);
                    *(GLB h4*)(F.OA() + rs * 2048 + hd * 128 + dv0) = ov;
                }
            }
#pragma unroll
            for (int mp = 0; mp < 2; ++mp) {
                h8 kf[2][4];
#pragma unroll
                for (int ml = 0; ml < 2; ++ml)
#pragma unroll
                    for (int kq = 0; kq < 4; ++kq) {
                        LAS unsigned char* ap = bufp + SC_KD + (16 * kq + 4 * h2 + q4) * SC_KROW + 64 * (2 * mp + ml) + 8 * (4 * blk + p4);
                        const fp16x4_t lo = __builtin_amdgcn_ds_read_tr16_b64_v4f16((LAS fp16x4_t*)ap);
                        const fp16x4_t hi = __builtin_amdgcn_ds_read_tr16_b64_v4f16((LAS fp16x4_t*)(ap + 8 * SC_KROW));
                        kf[ml][kq] = __builtin_shufflevector(__builtin_bit_cast(h4, lo), __builtin_bit_cast(h4, hi), 0, 1, 2, 3, 4, 5, 6, 7);
                    }
#pragma unroll
                for (int i = 0; i < 16; ++i) { S[2 * mp][i] *= gl; S[2 * mp + 1][i] *= gl; }
                SB();
#pragma unroll
                for (int kq = 0; kq < 4; ++kq) { S[2 * mp] = MFMA32(kf[0][kq], VNp[kq >> 1][kq & 1], S[2 * mp]); S[2 * mp + 1] = MFMA32(kf[1][kq], VNp[kq >> 1][kq & 1], S[2 * mp + 1]); }
                SB();
            }
        }
        asm volatile("s_waitcnt lgkmcnt(0)" ::: "memory"); __builtin_amdgcn_s_barrier(); asm volatile("" ::: "memory");
    }
    }
#undef SC_LOAD
#undef SC_STORE
    if (wave < 4) {
        GLB float* so = F.out() + (smp ? O_NGS : O_NGP) + ((size_t)(l * 16 + b) * 16 + hd) * 16384;
#pragma unroll
        for (int mt = 0; mt < 4; ++mt)
#pragma unroll
            for (int i = 0; i < 16; ++i) so[(32 * mt + (i & 3) + 8 * (i >> 2) + 4 * h2) * 128 + 32 * w + r32] = S[mt][i];
    }
    __syncthreads();
    if (PROBE_T && (lane_id_fresh() + F0.wave * 64) == 0) __hip_atomic_fetch_add((unsigned long long*)(F0.ctl() + CW_T) + 9, (unsigned long long)((unsigned)clock64() - tst_9), __ATOMIC_RELAXED, __HIP_MEMORY_SCOPE_AGENT);
}

template <int NKMAX>
DI void select_rows(GLB const float* scr, GLB unsigned long long* mask, int wave, int lane, int nk, int nvis) {
#pragma unroll 1
    for (int r = 0; r < 4; ++r) {
        const int q = wave * 4 + r;
        unsigned u[NKMAX];
#pragma unroll
        for (int k = 0; k < NKMAX; ++k) u[k] = __float_as_uint(scr[(size_t)q * LDR + 64 * k + lane]);
        asm volatile("" ::: "memory");
#pragma unroll
        for (int k = 0; k < NKMAX; ++k) u[k] = (k < nk) ? sortable(__uint_as_float(u[k])) : 0u;
        unsigned thr = 0u;
        if (nvis > 256) {
#pragma unroll 1
            for (int bit = 31; bit >= 0; --bit) {
                const unsigned cand = thr | (1u << bit);
                int c = 0;
#pragma unroll
                for (int k = 0; k < NKMAX; ++k) c += (int)__popcll(__ballot(u[k] >= cand));
                if (c >= 256) thr = cand;
                if (c == 256) break;
            }
        }
#pragma unroll
        for (int k = 0; k < NKMAX; ++k) { const unsigned long long bal = __ballot(u[k] >= thr); if (k < nk && lane == 0) mask[q * 65 + k] = bal; }
    }
}

DI unsigned wave_prefix_incl(unsigned v) {
    v += (unsigned)__builtin_amdgcn_update_dpp(0, (int)v, 0x111, 0xf, 0xf, true);
    v += (unsigned)__builtin_amdgcn_update_dpp(0, (int)v, 0x112, 0xf, 0xf, true);
    v += (unsigned)__builtin_amdgcn_update_dpp(0, (int)v, 0x114, 0xf, 0xf, true);
    v += (unsigned)__builtin_amdgcn_update_dpp(0, (int)v, 0x118, 0xf, 0xf, true);
    v += (unsigned)__builtin_amdgcn_update_dpp(0, (int)v, 0x142, 0xa, 0xf, false);
    v += (unsigned)__builtin_amdgcn_update_dpp(0, (int)v, 0x143, 0xc, 0xf, false);
    return v;
}
template <int NKMAX>
DI void select_rows_hist(GLB const float* scr, GLB unsigned long long* mask, LAS unsigned* hist, int wave, int lane, int nk, unsigned* chk) {
#pragma unroll 1
    for (int r = 0; r < 4; ++r) {
        const int q = wave * 4 + r;
        unsigned u[NKMAX];
#pragma unroll
        for (int k = 0; k < NKMAX; ++k) u[k] = __float_as_uint(scr[(size_t)q * LDR + 64 * k + lane]);
        asm volatile("" ::: "memory");
#pragma unroll
        for (int k = 0; k < NKMAX; ++k) u[k] = (k < nk) ? sortable(__uint_as_float(u[k])) : 0u;
        unsigned prefix = 0u, pmask = 0u, need = 256u;
#pragma unroll 1
        for (int pass = 0; pass < 3; ++pass) {
            const int shift = pass == 0 ? 21 : (pass == 1 ? 10 : 0);
            const unsigned bm = pass == 2 ? 1023u : 2047u;
#pragma unroll
            for (int i = 0; i < 8; ++i) *(LAS u32x4*)(hist + (i * 64 + lane) * 4) = (u32x4){0u, 0u, 0u, 0u};
#pragma unroll
            for (int k = 0; k < NKMAX; ++k)
                if (k < nk && (u[k] & pmask) == prefix) __hip_atomic_fetch_add(hist + ((u[k] >> shift) & bm), 1u, __ATOMIC_RELAXED, __HIP_MEMORY_SCOPE_WORKGROUP);
            unsigned s = 0u;
#pragma unroll
            for (int i = 0; i < 8; ++i) { const u32x4 v = *(const LAS u32x4*)(hist + (63 - lane) * 32 + 4 * i); s += v[0] + v[1] + v[2] + v[3]; }
            const unsigned P = wave_prefix_incl(s);
            const int Ls = (int)__builtin_ctzll(__ballot(P >= need));
            const unsigned above = (unsigned)__builtin_amdgcn_readlane((int)(P - s), Ls);
            const int grp = 63 - Ls;
            const unsigned hb = hist[grp * 32 + 31 - (lane & 31)];
            const unsigned Pb = wave_prefix_incl(hb);
            const int js = (int)__builtin_ctzll(__ballot(above + Pb >= need));
            need -= (unsigned)__builtin_amdgcn_readlane((int)(above + Pb - hb), js);
            prefix |= (unsigned)(grp * 32 + 31 - js) << shift; pmask |= bm << shift;
        }
        const unsigned thr = prefix;
        if (SELCHK) {
            unsigned t2 = 0u;
#pragma unroll 1
            for (int bit = 31; bit >= 0; --bit) { const unsigned cand = t2 | (1u << bit); int c = 0;
#pragma unroll
                for (int k = 0; k < NKMAX; ++k) c += (int)__popcll(__ballot(u[k] >= cand));
                if (c >= 256) t2 = cand; }
            bool bad = false;
#pragma unroll
            for (int k = 0; k < NKMAX; ++k) bad |= (k < nk) && (__ballot(u[k] >= thr) != __ballot(u[k] >= t2));
            if (bad && lane == 0) __hip_atomic_fetch_add(chk, 1u, __ATOMIC_RELAXED, __HIP_MEMORY_SCOPE_AGENT);
        }
#pragma unroll
        for (int k = 0; k < NKMAX; ++k) { const unsigned long long bal = __ballot(u[k] >= thr); if (k < nk && lane == 0) mask[q * 65 + k] = bal; }
    }
}

DI void attn_sel_unit(const Frame& F0, int l, int slab, int rs0) {
    const unsigned tst_11 = PROBE_T ? (unsigned)clock64() : 0u;
    const Frame F = F0.fresh();
    const int tid = F.tid, lane = F.lane, wave = F.wave, r32 = lane & 31, h2 = lane >> 5;
    LAS unsigned char* lds = F.lds;
    GLB unsigned long long* mask = (GLB unsigned long long*)(F.ws() + WS_MASK) + (size_t)(rs0 >> 5) * 32 * 65;
    LAS float* wil = (LAS float*)(lds + AT_WI);
    int R0, sq, t0; rowinfo(slab, rs0, R0, sq, t0);
    const bool smp = sq >= 16;
    const int qpos0 = (smp ? PAST : 0) + t0, nvis = 64 * (qpos0 / 64 + 1), nk = nvis >> 6, pb = posbase(sq);
    GLB float* scr = (GLB float*)(F.ws() + WS_SCR) + (size_t)F.bid * 32 * LDR;
    GLB const f16* PROJ = F.PROJ();
#pragma unroll
    for (int it = 0; it < 8; ++it) { const int i = tid + NTHR * it, row = i >> 7, c8 = (i & 127) * 8;
        *(LAS h8*)(lds + AT_QI + (row * AT_QIS + c8) * 2) = *(GLB const h8*)(PROJ + (size_t)(rs0 + row) * PS + C_QI + c8); }
    wil[tid] = F.WI()[(size_t)(R0 + (tid >> 4)) * 16 + (tid & 15)];
    __syncthreads();
    {
    {
        GLB const f16* KI = F.KIU();
        h8 an[2][4];
        { const int p0 = wave < nk ? wave : 0;
#pragma unroll
          for (int tl = 0; tl < 2; ++tl)
#pragma unroll
            for (int s = 0; s < 4; ++s) an[tl][s] = *(GLB const h8*)(KI + (size_t)(pb + 64 * p0 + 32 * tl + r32) * 64 + 16 * s + 8 * h2); }
#pragma unroll 1
        for (int pp = wave; pp < ((PROBE_REP & 512) ? 2 * nk : nk); pp += 8) { const int p = pp >= nk ? pp - nk : pp;
            h8 a[2][4];
#pragma unroll
            for (int tl = 0; tl < 2; ++tl)
#pragma unroll
                for (int s = 0; s < 4; ++s) a[tl][s] = an[tl][s];
            { const int pn = (pp + 8 >= nk && !(PROBE_REP & 512)) ? p : ((pp + 8) >= nk ? pp + 8 - nk : pp + 8), pq = pn < nk ? pn : p;
#pragma unroll
              for (int tl = 0; tl < 2; ++tl)
#pragma unroll
                for (int s = 0; s < 4; ++s) an[tl][s] = *(GLB const h8*)(KI + (size_t)(pb + 64 * pq + 32 * tl + r32) * 64 + 16 * s + 8 * h2); }
            f32x16 sc0, sc1;
#pragma unroll
            for (int i = 0; i < 16; ++i) { sc0[i] = 0.f; sc1[i] = 0.f; }
#pragma unroll 2
            for (int h = 0; h < 16; ++h) {
                h8 b[4];
#pragma unroll
                for (int s = 0; s < 4; ++s) b[s] = *(const LAS h8*)(lds + AT_QI + (r32 * AT_QIS + h * 64 + 16 * s + 8 * h2) * 2);
                f32x16 c0, c1;
#pragma unroll
                for (int i = 0; i < 16; ++i) { c0[i] = 0.f; c1[i] = 0.f; }
#pragma unroll
                for (int s = 0; s < 4; ++s) { c0 = MFMA32(a[0][s], b[s], c0); c1 = MFMA32(a[1][s], b[s], c1); }
                const float w = wil[r32 * 16 + h];
#pragma unroll
                for (int i = 0; i < 16; ++i) { sc0[i] += w * fmaxf(c0[i], 0.f); sc1[i] += w * fmaxf(c1[i], 0.f); }
            }
            GLB float* o = scr + (size_t)r32 * LDR + 64 * p + 4 * h2;
#pragma unroll
            for (int g = 0; g < 4; ++g) { *(GLB f32x4*)(o + 8 * g) = (f32x4){sc0[4 * g], sc0[4 * g + 1], sc0[4 * g + 2], sc0[4 * g + 3]};
                                          *(GLB f32x4*)(o + 32 + 8 * g) = (f32x4){sc1[4 * g], sc1[4 * g + 1], sc1[4 * g + 2], sc1[4 * g + 3]}; }
        }
    }
    asm volatile("s_waitcnt vmcnt(0)" ::: "memory");
    __syncthreads();
    __builtin_amdgcn_fence(__ATOMIC_ACQUIRE, "agent");
    { int lane2 = lane; asm volatile("" : "+v"(lane2));
      LAS unsigned* hist = (LAS unsigned*)(lds + wave * 8192);
      unsigned* chk = F.ctl() + CW_T + 1024;
      if (nk > 32) select_rows_hist<65>(scr, mask, hist, wave, lane2, nk, chk); else if (nk > 16) select_rows_hist<32>(scr, mask, hist, wave, lane2, nk, chk);
      else if (nk > 8) select_rows<16>(scr, mask, wave, lane2, nk, nvis); else select_rows<8>(scr, mask, wave, lane2, nk, nvis); }
    __syncthreads();
    }
    if (PROBE_T && (lane_id_fresh() + F0.wave * 64) == 0) __hip_atomic_fetch_add((unsigned long long*)(F0.ctl() + CW_T) + 11, (unsigned long long)((unsigned)clock64() - tst_11), __ATOMIC_RELAXED, __HIP_MEMORY_SCOPE_AGENT);
}
DI void attn_pv_unit(const Frame& F0, int l, int slab, int rs0, int n) {
    const Frame F = F0.fresh();
    unsigned tacc[9] = {0, 0, 0, 0, 0, 0, 0, 0, 0}; unsigned tlast = PROBE_T ? (unsigned)clock64() : 0u; const unsigned tstart = tlast;
#define TICK(k) do { if (PROBE_T) { const unsigned now_ = (unsigned)clock64(); tacc[k] += now_ - tlast; tlast = now_; } } while (0)
    const int tid = F.tid, lane = F.lane, wave = F.wave, r32 = lane & 31, h2 = lane >> 5;
    LAS unsigned char* lds = F.lds;
    LAS unsigned long long* mask = (LAS unsigned long long*)(lds + AT_MASK);
    LAS float* bt = (LAS float*)(lds + AT_BT);
    int R0, sq, t0; rowinfo(slab, rs0, R0, sq, t0);
    const bool smp = sq >= 16;
    const int qpos0 = (smp ? PAST : 0) + t0, nk = qpos0 / 64 + 1, pb = posbase(sq);
    GLB const f16* PROJ = F.PROJ();
    {
        GLB const unsigned long long* mg = (GLB const unsigned long long*)(F.ws() + WS_MASK) + (size_t)(rs0 >> 5) * 32 * 65;
        for (int i = tid; i < 32 * nk; i += NTHR) { const int q = i / nk, k = i - q * nk; mask[q * 65 + k] = mg[q * 65 + k]; }
        GLB const float* rb = F.in(I_RELB);
        for (int i = tid; i < 8 * 192; i += NTHR) { const int h = i / 192, rel = (i % 192) - 128; bt[(8 * n + h) * 192 + (i % 192)] = rb[rel_bucket(rel) * 16 + 8 * n + h] * LOG2E; }
    }
    __syncthreads();
    GLB const f16* KU = F.KU(); GLB const f16* VU = F.VU();
    const int i16 = lane & 15, q4 = i16 >> 2, p4 = i16 & 3, blk = (lane >> 4) & 1;
    {
        const int hq = 8 * n + wave;
        h8 qf[8];
#pragma unroll
        for (int s = 0; s < 8; ++s) qf[s] = *(GLB const h8*)(PROJ + (size_t)(rs0 + r32) * PS + C_QB + hq * 128 + 16 * s + 8 * h2);
        const float b15 = bt[hq * 192];
        f32x16 O[4];
#pragma unroll
        for (int mt = 0; mt < 4; ++mt)
#pragma unroll
            for (int i = 0; i < 16; ++i) O[mt][i] = 0.f;
        float m = -1e30f, lsum = 0.f;
        u32x4 kreg[2], vreg[2];
        const int srow = tid >> 4, sc8 = (tid & 15) * 8;
#define AT_LOAD(j) do { _Pragma("unroll") for (int it = 0; it < 2; ++it) { const size_t go = (size_t)(pb + 64 * (j) + srow + 32 * it) * 256 + n * 128 + sc8; \
            kreg[it] = *(GLB const u32x4*)(KU + go); vreg[it] = *(GLB const u32x4*)(VU + go); } } while (0)
#define AT_STORE(b) do { _Pragma("unroll") for (int it = 0; it < 2; ++it) { const int lo = AT_KV + (b) * AT_BUF + (srow + 32 * it) * AT_ROW + sc8 * 2; \
            *(LAS u32x4*)(lds + lo) = kreg[it]; *(LAS u32x4*)(lds + AT_KV + (b) * AT_BUF + AT_V + (srow + 32 * it) * AT_VROW + sc8 * 2) = vreg[it]; } } while (0)
        const bool grpB = wave >= 4;
        TICK(8);
        AT_LOAD(0); AT_STORE(0);
        if (grpB && nk > 1) AT_LOAD(1);
            asm volatile("s_waitcnt lgkmcnt(0)" ::: "memory"); __builtin_amdgcn_s_barrier(); asm volatile("" ::: "memory");
        if (grpB) {
            asm volatile("s_waitcnt lgkmcnt(0)" ::: "memory"); __builtin_amdgcn_s_barrier(); asm volatile("" ::: "memory");
        }
#pragma unroll 1
        for (int j = 0; j < nk; ++j) {
            const bool more = (j + 1) < nk;
            TICK(0);
            if (!grpB && more) AT_LOAD(j + 1);
            LAS unsigned char* kb = lds + AT_KV + (j & 1) * AT_BUF;
            LAS unsigned char* vb = kb + AT_V;
            f32x16 st[2];
#pragma unroll 1
            for (int prb_ = 0; prb_ < ((PROBE_REP & 2048) ? 2 : 1); ++prb_)
#pragma unroll
            for (int sub = 0; sub < 2; ++sub) {
                h8 ka[8];
#pragma unroll
                for (int s = 0; s < 8; ++s) ka[s] = *(const LAS h8*)(kb + (32 * sub + r32) * AT_ROW + 32 * s + 16 * h2);
                f32x16 c0;
#pragma unroll
                for (int i = 0; i < 16; ++i) c0[i] = 0.f;
                SB(); PRIO(1);
#pragma unroll
                for (int s = 0; s < 8; ++s) c0 = MFMA32(ka[s], qf[s], c0);
                PRIO(0); SB();
                st[sub] = c0;
            }
            TICK(1);
            const bool far = (64 * j + 63 - qpos0) <= -128;
            float mx = -1e30f;
            if (far) {
#pragma unroll
                for (int sub = 0; sub < 2; ++sub)
#pragma unroll
                    for (int i = 0; i < 16; ++i) mx = fmaxf(mx, st[sub][i]);
                mx = mx * SCL2 + b15;
            } else {
                const int relb = 64 * j + 4 * h2 - (qpos0 + r32) + 128;
#pragma unroll
                for (int sub = 0; sub < 2; ++sub)
#pragma unroll
                    for (int i = 0; i < 16; ++i) { int ri = relb + 32 * sub + (i & 3) + 8 * (i >> 2); ri = ri < 0 ? 0 : ri;
                        st[sub][i] = st[sub][i] * SCL2 + bt[hq * 192 + ri]; mx = fmaxf(mx, st[sub][i]); }
            }
            mx = fmaxf(mx, shx32(mx, lane));
            const float mnew = fmaxf(m, mx), alpha = __builtin_amdgcn_exp2f(m - mnew);
            m = mnew;
            lsum *= alpha;
            if (__any(alpha != 1.0f)) {
#pragma unroll
                for (int mt = 0; mt < 4; ++mt)
#pragma unroll
                    for (int i = 0; i < 16; ++i) O[mt][i] *= alpha;
            }
            TICK(2);
            if (grpB && more) AT_STORE((j + 1) & 1);
            asm volatile("s_waitcnt lgkmcnt(0)" ::: "memory"); __builtin_amdgcn_s_barrier(); asm volatile("" ::: "memory");
            TICK(3);
            if (grpB && (j + 2) < nk) AT_LOAD(j + 2);
            const unsigned long long mw = mask[r32 * 65 + j];
            float ps = 0.f;
            h8 pf[2][2];
            const float esc = far ? SCL2 : 1.0f, ecst = (far ? b15 : 0.f) - mnew;
            const ::h2 ones2 = {(f16)1.f, (f16)1.f};
#pragma unroll
            for (int sub = 0; sub < 2; ++sub) {
                const unsigned wsh = ((unsigned)(mw >> (32 * sub))) >> (4 * h2);
                u32x4 pw[2];
#pragma unroll
                for (int pr = 0; pr < 8; ++pr) {
                    const int i0 = 2 * pr, cb = (i0 & 3) + 8 * (i0 >> 2);
                    const float e0 = __builtin_amdgcn_exp2f(st[sub][i0] * esc + ecst), e1 = __builtin_amdgcn_exp2f(st[sub][i0 + 1] * esc + ecst);
                    const unsigned b0 = (unsigned)__builtin_amdgcn_sbfe((int)wsh, cb, 1), b1 = (unsigned)__builtin_amdgcn_sbfe((int)wsh, cb + 1, 1);
                    const unsigned mk = (b0 & 0xFFFFu) | (b1 & 0xFFFF0000u);
                    const unsigned pk = pk_f16(e0, e1) & mk;
                    ps = __builtin_amdgcn_fdot2(__builtin_bit_cast(::h2, pk), ones2, ps, false);
                    pw[pr >> 2][pr & 3] = pk;
                }
                pf[sub][0] = __builtin_bit_cast(h8, pw[0]); pf[sub][1] = __builtin_bit_cast(h8, pw[1]);
            }
            lsum += ps;
            TICK(4);
#pragma unroll 1
            for (int prb_ = (PROBE_REP & 4096) ? 0 : 1; prb_ < 2; ++prb_) {
            h8 pu[2][2];
            { float zr = prb_ ? 1.0f : 0.0f; asm volatile("" : "+v"(zr));
#pragma unroll
              for (int a_ = 0; a_ < 2; ++a_)
#pragma unroll
                for (int b_ = 0; b_ < 2; ++b_) { h8 t = pf[a_][b_];
                    if (PROBE_REP & 4096) {
#pragma unroll
                        for (int jj = 0; jj < 8; ++jj) t[jj] = (f16)((float)t[jj] * zr); }
                    pu[a_][b_] = t; } }
#pragma unroll
            for (int mp = 0; mp < 2; ++mp) {
                h8 va[2][4];
#pragma unroll
                for (int ml = 0; ml < 2; ++ml)
#pragma unroll
                    for (int sub = 0; sub < 2; ++sub)
#pragma unroll
                        for (int ks = 0; ks < 2; ++ks) {
                            LAS unsigned char* ap = vb + (32 * sub + 16 * ks + 4 * h2 + q4) * AT_VROW + 64 * (2 * mp + ml) + 8 * (4 * blk + p4);
                            const fp16x4_t lo = __builtin_amdgcn_ds_read_tr16_b64_v4f16((LAS fp16x4_t*)ap);
                            const fp16x4_t hi = __builtin_amdgcn_ds_read_tr16_b64_v4f16((LAS fp16x4_t*)(ap + 8 * AT_VROW));
                            va[ml][sub * 2 + ks] = __builtin_shufflevector(__builtin_bit_cast(h4, lo), __builtin_bit_cast(h4, hi), 0, 1, 2, 3, 4, 5, 6, 7);
                        }
                SB(); PRIO(1);
#pragma unroll
                for (int kk = 0; kk < 4; ++kk) { O[2 * mp] = MFMA32(va[0][kk], pu[kk >> 1][kk & 1], O[2 * mp]); O[2 * mp + 1] = MFMA32(va[1][kk], pu[kk >> 1][kk & 1], O[2 * mp + 1]); }
                PRIO(0); SB();
            }
            }
            TICK(5);
            if (!grpB && more) AT_STORE((j + 1) & 1);
            asm volatile("s_waitcnt lgkmcnt(0)" ::: "memory"); __builtin_amdgcn_s_barrier(); asm volatile("" ::: "memory");
        }
        if (!grpB) {
            asm volatile("s_waitcnt lgkmcnt(0)" ::: "memory"); __builtin_amdgcn_s_barrier(); asm volatile("" ::: "memory");
        }
#undef AT_LOAD
#undef AT_STORE
        TICK(6);
        const float ltot = lsum + shx32(lsum, lane), inv = 1.0f / ltot;
        const size_t orow = (size_t)(rs0 + r32);
        GLB const f16* zp = PROJ + orow * PS + C_ZB + hq * 128 + 4 * h2;
        GLB f16* ob = F.OB() + orow * 2048 + hq * 128 + 4 * h2;
        h4 zbv[4][4];
#pragma unroll
        for (int mt = 0; mt < 4; ++mt)
#pragma unroll
            for (int g = 0; g < 4; ++g) zbv[mt][g] = *(GLB const h4*)(zp + 32 * mt + 8 * g);
        asm volatile("" ::: "memory");
#pragma unroll
        for (int mt = 0; mt < 4; ++mt)
#pragma unroll
            for (int g = 0; g < 4; ++g) {
                h4 ov;
#pragma unroll
                for (int jj = 0; jj < 4; ++jj) ov[jj] = (f16)(O[mt][4 * g + jj] * inv * (float)zbv[mt][g][jj]);
                *(GLB h4*)(ob + 32 * mt + 8 * g) = ov;
            }
    }
    if (PROBE_T && tid == 0) { TICK(7); tacc[7] = tlast - tstart;
        unsigned long long* tc = (unsigned long long*)(F.ctl() + CW_T);
#pragma unroll
        for (int k_ = 0; k_ < 9; ++k_) __hip_atomic_fetch_add(tc + k_, (unsigned long long)tacc[k_], __ATOMIC_RELAXED, __HIP_MEMORY_SCOPE_AGENT); }
#undef TICK
    __syncthreads();
}

DI void ab_tile_unit(const Frame& F, int l, int t);
DI void out_tile_unit(const Frame& F, int l, int t);
DI void phase_mix(const Frame F0, int l, int slab, int rep = 0) {
    const Frame F = F0.fresh();
    LAS int* ubox = (LAS int*)(F.lds + LDS_MISC + 64);
    const int xcc = (int)(xb_xcc_id() & 7u);
    const int nex = slab == 1 ? 4 : 0;
    const int nsc = 8 + (slab == 0 ? 32 : 0), nsb = slab == 0 ? 8 : 0, total = nex + nsc + nsb + 64;
#pragma unroll 1
    for (int qq = 0; qq < 8; ++qq) {
        const int q = (xcc + qq) & 7;
        unsigned* ctr = F.ctl() + CW_Q + ((rep * 8 + l * NSLAB + slab) * 8 + q) * 64;
        for (;;) {
            if (F.tid == 0) ubox[0] = (int)__hip_atomic_fetch_add(ctr, 1u, __ATOMIC_RELAXED, __HIP_MEMORY_SCOPE_AGENT);
            __syncthreads();
            const int u0 = ubox[0];
            __syncthreads();
            if (u0 >= total) break;
            if (u0 < nex) { out_tile_unit(F, l, u0 * 8 + q); continue; }
            const int u = u0 - nex;
            if (u < 8) { const int cu = u * 8 + q; gdn_scan_unit(F, l, slab, slab * 4 + (cu >> 4), cu & 15);
                if (PROBE_REP & 256) gdn_scan_unit(F, l, slab, slab * 4 + (cu >> 4), cu & 15); }
            else if (u < nsc) { const int v = (u - 8) * 8 + q; gdn_scan_unit(F, l, slab, 16 + (v >> 4), v & 15); }
            else if (u < nsc + nsb) { const int w = u - nsc; attn_pv_unit(F, l, slab, 8192 + 32 * ((w >> 1) * 8 + q), w & 1); }
            else { const int k = u - nsc - nsb; attn_pv_unit(F, l, slab, (q & 3) * 2048 + (63 - (2 * (k >> 1) + (q >> 2))) * 32, k & 1); }
        }
    }
}
DI void phase_pre(const Frame F0, int l, int slab, int rep = 0) {
    const Frame F = F0.fresh();
    LAS int* ubox = (LAS int*)(F.lds + LDS_MISC + 64);
    unsigned* ctr = F.ctl() + CW_Q + (128 + rep * 8 + l * NSLAB + slab) * 64;
    const int nex = slab == 1 ? 32 : 0;
    const int nsel = ts_of(slab) / 32, nc = slab == 0 ? 144 : 128, total = nex + nsel + nc * 16;
    int nxt = 0;
    if (F.tid == 0) nxt = (int)__hip_atomic_fetch_add(ctr, 1u, __ATOMIC_RELAXED, __HIP_MEMORY_SCOPE_AGENT);
    for (;;) {
        if (F.tid == 0) ubox[0] = nxt;
        __syncthreads();
        const int u0 = ubox[0];
        __syncthreads();
        if (u0 >= total) break;
        if (F.tid == 0) nxt = (int)__hip_atomic_fetch_add(ctr, 1u, __ATOMIC_RELAXED, __HIP_MEMORY_SCOPE_AGENT);
        if (u0 < nex) { ab_tile_unit(F, l, u0); continue; }
        const int u = u0 - nex;
        if (u < nsel) {
            int q = u, rs0;
            if (slab == 0 && q < 32) rs0 = 8192 + 32 * q;
            else { if (slab == 0) q -= 32; rs0 = (q & 3) * 2048 + (63 - (q >> 2)) * 32; }
            attn_sel_unit(F, l, slab, rs0);
        } else { const int v = u - nsel; gdn_pre_unit(F, l, slab, v >> 4, v & 15); }
    }
}
DI void phase_final(const Frame F0) {
    const Frame F = F0.fresh();
    if (PROBE_T) { const unsigned long long tot = __hip_atomic_load((unsigned long long*)(F.ctl() + CW_T) + (PROBE_T - 1), __ATOMIC_RELAXED, __HIP_MEMORY_SCOPE_AGENT);
        const long long target = (long long)(tot / (unsigned long long)F.G); const long long t0 = clock64(); while (clock64() - t0 < target) __builtin_amdgcn_s_sleep(1); }
    const bool selbad = SELCHK && __hip_atomic_load(F.ctl() + CW_T + 1024, __ATOMIC_RELAXED, __HIP_MEMORY_SCOPE_AGENT) != 0u;
    GLB const float* nw = F.in(I_FNW);
    f32x4 nwv[8];
#pragma unroll
    for (int i = 0; i < 8; ++i) nwv[i] = *(GLB const f32x4*)(nw + (i * 64 + F.lane) * 4);
    for (int R = F.bid * NWAVES + F.wave; R < NTOK; R += F.G * NWAVES) {
        GLB float* x = F.out() + (size_t)R * D;
        f32x4 v[8]; float ss = 0.f;
#pragma unroll
        for (int i = 0; i < 8; ++i) { v[i] = *(GLB const f32x4*)(x + (i * 64 + F.lane) * 4); ss += v[i][0] * v[i][0] + v[i][1] * v[i][1] + v[i][2] * v[i][2] + v[i][3] * v[i][3]; }
        ss = wave_sum(ss, F.lane);
        const float r = rsqrtf(ss * (1.0f / 2048.0f) + EPS);
#pragma unroll
        for (int i = 0; i < 8; ++i) { const int c = (i * 64 + F.lane) * 4; *(GLB f32x4*)(x + c) = v[i] * (selbad ? __builtin_nanf("") : r) * nwv[i]; }
    }
}

DI void phase_inproj(const Frame F, int l, int s, int part, int Gg, int gidx) {
    const int Ts = ts_of(s);
    pg8::Gemm g{F.H(s & 1), F.WIN() + (size_t)l * NP * 2048, F.H(s & 1), F.WIN() + (size_t)l * NP * 2048, Ts, NP, 2048};
    pg8::SubOrder S; S.init2(Ts, part, Gg, gidx);
    EpiProj E{F.PROJ(), F.out(), F.KU(), F.VU(), F.KIU(), F.WI(), F.BETA(), F.GG(), F.in(I_ALOG) + l * 16, F.in(I_DTB) + l * 16, l, s};
    pg8::gemm_phase<EpiProj, pg8::SubOrder>(F.lds, g, S, E, F.wave);
}
DI void ab_tile_unit(const Frame& F, int l, int t) {
    pg8::Gemm g{F.OA(), F.WA() + (size_t)l * 2048 * 2048, F.OB(), F.WB() + (size_t)l * 2048 * 2048, 9216, 2048, 2048};
    pg8::OneTile S{32 + (t >> 3), t & 7, 2};
    EpiAB E{F.PROJ(), F.MG()};
    pg8::gemm_phase<EpiAB, pg8::OneTile>(F.lds, g, S, E, F.wave);
}
DI void out_tile_unit(const Frame& F, int l, int t) {
    pg8::Gemm g{F.MG(), F.WO() + (size_t)l * 2048 * 2048, F.MG(), F.WO() + (size_t)l * 2048 * 2048, 9216, 2048, 2048};
    pg8::OneTile S{32 + (t >> 3), t & 7, 1};
    EpiOut E{F.in(I_XP), F.in(I_XS), F.out(), F.ADA() + (size_t)l * 32 * 6144, l, 0};
    pg8::gemm_phase<EpiOut, pg8::OneTile>(F.lds, g, S, E, F.wave);
}
DI void phase_ab(const Frame F, int l, int s) {
    const int Ts = 8192;
    pg8::Gemm g{F.OA(), F.WA() + (size_t)l * 2048 * 2048, F.OB(), F.WB() + (size_t)l * 2048 * 2048, Ts, 2048, 2048};
    pg8::DualOrder S; S.init(Ts, 2048, F.G, F.bid);
    EpiAB E{F.PROJ(), F.MG()};
    pg8::gemm_phase<EpiAB, pg8::DualOrder>(F.lds, g, S, E, F.wave);
}
DI void phase_outp(const Frame F, int l, int s) {
    const int Ts = 8192;
    pg8::Gemm g{F.MG(), F.WO() + (size_t)l * 2048 * 2048, F.MG(), F.WO() + (size_t)l * 2048 * 2048, Ts, 2048, 2048};
    pg8::StaticOrder S; S.init(Ts, 2048, F.G, F.bid);
    EpiOut E{F.in(I_XP), F.in(I_XS), F.out(), F.ADA() + (size_t)l * 32 * 6144, l, s};
    pg8::gemm_phase<EpiOut, pg8::StaticOrder>(F.lds, g, S, E, F.wave);
}
constexpr int NPH = 4;
constexpr int N_PHASES = 3 + 2 * NSLAB * NPH + 1;
constexpr int JG = 20;
__global__ void __launch_bounds__(NTHR, 2) fwd_kernel(Args args) {
    extern __shared__ __attribute__((aligned(16))) unsigned char lds[];
    Frame F;
    F.lds = (LAS unsigned char*)lds;
    F.tid = threadIdx.x; F.lane = F.tid & 63; F.wave = __builtin_amdgcn_readfirstlane(F.tid >> 6); F.G = gridDim.x; F.bid = blockIdx.x;
    if (F.tid < 22) *(LAS unsigned long long*)(F.lds + LDS_TAB + 8 * F.tid) = (unsigned long long)args.in[F.tid];
    if (F.tid == 22) *(LAS unsigned long long*)(F.lds + LDS_TAB + 8 * 22) = (unsigned long long)args.out;
    if (F.tid == 23) *(LAS unsigned long long*)(F.lds + LDS_TAB + 8 * 23) = (unsigned long long)args.ws;
    volatile LAS unsigned* MISC = (volatile LAS unsigned*)(F.lds + LDS_MISC);
    if (F.tid < 64) MISC[F.tid] = 0u;
    __syncthreads();
    const int lo = args.ph_lo, hi = args.ph_hi;
    const bool multi = (hi - lo) > 1;
    if (multi) (void)xcd_barrier_post(F.ctl() + CW_BAR, MISC);
    const int jcls = F.bid >> 3, JGe = (F.G >> 3) * JG / 32, Gg = JGe * 8;
    const bool isG = jcls < JGe; const int gidx = jcls * 8 + (F.bid & 7);
#define IN(k) (lo <= (k) && (k) < hi)
#define GBAR() do { XcdBarrier bar_; bar_.bar = F.ctl() + CW_BAR; bar_.x = xb_xcc_id(); bar_.st = MISC; xcd_barrier(bar_, (int)(lane_id_fresh() == 0 && F.wave == 0)); } while (0)
#define SEAM(k) do { if (IN(k) && IN((k) + 1)) { XcdBarrier bar_; bar_.bar = F.ctl() + CW_BAR; bar_.x = xb_xcc_id(); bar_.st = MISC; xcd_barrier(bar_, (int)(lane_id_fresh() == 0 && F.wave == 0)); } } while (0)
    if (IN(0)) p0_prologue(F);
    SEAM(0);
    if (IN(1)) phase_norm(F, 0, 0);
    SEAM(1);
    if (IN(2)) { phase_inproj(F, 0, 0, 1, F.G, F.bid); phase_norm(F, 0, 1); }
    SEAM(2);
    for (int l = 0; l < 2; ++l)
        for (int s = 0; s < NSLAB; ++s) {
            const int pb = 3 + (l * NSLAB + s) * NPH;
            const int nl = s + 1 < NSLAB ? l : l + 1, ns = s + 1 < NSLAB ? s + 1 : 0;
#pragma unroll 1
            for (int st = 0; st < 2; ++st) {
                if (IN(pb + st)) {
                    const int gl_ = st ? nl : l, gs_ = st ? ns : s;
                    if (isG && gl_ < 2) phase_inproj(F, gl_, gs_, st ? 1 : 2, Gg, gidx);
                    if (st == 0) phase_pre(F, l, s); else phase_mix(F, l, s);
                }
                SEAM(pb + st);
            }
            if (IN(pb + 2)) phase_ab(F, l, s);
            SEAM(pb + 2);
            if (IN(pb + 3)) {
                phase_outp(F, l, s);
                const int s2 = s + 2, l2 = s2 < NSLAB ? l : l + 1;
                if (l2 < 2) phase_norm(F, l2, s2 & 3);
            }
            SEAM(pb + 3);
        }
    if (IN(N_PHASES - 1)) phase_final(F);
#undef IN
#undef SEAM
#undef GBAR
}

extern "C" void kernel_launch(void* const* d_in, const int* in_sizes, int n_in, void* d_out, int out_size, void* d_ws, size_t ws_size, hipStream_t stream) {
    static int grid = 0;
    if (grid == 0) {
        if (n_in != 22 || (size_t)out_size != O_END || ws_size < WS_END) { fprintf(stderr, "kernel_launch: unexpected shapes (n_in %d out %d ws %zu, need %zu)\n", n_in, out_size, ws_size, (size_t)WS_END); grid = -1; return; }
        int dev = 0, cus = 0, per_cu = 0;
        if (hipGetDevice(&dev) != hipSuccess || hipDeviceGetAttribute(&cus, hipDeviceAttributeMultiprocessorCount, dev) != hipSuccess) { grid = -1; return; }
        if (hipFuncSetAttribute((const void*)fwd_kernel, hipFuncAttributeMaxDynamicSharedMemorySize, LDS_BYTES) != hipSuccess) { fprintf(stderr, "kernel_launch: hipFuncSetAttribute failed\n"); grid = -1; return; }
        if (hipOccupancyMaxActiveBlocksPerMultiprocessor(&per_cu, (const void*)fwd_kernel, NTHR, LDS_BYTES) != hipSuccess || per_cu < 1) { fprintf(stderr, "kernel_launch: occupancy query says %d\n", per_cu); }
        (void)hipGetLastError();
        grid = cus < 256 ? cus : 256;
    }
    if (grid < 0) return;
    (void)hipMemsetAsync((char*)d_ws + WS_CTL, 0, CTL_BYTES, stream);
    Args a{};
    for (int i = 0; i < 22; ++i) a.in[i] = (const float*)d_in[i];
    a.out = (float*)d_out; a.ws = (unsigned char*)d_ws;
#if MK_ONE_LAUNCH
    a.ph_lo = 0; a.ph_hi = N_PHASES;
    hipLaunchKernelGGL(fwd_kernel, dim3(grid), dim3(NTHR), LDS_BYTES, stream, a);
#else
    for (int p = 0; p < N_PHASES; ++p) { a.ph_lo = p; a.ph_hi = p + 1; hipLaunchKernelGGL(fwd_kernel, dim3(grid), dim3(NTHR), LDS_BYTES, stream, a); }
#endif
}
```
